# Optimizing an MI355X kernel written in HIP

```python
import math
import jax, jax.numpy as jnp
from jax import lax
import numpy as np

D_MODEL = 2048
BATCH = 8
SEQ = 2048
DEPTH = 2

HEAD_DIM = 64
A_HEADS = 16
A_KV_HEADS = 4
A_WINDOW = 128
A_BLOCK = 128
B_HEADS = 8
B_BLOCK = 256
B_TOPK = 3
B_QCHUNK = 32
C_HEADS = 8
C_LATENT = 128
IDX_HEADS = 8
IDX_DIM = 32
C_TOPK_MAX = 256
C_QCHUNK = 128
REL_BUCKETS = 32
REL_MAX_DIST = 2048
N_ATTN_HEADS = A_HEADS + B_HEADS + C_HEADS
PEER_HEADS = 8
PEER_KEYS = 128
PEER_N = PEER_KEYS * PEER_KEYS
PEER_QDIM = 256
PEER_TOPK = 16
PEER_TCHUNK = 128
EPS = 1e-6
NEG = -1e30

IN_SPLITS = (A_HEADS * HEAD_DIM, A_KV_HEADS * HEAD_DIM, A_KV_HEADS * HEAD_DIM,
             B_HEADS * HEAD_DIM, B_HEADS * HEAD_DIM, B_HEADS * HEAD_DIM,
             C_HEADS * HEAD_DIM, C_LATENT, IDX_HEADS * IDX_DIM, IDX_DIM, IDX_HEADS,
             D_MODEL, D_MODEL, D_MODEL)
IN_COLS = sum(IN_SPLITS)

kernel_name = "hybrid_gated_swa_moba_dsa_peer"


def rmsnorm(x, g):
    x32 = x.astype(jnp.float32)
    y = x32 * lax.rsqrt(jnp.mean(x32 * x32, axis=-1, keepdims=True) + EPS)
    return (y * g.astype(jnp.float32)).astype(x.dtype)


def rel_bucket(dist):
    d = jnp.maximum(dist, 0)
    max_exact = REL_BUCKETS // 2
    df = jnp.maximum(d, max_exact).astype(jnp.float32)
    large = max_exact + (jnp.log(df / max_exact) / math.log(REL_MAX_DIST / max_exact)
                         * (REL_BUCKETS - max_exact)).astype(jnp.int32)
    large = jnp.minimum(large, REL_BUCKETS - 1)
    return jnp.where(d < max_exact, d, large)


def swa_sink_attention(q, k, v, sinks, bt):
    B, T = q.shape[0], q.shape[1]
    nq = T // A_BLOCK
    G = A_HEADS // A_KV_HEADS
    qb = q.reshape(B, nq, A_BLOCK, A_KV_HEADS, G, HEAD_DIM)
    pad = jnp.zeros((B, A_BLOCK, A_KV_HEADS, HEAD_DIM), k.dtype)
    kp = jnp.concatenate([pad, k], axis=1).reshape(B, nq + 1, A_BLOCK, A_KV_HEADS, HEAD_DIM)
    vp = jnp.concatenate([pad.astype(v.dtype), v], axis=1).reshape(B, nq + 1, A_BLOCK, A_KV_HEADS, HEAD_DIM)
    kb = jnp.concatenate([kp[:, :-1], kp[:, 1:]], axis=2)
    vb = jnp.concatenate([vp[:, :-1], vp[:, 1:]], axis=2)
    s = jnp.einsum("bnqhgd,bnkhd->bnhgqk", qb, kb).astype(jnp.float32) * (HEAD_DIM ** -0.5)
    qpos = jnp.arange(A_BLOCK)[:, None] + A_BLOCK
    kpos = jnp.arange(2 * A_BLOCK)[None, :]
    dist = qpos - kpos
    band = (dist >= 0) & (dist < A_WINDOW)
    real = (jnp.arange(nq)[:, None, None] > 0) | (kpos[None] >= A_BLOCK)
    mask = band[None] & real
    bias = bt[rel_bucket(dist)].astype(jnp.float32)
    bias = jnp.transpose(bias, (2, 0, 1)).reshape(A_KV_HEADS, G, A_BLOCK, 2 * A_BLOCK)
    s = jnp.where(mask[None, :, None, None], s + bias[None, None], NEG)
    sink = jnp.broadcast_to(sinks.astype(jnp.float32).reshape(A_KV_HEADS, G, 1, 1)[None, None],
                            s.shape[:-1] + (1,))
    p = jax.nn.softmax(jnp.concatenate([s, sink], axis=-1), axis=-1)[..., :-1]
    o = jnp.einsum("bnhgqk,bnkhd->bnqhgd", p.astype(v.dtype), vb)
    return o.reshape(B, T, A_HEADS * HEAD_DIM)


def moba_attention(q, k, v, bt):
    B, T = q.shape[0], q.shape[1]
    H = B_HEADS
    nb = -(-T // B_BLOCK)
    pad = nb * B_BLOCK - T
    kb = jnp.pad(k, ((0, 0), (0, pad), (0, 0), (0, 0))).reshape(B, nb, B_BLOCK, H, HEAD_DIM).transpose(0, 3, 1, 2, 4)
    vb = jnp.pad(v, ((0, 0), (0, pad), (0, 0), (0, 0))).reshape(B, nb, B_BLOCK, H, HEAD_DIM).transpose(0, 3, 1, 2, 4)
    kmean = jnp.mean(kb.astype(jnp.float32), axis=3)
    qblk = jnp.arange(T) // B_BLOCK
    gate = jnp.einsum("bthd,bhnd->bhtn", q.astype(jnp.float32), kmean)
    past = jnp.arange(nb)[None, :] < qblk[:, None]
    gate = jnp.where(past, gate, NEG)
    topb = min(B_TOPK, nb)
    _, sel = lax.top_k(gate, topb)
    valid = sel < qblk[None, None, :, None]
    nc = T // B_QCHUNK
    qc = q.reshape(B, nc, B_QCHUNK, H, HEAD_DIM).transpose(1, 0, 3, 2, 4)
    selc = sel.reshape(B, H, nc, B_QCHUNK, topb).transpose(2, 0, 1, 3, 4)
    validc = valid.reshape(B, H, nc, B_QCHUNK, topb).transpose(2, 0, 1, 3, 4)
    btT = bt.T.astype(jnp.float32)
    bi = jnp.arange(B)[:, None, None, None]
    hi = jnp.arange(H)[None, :, None, None]
    scale = HEAD_DIM ** -0.5

    def chunk(args):
        c, qx, sx, vx = args
        tq = c * B_QCHUNK + jnp.arange(B_QCHUNK)
        ks = kb[bi, hi, sx]
        vs = vb[bi, hi, sx]
        s_sel = jnp.einsum("bhqd,bhqnkd->bhqnk", qx, ks).astype(jnp.float32) * scale
        pos_sel = sx[..., None] * B_BLOCK + jnp.arange(B_BLOCK)
        b_sel = btT[hi[..., None], rel_bucket(tq[:, None, None] - pos_sel)]
        s_sel = jnp.where(vx[..., None], s_sel + b_sel, NEG).reshape(B, H, B_QCHUNK, topb * B_BLOCK)
        j = (c * B_QCHUNK) // B_BLOCK
        k_own = lax.dynamic_index_in_dim(kb, j, axis=2, keepdims=False)
        v_own = lax.dynamic_index_in_dim(vb, j, axis=2, keepdims=False)
        pos_own = j * B_BLOCK + jnp.arange(B_BLOCK)
        d_own = tq[:, None] - pos_own[None, :]
        s_own = jnp.einsum("bhqd,bhkd->bhqk", qx, k_own).astype(jnp.float32) * scale + btT[:, rel_bucket(d_own)][None]
        s_own = jnp.where((d_own >= 0)[None, None], s_own, NEG)
        p = jax.nn.softmax(jnp.concatenate([s_sel, s_own], axis=-1), axis=-1).astype(v.dtype)
        p_sel = p[..., :topb * B_BLOCK].reshape(B, H, B_QCHUNK, topb, B_BLOCK)
        p_own = p[..., topb * B_BLOCK:]
        return (jnp.einsum("bhqnk,bhqnkd->bhqd", p_sel, vs)
                + jnp.einsum("bhqk,bhkd->bhqd", p_own, v_own))

    o = lax.map(chunk, (jnp.arange(nc), qc, selc, validc))
    return o.transpose(1, 0, 3, 2, 4).reshape(B, T, H * HEAD_DIM)


def dsa_attention(q, c_lat, w_uk, w_uv, iq, ik, iw, bt):
    B, T = q.shape[0], q.shape[1]
    H = C_HEADS
    kc = min(C_TOPK_MAX, T // 4)
    nc = T // C_QCHUNK
    q_abs = jnp.einsum("bthd,chd->bthc", q, w_uk)
    qac = q_abs.reshape(B, nc, C_QCHUNK, H, C_LATENT).transpose(1, 0, 2, 3, 4)
    iqc = iq.reshape(B, nc, C_QCHUNK, IDX_HEADS, IDX_DIM).transpose(1, 0, 2, 3, 4)
    iwc = iw.reshape(B, nc, C_QCHUNK, IDX_HEADS).transpose(1, 0, 2, 3)
    btT = bt.T.astype(jnp.float32)
    kpos = jnp.arange(T)
    bi = jnp.arange(B)[:, None, None]
    hi = jnp.arange(H)[None, :, None, None]
    idx_scale = (IDX_DIM ** -0.5) * (IDX_HEADS ** -0.5)
    scale = HEAD_DIM ** -0.5

    def chunk(args):
        c, qx, iqx, iwx = args
        tq = c * C_QCHUNK + jnp.arange(C_QCHUNK)
        logits = jnp.einsum("bqhd,bsd->bqhs", iqx, ik).astype(jnp.float32)
        score = jnp.einsum("bqh,bqhs->bqs", iwx.astype(jnp.float32), jax.nn.relu(logits)) * idx_scale
        score = jnp.where(kpos[None, None, :] <= tq[None, :, None], score, NEG)
        _, sel = lax.top_k(score, kc)
        c_sel = c_lat[bi, sel]
        dist = tq[None, :, None] - sel
        s = (jnp.einsum("bqhc,bqkc->bhqk", qx, c_sel).astype(jnp.float32) * scale
             + btT[hi, rel_bucket(dist)[:, None]])
        s = jnp.where((dist >= 0)[:, None], s, NEG)
        p = jax.nn.softmax(s, axis=-1).astype(c_lat.dtype)
        oc = jnp.einsum("bhqk,bqkc->bqhc", p, c_sel)
        return jnp.einsum("bqhc,chd->bqhd", oc, w_uv).reshape(B, C_QCHUNK, H * HEAD_DIM)

    o = lax.map(chunk, (jnp.arange(nc), qac, iqc, iwc))
    return o.transpose(1, 0, 2, 3).reshape(B, T, H * HEAD_DIM)


def peer_ffn(h, w_q, sub_keys, u_tab, v_tab):
    B, T, D = h.shape
    n = B * T
    xt = h.reshape(n, D)
    q = (xt @ w_q).reshape(n, PEER_HEADS, 2, PEER_QDIM // 2)
    s = jnp.einsum("nhpd,hpkd->nhpk", q, sub_keys).astype(jnp.float32)
    s1, i1 = lax.top_k(s[:, :, 0], PEER_TOPK)
    s2, i2 = lax.top_k(s[:, :, 1], PEER_TOPK)
    cand_s = (s1[..., :, None] + s2[..., None, :]).reshape(n, PEER_HEADS, PEER_TOPK * PEER_TOPK)
    cand_i = (i1[..., :, None] * PEER_KEYS + i2[..., None, :]).reshape(n, PEER_HEADS, PEER_TOPK * PEER_TOPK)
    top_s, pos = lax.top_k(cand_s, PEER_TOPK)
    experts = jnp.take_along_axis(cand_i, pos, axis=-1)
    g = jax.nn.softmax(top_s, axis=-1).astype(h.dtype)
    nch = n // PEER_TCHUNK

    def chunk(args):
        xc, ec, gc = args
        a = jax.nn.gelu(jnp.einsum("td,thkd->thk", xc, u_tab[ec]))
        return jnp.einsum("thk,thkd->td", gc * a, v_tab[ec])

    out = lax.map(chunk, (xt.reshape(nch, PEER_TCHUNK, D),
                          experts.reshape(nch, PEER_TCHUNK, PEER_HEADS, PEER_TOPK),
                          g.reshape(nch, PEER_TCHUNK, PEER_HEADS, PEER_TOPK)))
    return out.reshape(B, T, D)


def setup_inputs(seed: int = 0) -> dict:
    key = jax.random.key(seed)
    ks = jax.random.split(key, 18)

    def nrm(k, shape, scale):
        return jax.random.normal(k, shape, jnp.float32) * scale

    L = DEPTH
    return {
        "x": nrm(ks[0], (BATCH, SEQ, D_MODEL), 1.0),
        "rel_bias": nrm(ks[1], (REL_BUCKETS, N_ATTN_HEADS), 0.5),
        "g_mix": 1.0 + nrm(ks[2], (L, D_MODEL), 0.02),
        "w_in": nrm(ks[3], (L, D_MODEL, IN_COLS), D_MODEL ** -0.5),
        "a_sinks": nrm(ks[4], (L, A_HEADS), 0.5),
        "c_lat_gain": 1.0 + nrm(ks[5], (L, C_LATENT), 0.02),
        "c_w_uk": nrm(ks[6], (L, C_LATENT, C_HEADS, HEAD_DIM), C_LATENT ** -0.5),
        "c_w_uv": nrm(ks[7], (L, C_LATENT, C_HEADS, HEAD_DIM), C_LATENT ** -0.5),
        "w_br_a": nrm(ks[8], (L, A_HEADS * HEAD_DIM, D_MODEL), (A_HEADS * HEAD_DIM) ** -0.5),
        "w_br_b": nrm(ks[9], (L, B_HEADS * HEAD_DIM, D_MODEL), (B_HEADS * HEAD_DIM) ** -0.5),
        "w_br_c": nrm(ks[10], (L, C_HEADS * HEAD_DIM, D_MODEL), (C_HEADS * HEAD_DIM) ** -0.5),
        "w_out": nrm(ks[11], (L, D_MODEL, D_MODEL), D_MODEL ** -0.5),
        "g_ffn": 1.0 + nrm(ks[12], (L, D_MODEL), 0.02),
        "peer_w_q": nrm(ks[13], (L, D_MODEL, PEER_HEADS * PEER_QDIM), D_MODEL ** -0.5),
        "peer_sub_keys": nrm(ks[14], (L, PEER_HEADS, 2, PEER_KEYS, PEER_QDIM // 2), (PEER_QDIM // 2) ** -0.5),
        "peer_u": nrm(ks[15], (L, PEER_N, D_MODEL), D_MODEL ** -0.5),
        "peer_v": nrm(ks[16], (L, PEER_N, D_MODEL), 0.25),
        "g_final": 1.0 + nrm(ks[17], (D_MODEL,), 0.02),
    }


def reference(x, rel_bias, g_mix, w_in, a_sinks, c_lat_gain, c_w_uk, c_w_uv, w_br_a, w_br_b, w_br_c,
              w_out, g_ffn, peer_w_q, peer_sub_keys, peer_u, peer_v, g_final):
    B, T, D = x.shape
    splits = [int(o) for o in np.cumsum(IN_SPLITS)[:-1]]
    bt_a = rel_bias[:, :A_HEADS]
    bt_b = rel_bias[:, A_HEADS:A_HEADS + B_HEADS]
    bt_c = rel_bias[:, A_HEADS + B_HEADS:]
    for l in range(DEPTH):
        h = rmsnorm(x, g_mix[l])
        (qa, ka, va, qb, kb, vb, qc, clat, iq, ik, iw, ga, gb, gc) = jnp.split(h @ w_in[l], splits, axis=-1)
        ya = swa_sink_attention(qa.reshape(B, T, A_HEADS, HEAD_DIM),
                                ka.reshape(B, T, A_KV_HEADS, HEAD_DIM),
                                va.reshape(B, T, A_KV_HEADS, HEAD_DIM), a_sinks[l], bt_a)
        yb = moba_attention(qb.reshape(B, T, B_HEADS, HEAD_DIM),
                            kb.reshape(B, T, B_HEADS, HEAD_DIM),
                            vb.reshape(B, T, B_HEADS, HEAD_DIM), bt_b)
        yc = dsa_attention(qc.reshape(B, T, C_HEADS, HEAD_DIM), rmsnorm(clat, c_lat_gain[l]),
                           c_w_uk[l], c_w_uv[l], iq.reshape(B, T, IDX_HEADS, IDX_DIM), ik, iw, bt_c)
        merged = (jax.nn.sigmoid(ga) * (ya @ w_br_a[l])
                  + jax.nn.sigmoid(gb) * (yb @ w_br_b[l])
                  + jax.nn.sigmoid(gc) * (yc @ w_br_c[l]))
        x = x + merged @ w_out[l]
        x = x + peer_ffn(rmsnorm(x, g_ffn[l]), peer_w_q[l], peer_sub_keys[l], peer_u[l], peer_v[l])
    return rmsnorm(x, g_final)
```

```cpp
#include <hip/hip_runtime.h>
#include <cstdio>
#include <cstdint>
namespace pg8 {
#define PG8_LAS __attribute__((address_space(3)))
typedef unsigned short bf16_t;
typedef short bf16x8 __attribute__((ext_vector_type(8)));
typedef float f32x4 __attribute__((ext_vector_type(4)));
typedef unsigned u32x4 __attribute__((ext_vector_type(4)));
constexpr int BM = 256, BK = 64, HALF = 128, HTB = HALF * BK * 2  , STAGE_BYTES = 8 * HTB, NXCD = 8, WGM = 8;

__host__ __device__ __forceinline__ int lds_byte(int r, int c) { const int st = (r >> 4) * 2 + (c >> 5), rr = r & 15, cc = c & 31, ob = rr * 64 + cc * 2; return st * 1024 + (ob ^ (((ob >> 9) & 1) << 5)); }
__host__ __device__ __forceinline__ void stage_rc(int b, int& R, int& C) { const int st = b / 1024, sb = b % 1024, swz = sb ^ (((sb >> 9) & 1) << 5); R = (st >> 1) * 16 + swz / 64; C = (st & 1) * 32 + (swz % 64) / 2; }
__host__ __device__ __forceinline__ int perm32(int rho) { const int n = rho >> 4, i = rho & 15; return 8 * (i >> 2) + 4 * n + (i & 3); }

struct Unit { int pm, pn; };
struct Gemm { const bf16_t* A; const bf16_t* Bt; int M, N, K; };

struct StaticOrder {
    int nM, nN, nwg, G, c;
    __host__ __device__ void init(int M, int N, int G_, int c_) { nM = M / BM; nN = N / BM; nwg = nM * nN; G = G_; c = c_; }
    __host__ __device__ bool next(int i, Unit& u) const {
        const long L = (long)i * G + c; if (L >= nwg) return false;
        int wgid = (int)L; { const int q = nwg / NXCD, r = nwg % NXCD, xcd = wgid % NXCD, off = wgid / NXCD; wgid = (xcd < r ? xcd * (q + 1) : r * (q + 1) + (xcd - r) * q) + off; }
        const int nig = WGM * nN, gid = wgid / nig, fm = gid * WGM, gsz = (nM - fm) < WGM ? (nM - fm) : WGM;
        u.pm = fm + ((wgid % nig) % gsz); u.pn = (wgid % nig) / gsz; return true;
    }
    __device__ __forceinline__ void a_ready(const Unit&) const {}
    __device__ __forceinline__ void done(const Unit&) const {}
};

__device__ __forceinline__ unsigned cvt_pk_bf16(float lo, float hi) { unsigned r; asm volatile("v_cvt_pk_bf16_f32 %0, %1, %2" : "=v"(r) : "v"(lo), "v"(hi)); return r; }
typedef float f32x2 __attribute__((ext_vector_type(2)));
typedef unsigned u32x2 __attribute__((ext_vector_type(2)));
__device__ __forceinline__ float bf_lo(unsigned u) { return __builtin_bit_cast(float, u << 16); }
__device__ __forceinline__ float bf_hi(unsigned u) { return __builtin_bit_cast(float, u & 0xffff0000u); }
__device__ __forceinline__ float sigmoidf_(float v) { return 1.0f / (1.0f + __expf(-v)); }

struct EpiProj {
    static constexpr bool PERM = true, AFTER_DRAIN = false;
    bf16_t* PA; bf16_t* GT; const float* rowss;
    __device__ __forceinline__ void operator()(const f32x4 (&acc)[2][2][4][2], const Unit& u, int wr, int wc, int fr, int fq) const {
        const int row0 = u.pm * BM + wr * 64 + fr;
        const bool gate = u.pn >= 16;
        bf16_t* base = gate ? GT : PA; const int ldc = gate ? 6144 : 4096;
        const int col0 = (gate ? (u.pn - 16) : u.pn) * BM + wc * 32 + 8 * fq;
#pragma unroll
        for (int ai = 0; ai < 2; ++ai)
#pragma unroll
            for (int m = 0; m < 4; ++m) { const int row = row0 + ai * HALF + m * 16; const float rs = rsqrtf(rowss[row] * (1.0f / 2048.0f) + 1e-6f);
                bf16_t* rowp = base + (size_t)row * ldc + col0;
#pragma unroll
                for (int bj = 0; bj < 2; ++bj) { f32x4 v0 = acc[ai][bj][m][0] * rs, v1 = acc[ai][bj][m][1] * rs;
                    if (gate) { v0 = (f32x4){sigmoidf_(v0[0]), sigmoidf_(v0[1]), sigmoidf_(v0[2]), sigmoidf_(v0[3])}; v1 = (f32x4){sigmoidf_(v1[0]), sigmoidf_(v1[1]), sigmoidf_(v1[2]), sigmoidf_(v1[3])}; }
                    u32x4 w; w.x = cvt_pk_bf16(v0[0], v0[1]); w.y = cvt_pk_bf16(v0[2], v0[3]); w.z = cvt_pk_bf16(v1[0], v1[1]); w.w = cvt_pk_bf16(v1[2], v1[3]);
                    *(u32x4*)(rowp + bj * HALF) = w; } }
    }
};
struct EpiGate {
    static constexpr bool PERM = true, AFTER_DRAIN = false;
    bf16_t* MG; const bf16_t* GT; int goff; int first;
    __device__ __forceinline__ void operator()(const f32x4 (&acc)[2][2][4][2], const Unit& u, int wr, int wc, int fr, int fq) const {
        const int row0 = u.pm * BM + wr * 64 + fr; const int col0 = u.pn * BM + wc * 32 + 8 * fq;
#pragma unroll
        for (int ai = 0; ai < 2; ++ai)
#pragma unroll
            for (int m = 0; m < 4; ++m) { const int row = row0 + ai * HALF + m * 16;
                const bf16_t* gp = GT + (size_t)row * 6144 + goff + col0; bf16_t* op = MG + (size_t)row * 2048 + col0;
                const u32x4 g0 = *(const u32x4*)gp, g1 = *(const u32x4*)(gp + HALF);
                u32x4 o0 = (u32x4){0u, 0u, 0u, 0u}, o1 = (u32x4){0u, 0u, 0u, 0u};
                if (!first) { o0 = *(const u32x4*)op; o1 = *(const u32x4*)(op + HALF); }
#pragma unroll
                for (int bj = 0; bj < 2; ++bj) { const u32x4 gv = bj ? g1 : g0, ov = bj ? o1 : o0;
                    f32x4 v0 = acc[ai][bj][m][0], v1 = acc[ai][bj][m][1];
                    v0 = v0 * (f32x4){bf_lo(gv.x), bf_hi(gv.x), bf_lo(gv.y), bf_hi(gv.y)} + (f32x4){bf_lo(ov.x), bf_hi(ov.x), bf_lo(ov.y), bf_hi(ov.y)};
                    v1 = v1 * (f32x4){bf_lo(gv.z), bf_hi(gv.z), bf_lo(gv.w), bf_hi(gv.w)} + (f32x4){bf_lo(ov.z), bf_hi(ov.z), bf_lo(ov.w), bf_hi(ov.w)};
                    u32x4 w; w.x = cvt_pk_bf16(v0[0], v0[1]); w.y = cvt_pk_bf16(v0[2], v0[3]); w.z = cvt_pk_bf16(v1[0], v1[1]); w.w = cvt_pk_bf16(v1[2], v1[3]);
                    *(u32x4*)(op + bj * HALF) = w; }
                asm volatile("" ::: "memory"); }
    }
};
struct EpiResid {
    static constexpr bool PERM = false, AFTER_DRAIN = false;
    const float* xold; float* xnew; bf16_t* xb; float* rowss;
    __device__ __forceinline__ void operator()(const f32x4 (&acc)[2][2][4][2], const Unit& u, int wr, int wc, int fr, int fq) const {
        const int col0 = u.pn * BM + wc * 32 + 4 * fq;
#pragma unroll
        for (int ai = 0; ai < 2; ++ai)
#pragma unroll
            for (int m = 0; m < 4; ++m) { const int r = u.pm * BM + ai * HALF + wr * 64 + m * 16 + fr; const size_t off = (size_t)r * 2048 + col0; float ss = 0.f;
#pragma unroll
                for (int bj = 0; bj < 2; ++bj)
#pragma unroll
                    for (int n = 0; n < 2; ++n) { const size_t o = off + bj * HALF + n * 16; const f32x4 xo = *(const f32x4*)(xold + o); const f32x4 v = xo + acc[ai][bj][m][n];
                        *(f32x4*)(xnew + o) = v; ss += (v[0] * v[0] + v[1] * v[1]) + (v[2] * v[2] + v[3] * v[3]);
                        u32x2 w; w.x = cvt_pk_bf16(v[0], v[1]); w.y = cvt_pk_bf16(v[2], v[3]); *(u32x2*)(xb + o) = w; }
                ss += __shfl_xor(ss, 16); ss += __shfl_xor(ss, 32);
                if (fq == 0) rowss[(size_t)r * 32 + u.pn * 4 + wc] = ss; }
    }
};
struct EpiQ {
    static constexpr bool PERM = true, AFTER_DRAIN = false;
    bf16_t* Q;
    __device__ __forceinline__ void operator()(const f32x4 (&acc)[2][2][4][2], const Unit& u, int wr, int wc, int fr, int fq) const {
        const int row0 = u.pm * BM + wr * 64 + fr; const int col0 = u.pn * BM + wc * 32 + 8 * fq;
#pragma unroll
        for (int ai = 0; ai < 2; ++ai)
#pragma unroll
            for (int m = 0; m < 4; ++m) { const int row = row0 + ai * HALF + m * 16;
                bf16_t* rowp = Q + (size_t)row * 2048 + col0;
#pragma unroll
                for (int bj = 0; bj < 2; ++bj) { const f32x4 v0 = acc[ai][bj][m][0], v1 = acc[ai][bj][m][1];
                    u32x4 w; w.x = cvt_pk_bf16(v0[0], v0[1]); w.y = cvt_pk_bf16(v0[2], v0[3]); w.z = cvt_pk_bf16(v1[0], v1[1]); w.w = cvt_pk_bf16(v1[2], v1[3]);
                    *(u32x4*)(rowp + bj * HALF) = w; } }
    }
};
template <class Epi, class Sched, bool ALIGN_EPI = false, bool SP2 = false>
__device__ __forceinline__ void gemm_phase(PG8_LAS unsigned char* lds, const Gemm g, const Sched& S, const Epi& E) {
    int tid_ = threadIdx.x; asm volatile("" : "+v"(tid_));
    const int tid = tid_, wid = __builtin_amdgcn_readfirstlane(tid >> 6), lane = tid & 63, wr = wid >> 2, wc = wid & 3, fr = lane & 15, fq = lane >> 4;
    const int K = g.K, nt = K / BK;
    unsigned voffA[2], voffB[2];
#pragma unroll
    for (int i = 0; i < 2; ++i) { int R, C; stage_rc(tid * 16 + i * 8192, R, C); const int Rb = Epi::PERM ? ((R & ~31) + perm32(R & 31)) : R;
        voffA[i] = (unsigned)(R * K + C) * 2u; voffB[i] = (unsigned)(Rb * K + C) * 2u; }
    const size_t kstep = (size_t)(BK * 2);
    const size_t hstep = (size_t)HALF * K * 2;
    const size_t tstep = 2 * hstep;
    const unsigned ldsw = (unsigned)wid * 1024u;
    const int aoff = lds_byte(wr * 64 + fr, fq * 8), boff = lds_byte(wc * 32 + fr, fq * 8);
#define PG8_SA(b, h) (((b) * 2 + (h)) * HTB)
#define PG8_SB(b, h) ((4 + (b) * 2 + (h)) * HTB)
#define PG8_STAGE(bufoff, gbase, voff) do { _Pragma("unroll") for (int _i = 0; _i < 2; ++_i) \
        __builtin_amdgcn_global_load_lds((const unsigned*)((const char*)(gbase) + (voff)[_i]), (PG8_LAS unsigned*)(lds + (bufoff) + ldsw + _i * 8192), 16, 0, 0); } while (0)
#define PG8_LDA(dst, b, h) do { _Pragma("unroll") for (int m = 0; m < 4; ++m) _Pragma("unroll") for (int k = 0; k < 2; ++k) dst[m][k] = *(const PG8_LAS bf16x8*)(lds + PG8_SA(b, h) + aoff + m * 2048 + k * 1024); } while (0)
#define PG8_LDB(dst, b, h) do { _Pragma("unroll") for (int n = 0; n < 2; ++n) _Pragma("unroll") for (int k = 0; k < 2; ++k) dst[n][k] = *(const PG8_LAS bf16x8*)(lds + PG8_SB(b, h) + boff + n * 2048 + k * 1024); } while (0)
#define PG8_MMA(ai, bj, At, Bt) do { __builtin_amdgcn_s_setprio(1); _Pragma("unroll") for (int m = 0; m < 4; ++m) _Pragma("unroll") for (int n = 0; n < 2; ++n) _Pragma("unroll") for (int k = 0; k < 2; ++k) \
        acc[ai][bj][m][n] = __builtin_amdgcn_mfma_f32_16x16x32_bf16(Bt[n][k], At[m][k], acc[ai][bj][m][n], 0, 0, 0); __builtin_amdgcn_s_setprio(0); } while (0)
#define PG8_WAIT_V(n) asm volatile("s_waitcnt vmcnt(" #n ")" ::: "memory")
#define PG8_WAIT_L(n) asm volatile("s_waitcnt lgkmcnt(" #n ")" ::: "memory")
#define PG8_BAR __builtin_amdgcn_s_barrier()
#define PG8_SCHED __builtin_amdgcn_sched_barrier(0)
    Unit cur, nxt; int ui = 0;
    if (!S.next(0, cur)) return;
    f32x4 acc[2][2][4][2];
#pragma unroll
    for (int a = 0; a < 2; ++a)
#pragma unroll
        for (int b = 0; b < 2; ++b)
#pragma unroll
            for (int m = 0; m < 4; ++m)
#pragma unroll
                for (int n = 0; n < 2; ++n) acc[a][b][m][n] = (f32x4){0.f, 0.f, 0.f, 0.f};
    bf16x8 At[4][2], B0[2][2], B1[2][2];
    const char* cA = (const char*)g.A + (size_t)cur.pm * tstep; const char* cB = (const char*)g.Bt + (size_t)cur.pn * tstep;
    S.a_ready(cur);
    if constexpr (SP2) {
        PG8_STAGE(PG8_SB(0, 0), cB, voffB); PG8_STAGE(PG8_SB(0, 1), cB + hstep, voffB); PG8_STAGE(PG8_SA(0, 0), cA, voffA); PG8_STAGE(PG8_SA(0, 1), cA + hstep, voffA);
        if (wr == 1) PG8_BAR;
        PG8_WAIT_V(2); PG8_BAR;
        PG8_STAGE(PG8_SB(1, 0), cB + kstep, voffB); PG8_STAGE(PG8_SA(1, 0), cA + kstep, voffA); PG8_STAGE(PG8_SB(1, 1), cB + hstep + kstep, voffB);
        PG8_WAIT_V(6); PG8_BAR;
    } else {
        PG8_STAGE(PG8_SB(0, 0), cB, voffB); PG8_STAGE(PG8_SA(0, 0), cA, voffA); PG8_STAGE(PG8_SB(0, 1), cB + hstep, voffB); PG8_STAGE(PG8_SA(0, 1), cA + hstep, voffA);
        if (wr == 1) PG8_BAR;
        PG8_WAIT_V(4); PG8_BAR;
        PG8_STAGE(PG8_SB(1, 0), cB + kstep, voffB); PG8_STAGE(PG8_SA(1, 0), cA + kstep, voffA); PG8_STAGE(PG8_SB(1, 1), cB + hstep + kstep, voffB);
        PG8_WAIT_V(6); PG8_BAR;
    }
    for (;;) {
        const bool has_next = S.next(ui + 1, nxt);
        const char* nA = has_next ? (const char*)g.A + (size_t)nxt.pm * tstep : cA; const char* nB = has_next ? (const char*)g.Bt + (size_t)nxt.pn * tstep : cB;
        for (int t = 0; t < nt; t += 2) {
            const bool last = (t == nt - 2);
            const char* a1 = cA + (size_t)(t + 1) * kstep;
            const char* a2 = last ? nA : cA + (size_t)(t + 2) * kstep; const char* b2 = last ? nB : cB + (size_t)(t + 2) * kstep;
            const char* a3 = a2 + kstep; const char* b3 = b2 + kstep;
            if (last && has_next) S.a_ready(nxt);
            if constexpr (SP2) {
            PG8_LDB(B0, 0, 0); PG8_LDB(B1, 0, 1); PG8_SCHED; PG8_LDA(At, 0, 0); PG8_STAGE(PG8_SA(1, 1), a1 + hstep, voffA);
            PG8_WAIT_V(8); PG8_WAIT_L(0); PG8_BAR; PG8_MMA(0, 0, At, B0); PG8_MMA(0, 1, At, B1); PG8_BAR; PG8_SCHED;
            PG8_LDA(At, 0, 1); PG8_STAGE(PG8_SB(0, 0), b2, voffB); PG8_STAGE(PG8_SB(0, 1), b2 + hstep, voffB); PG8_STAGE(PG8_SA(0, 0), a2, voffA);
            PG8_WAIT_V(8); PG8_WAIT_L(0); PG8_BAR; PG8_MMA(1, 0, At, B0); PG8_MMA(1, 1, At, B1); PG8_BAR; PG8_SCHED;
            PG8_LDB(B0, 1, 0); PG8_LDB(B1, 1, 1); PG8_SCHED; PG8_LDA(At, 1, 0); PG8_STAGE(PG8_SA(0, 1), a2 + hstep, voffA);
            PG8_WAIT_V(8); PG8_WAIT_L(0); PG8_BAR; PG8_MMA(0, 0, At, B0); PG8_MMA(0, 1, At, B1); PG8_BAR; PG8_SCHED;
            PG8_LDA(At, 1, 1); PG8_STAGE(PG8_SB(1, 0), b3, voffB); PG8_STAGE(PG8_SB(1, 1), b3 + hstep, voffB); PG8_STAGE(PG8_SA(1, 0), a3, voffA);
            PG8_WAIT_V(8); PG8_WAIT_L(0); PG8_BAR; PG8_MMA(1, 0, At, B0); PG8_MMA(1, 1, At, B1); PG8_BAR; PG8_SCHED;
            } else {
            PG8_LDB(B0, 0, 0); PG8_SCHED; PG8_LDA(At, 0, 0); PG8_STAGE(PG8_SA(1, 1), a1 + hstep, voffA);
            PG8_WAIT_L(8); PG8_BAR; PG8_WAIT_L(0); PG8_MMA(0, 0, At, B0); PG8_BAR; PG8_SCHED;
            PG8_LDB(B1, 0, 1); PG8_STAGE(PG8_SB(0, 0), b2, voffB);
            PG8_BAR; PG8_WAIT_L(0); PG8_MMA(0, 1, At, B1); PG8_BAR;
            PG8_LDA(At, 0, 1); PG8_STAGE(PG8_SA(0, 0), a2, voffA);
            PG8_BAR; PG8_WAIT_L(0); PG8_MMA(1, 0, At, B0); PG8_BAR; PG8_SCHED;
            PG8_STAGE(PG8_SB(0, 1), b2 + hstep, voffB);
            PG8_WAIT_V(6); PG8_BAR; PG8_MMA(1, 1, At, B1); PG8_BAR;
            PG8_LDB(B0, 1, 0); PG8_SCHED; PG8_LDA(At, 1, 0); PG8_STAGE(PG8_SA(0, 1), a2 + hstep, voffA);
            PG8_WAIT_L(8); PG8_BAR; PG8_WAIT_L(0); PG8_MMA(0, 0, At, B0); PG8_BAR; PG8_SCHED;
            PG8_LDB(B1, 1, 1); PG8_STAGE(PG8_SB(1, 0), b3, voffB);
            PG8_BAR; PG8_WAIT_L(0); PG8_MMA(0, 1, At, B1); PG8_BAR;
            PG8_LDA(At, 1, 1); PG8_STAGE(PG8_SA(1, 0), a3, voffA);
            PG8_BAR; PG8_WAIT_L(0); PG8_MMA(1, 0, At, B0); PG8_BAR; PG8_SCHED;
            PG8_STAGE(PG8_SB(1, 1), b3 + hstep, voffB);
            PG8_WAIT_V(6); PG8_BAR; PG8_MMA(1, 1, At, B1); PG8_BAR;
            }
        }
        if constexpr (ALIGN_EPI) { if (wr == 0) PG8_BAR; }
        if constexpr (!Epi::AFTER_DRAIN) { E(acc, cur, wr, wc, fr, fq); S.done(cur); }
        if (!has_next) break;
#pragma unroll
        for (int a = 0; a < 2; ++a)
#pragma unroll
            for (int b = 0; b < 2; ++b)
#pragma unroll
                for (int m = 0; m < 4; ++m)
#pragma unroll
                    for (int n = 0; n < 2; ++n) acc[a][b][m][n] = (f32x4){0.f, 0.f, 0.f, 0.f};
        cur = nxt; cA = nA; cB = nB; ++ui;
        if constexpr (ALIGN_EPI) { if (wr == 1) PG8_BAR; }
    }
    PG8_WAIT_V(0);
    if constexpr (!ALIGN_EPI) { if (wr == 0) PG8_BAR; }
    PG8_BAR;
    if constexpr (Epi::AFTER_DRAIN) { E.fused(acc, cur, wr, wc, fr, fq, lds, wid, lane); S.done(cur); }
#undef PG8_SA
#undef PG8_SB
#undef PG8_STAGE
#undef PG8_LDA
#undef PG8_LDB
#undef PG8_MMA
#undef PG8_WAIT_V
#undef PG8_WAIT_L
#undef PG8_BAR
#undef PG8_SCHED
}
}
#define PG8_SP2 true
#define GAS __attribute__((address_space(1)))
#define LAS __attribute__((address_space(3)))
typedef unsigned short bf16;
typedef unsigned v4u __attribute__((ext_vector_type(4)));
typedef float f32x4 __attribute__((ext_vector_type(4)));
typedef short bf16x8 __attribute__((ext_vector_type(8)));
typedef GAS unsigned gu32;
typedef GAS unsigned long long gu64;
#define RLX_AGENT __ATOMIC_RELAXED, __HIP_MEMORY_SCOPE_AGENT
#define LDS_WAIT() asm volatile("s_waitcnt lgkmcnt(0)" ::: "memory")
#define VM_WAIT() asm volatile("s_waitcnt vmcnt(0)" ::: "memory")
__device__ __forceinline__ unsigned long long rt() { return __builtin_amdgcn_s_memrealtime(); }
__device__ __forceinline__ unsigned f2bf(float f) { unsigned u = __builtin_bit_cast(unsigned, f); return (u + 0x7fffu + ((u >> 16) & 1u)) >> 16; }
__device__ __forceinline__ unsigned pk2(float lo, float hi) { return f2bf(lo) | (f2bf(hi) << 16); }

#define XB_TMO      128
#define XB_XCNT(j)  (256  + 64 * (j))
#define XB_XSUB(j)  (1280 + 64 * (j))
#define XB_XGEN(j)  (2304 + 64 * (j))
#define XB_TOP      3328
#define XB_TOPGEN   3392
#define XCD_BAR_WORDS 3456
#define XB_SPIN_CAP (1u << 18)

__device__ __forceinline__ unsigned xb_ld(unsigned* p)              { return __hip_atomic_load(p, __ATOMIC_RELAXED, __HIP_MEMORY_SCOPE_AGENT); }
__device__ __forceinline__ unsigned xb_add(unsigned* p, unsigned v) { return __hip_atomic_fetch_add(p, v, __ATOMIC_RELAXED, __HIP_MEMORY_SCOPE_AGENT); }
__device__ __forceinline__ unsigned xb_xcc_id() { return (unsigned)__builtin_amdgcn_s_getreg((3 << 11) | 20) & 0xFu; }
#define XB_SPIN(cond, bar) do { unsigned _sp = 0; while (cond) { __builtin_amdgcn_s_sleep(1); \
    if ((++_sp & 255u) == 0u) { if (xb_ld(&(bar)[XB_TMO])) break; if (_sp > XB_SPIN_CAP) { atomicAdd(&(bar)[XB_TMO], 1u); break; } } } } while (0)

struct XcdBarrier {
    unsigned* bar; unsigned x;
    volatile LAS unsigned* st;
};

__device__ __forceinline__ XcdBarrier xcd_barrier_post(unsigned* bar, volatile LAS unsigned* st) {
    XcdBarrier b; b.bar = bar; b.x = xb_xcc_id(); b.st = st;
    if (threadIdx.x == 0) (void)xb_add(&bar[XB_XCNT(b.x)], 1u);
    return b;
}
__device__ __forceinline__ void xcd_barrier_complete(unsigned* bar, unsigned x, unsigned& nloc, unsigned& nx) {
    const unsigned G = gridDim.x * gridDim.y * gridDim.z;
    unsigned sum, cnt, mine, sp = 0u;
    for (;;) {
        sum = 0u; cnt = 0u; mine = 0u;
#pragma unroll
        for (unsigned j = 0; j < 16; ++j) { const unsigned c = xb_ld(&bar[XB_XCNT(j)]); sum += c; cnt += (c > 0u) ? 1u : 0u; mine = (j == x) ? c : mine; }
        if (sum == G) break;
        __builtin_amdgcn_s_sleep(1);
        if ((++sp & 255u) == 0u) { if (xb_ld(&bar[XB_TMO])) break; if (sp > XB_SPIN_CAP) { atomicAdd(&bar[XB_TMO], 1u); break; } }
    }
    nloc = mine > 0u ? mine : 1u; nx = cnt > 0u ? cnt : 1u;
}

__device__ __forceinline__ void xcd_barrier(const XcdBarrier& b) {
    asm volatile("s_waitcnt vmcnt(0)" ::: "memory");
    __syncthreads();
    if (threadIdx.x == 0) {
        unsigned* bar = b.bar;
        __builtin_amdgcn_s_waitcnt(0);
        unsigned nloc = b.st[0], nx = b.st[1];
        if (nloc == 0u) { xcd_barrier_complete(bar, b.x, nloc, nx); b.st[0] = nloc; b.st[1] = nx; }
        const unsigned old = xb_add(&bar[XB_XSUB(b.x)], 1u);
        const unsigned gen = old / nloc;
        if (old + 1u == (gen + 1u) * nloc) {
            __builtin_amdgcn_fence(__ATOMIC_RELEASE, "agent");
            asm volatile("s_waitcnt vmcnt(0)" ::: "memory");
            const unsigned og = xb_add(&bar[XB_TOP], 1u);
            const unsigned tg = og / nx;
            if (og + 1u == (tg + 1u) * nx) xb_add(&bar[XB_TOPGEN], 1u);
            else XB_SPIN(xb_ld(&bar[XB_TOPGEN]) == tg, bar);
            __builtin_amdgcn_fence(__ATOMIC_ACQUIRE, "agent");
            xb_add(&bar[XB_XGEN(b.x)], 1u);
            asm volatile("s_waitcnt vmcnt(0)" ::: "memory");
        } else {
            XB_SPIN(xb_ld(&bar[XB_XGEN(b.x)]) == gen, bar);
            __builtin_amdgcn_fence(__ATOMIC_ACQUIRE, "agent");
            asm volatile("s_waitcnt vmcnt(0)" ::: "memory");
        }
    }
    __syncthreads();
}
namespace cfg {
constexpr int NWAVES = 8;
constexpr int M = 16384, D = 2048, T = 2048, NBATCH = 8, DEPTH = 2;
constexpr int IN_COLS = 10152, NPROJ = 10240, PA_LD = 4096, GT_LD = 6144;
constexpr int C_QA = 0, C_KA = 1024, C_VA = 1280, C_QB = 1536, C_KB = 2048, C_VB = 2560, C_QC = 3072, C_CL = 3584, C_IQ = 3712, C_IK = 3968, C_IW = 4000;
constexpr float EPS = 1e-6f;
constexpr size_t MiB = 1u << 20;
constexpr size_t WS_CTL = 0, CTL_ZERO_BYTES = 1 * MiB;
constexpr size_t WS_ROWSSB = 842 * MiB;
constexpr size_t WS_ROWSSA = 1 * MiB;
constexpr size_t WS_KMEAN = 1 * MiB + 64 * 1024;
constexpr size_t WS_BIASD = 1 * MiB + 256 * 1024;
constexpr size_t WS_CN = 2 * MiB;
constexpr size_t WS_MASK = 6 * MiB;
constexpr size_t WS_WA = 10 * MiB, WS_WB = 18 * MiB, WS_WC = 22 * MiB, WS_WOUT = 26 * MiB, WS_WQ = 42 * MiB, WS_WIN = 58 * MiB;
constexpr size_t WS_U = 138 * MiB, WS_V = 266 * MiB;
constexpr size_t WS_XB = 394 * MiB;
constexpr size_t WS_PA = 458 * MiB;
constexpr size_t WS_MG = WS_PA, WS_QP = WS_PA + 64 * MiB;
constexpr size_t WS_GT = 586 * MiB;
constexpr size_t WS_YA = 778 * MiB, WS_YB = 810 * MiB, WS_YC = 826 * MiB;
constexpr size_t WS_END = 844 * MiB;
constexpr int CW_BAR = 4096;
constexpr int RING_BYTES = 131072, LDSCTL_OFF = RING_BYTES, MISC_OFF = LDSCTL_OFF + 320, LDS_BYTES = 147456;
constexpr int NPHASE = 15;
}
using namespace cfg;
typedef __bf16 bf16x2_t __attribute__((ext_vector_type(2)));
__device__ __forceinline__ float bflo(unsigned u) { return __builtin_bit_cast(float, u << 16); }
__device__ __forceinline__ float bfhi(unsigned u) { return __builtin_bit_cast(float, u & 0xffff0000u); }
__device__ __forceinline__ float bf1(bf16 v) { return __builtin_bit_cast(float, (unsigned)v << 16); }
__device__ __forceinline__ float dot2(unsigned a, unsigned b, float c) { return __builtin_amdgcn_fdot2_f32_bf16(__builtin_bit_cast(bf16x2_t, a), __builtin_bit_cast(bf16x2_t, b), c, false); }
__device__ __forceinline__ float dot8(v4u a, v4u b, float c) { c = dot2(a.x, b.x, c); c = dot2(a.y, b.y, c); c = dot2(a.z, b.z, c); c = dot2(a.w, b.w, c); return c; }
__device__ __forceinline__ float wave_sum(float v) {
#pragma unroll
    for (int o = 1; o < 64; o <<= 1) v += __shfl_xor(v, o);
    return v;
}
__device__ __forceinline__ float wave_max(float v) {
#pragma unroll
    for (int o = 1; o < 64; o <<= 1) v = fmaxf(v, __shfl_xor(v, o));
    return v;
}
__device__ __forceinline__ unsigned fkey(float f) { const unsigned u = __builtin_bit_cast(unsigned, f); return u ^ ((unsigned)((int)u >> 31) | 0x80000000u); }
__device__ __forceinline__ int mbcnt64(unsigned long long m) { return (int)__builtin_amdgcn_mbcnt_hi((unsigned)(m >> 32), __builtin_amdgcn_mbcnt_lo((unsigned)m, 0u)); }
__device__ __forceinline__ float rdlane(float v, int l) { return __builtin_bit_cast(float, __builtin_amdgcn_readlane(__builtin_bit_cast(int, v), l)); }
__device__ __forceinline__ float gelu_tanh(float x) { const float u = 0.7978845608028654f * (x + 0.044715f * x * x * x); const float e = __expf(2.0f * u); const float th = 1.0f - 2.0f / (e + 1.0f); return 0.5f * x * (1.0f + th); }
template <int NR> __device__ __forceinline__ void wave_topk_select(const unsigned (&keys)[NR], int k, bool (&sel)[NR]) {
    unsigned tau = 0u;
    for (int bit = 31; bit >= 0; --bit) {
        const unsigned cand = tau | (1u << bit); int cnt = 0;
#pragma unroll
        for (int j = 0; j < NR; ++j) cnt += __popcll(__ballot(keys[j] >= cand));
        if (cnt >= k) tau = cand;
    }
    int need = k;
#pragma unroll
    for (int j = 0; j < NR; ++j) need -= __popcll(__ballot(keys[j] > tau));
#pragma unroll
    for (int j = 0; j < NR; ++j) {
        const bool e = keys[j] == tau; const unsigned long long eq = __ballot(e); const int c = __popcll(eq); bool take;
        if (c <= need) { take = e; need -= c; } else { take = e && (mbcnt64(eq) < need); need = 0; }
        sel[j] = (keys[j] > tau) || take;
    }
}
__device__ __forceinline__ void p0_transpose_item(const float* W, int ldw, int c0, int ncv, int K, const float* g, bf16* WT, int row_off, LAS float* scr, int item, int nblk, int lane) {
    const int kb = item / nblk, nb = item % nblk, k0 = 64 * kb, n0 = 32 * nb;
    const int nl = n0 + (lane & 31); const bool ok = nl < ncv;
#pragma unroll 8
    for (int i = 0; i < 32; ++i) { const int kk = 2 * i + (lane >> 5); float v = ok ? W[(size_t)(k0 + kk) * ldw + c0 + nl] : 0.f; if (g) v *= g[k0 + kk]; scr[kk * 33 + (lane & 31)] = v; }
    LDS_WAIT(); asm volatile("" ::: "memory");
    const int c = lane & 7;
#pragma unroll
    for (int j = 0; j < 4; ++j) { const int n = (lane >> 3) + 8 * j; const LAS float* s = scr + (8 * c) * 33 + n;
        v4u o; o.x = pk2(s[0 * 33], s[1 * 33]); o.y = pk2(s[2 * 33], s[3 * 33]); o.z = pk2(s[4 * 33], s[5 * 33]); o.w = pk2(s[6 * 33], s[7 * 33]);
        *(v4u*)(WT + (size_t)(row_off + n0 + n) * K + k0 + 8 * c) = o; }
    LDS_WAIT(); asm volatile("" ::: "memory");
}
__device__ __forceinline__ float row_to_bf16(const float* src, const float* g, bf16* dst, int lane) {
    float ss = 0.f;
#pragma unroll
    for (int i = 0; i < 4; ++i) { const int e0 = 8 * (lane + 64 * i);
        f32x4 a = *(const f32x4*)(src + e0), b = *(const f32x4*)(src + e0 + 4);
        ss += (a.x * a.x + a.y * a.y) + (a.z * a.z + a.w * a.w) + (b.x * b.x + b.y * b.y) + (b.z * b.z + b.w * b.w);
        if (g) { const f32x4 ga = *(const f32x4*)(g + e0), gb = *(const f32x4*)(g + e0 + 4); a = a * ga; b = b * gb; }
        v4u o; o.x = pk2(a.x, a.y); o.y = pk2(a.z, a.w); o.z = pk2(b.x, b.y); o.w = pk2(b.z, b.w);
        *(v4u*)(dst + e0) = o; }
    return wave_sum(ss);
}
__device__ __forceinline__ int rel_bucket(int d) {
    if (d < 16) return d;
    const int v = 16 + (int)(logf((float)d / 16.0f) / 4.852030263919617f * 16.0f);
    return v < 31 ? v : 31;
}
struct Ptrs {
    const float *x, *rel_bias, *g_mix, *w_in, *a_sinks, *c_gain, *w_uk, *w_uv, *w_a, *w_b, *w_c, *w_out, *g_ffn, *w_q, *sub_keys, *peer_u, *peer_v, *g_final;
    float* out; unsigned char* ws;
};
__device__ __forceinline__ void p0_prologue(const Ptrs& P, LAS unsigned char* lds, int gw, int NGW, int wave, int lane) {
    LAS float* scr = (LAS float*)(lds + wave * 16384);
    unsigned char* ws = P.ws;
    constexpr int I_IN1 = 32 * 128, I_IN2 = 32 * 192, I_A = 16 * 64, I_B = 8 * 64, I_C = 8 * 64, I_O = 32 * 64, I_Q = 32 * 64;
    constexpr int I_LAYER = I_IN1 + I_IN2 + I_A + I_B + I_C + I_O + I_Q;
    for (int it = gw; it < 2 * I_LAYER; it += NGW) {
        const int l = it / I_LAYER; int r = it % I_LAYER;
        bf16* WinT = (bf16*)(ws + WS_WIN) + (size_t)l * NPROJ * 2048;
        const float* win = P.w_in + (size_t)l * 2048 * IN_COLS; const float* gm = P.g_mix + l * 2048;
        if (r < I_IN1) { p0_transpose_item(win, IN_COLS, 0, 4008, 2048, gm, WinT, 0, scr, r, 128, lane); continue; } r -= I_IN1;
        if (r < I_IN2) { p0_transpose_item(win, IN_COLS, 4008, 6144, 2048, gm, WinT, 4096, scr, r, 192, lane); continue; } r -= I_IN2;
        if (r < I_A) { p0_transpose_item(P.w_a + (size_t)l * 1024 * 2048, 2048, 0, 2048, 1024, nullptr, (bf16*)(ws + WS_WA) + (size_t)l * 2048 * 1024, 0, scr, r, 64, lane); continue; } r -= I_A;
        if (r < I_B) { p0_transpose_item(P.w_b + (size_t)l * 512 * 2048, 2048, 0, 2048, 512, nullptr, (bf16*)(ws + WS_WB) + (size_t)l * 2048 * 512, 0, scr, r, 64, lane); continue; } r -= I_B;
        if (r < I_C) { p0_transpose_item(P.w_c + (size_t)l * 512 * 2048, 2048, 0, 2048, 512, nullptr, (bf16*)(ws + WS_WC) + (size_t)l * 2048 * 512, 0, scr, r, 64, lane); continue; } r -= I_C;
        if (r < I_O) { p0_transpose_item(P.w_out + (size_t)l * 2048 * 2048, 2048, 0, 2048, 2048, nullptr, (bf16*)(ws + WS_WOUT) + (size_t)l * 2048 * 2048, 0, scr, r, 64, lane); continue; } r -= I_O;
        p0_transpose_item(P.w_q + (size_t)l * 2048 * 2048, 2048, 0, 2048, 2048, P.g_ffn + l * 2048, (bf16*)(ws + WS_WQ) + (size_t)l * 2048 * 2048, 0, scr, r, 64, lane);
    }
    for (int it = gw; it < 4 * 16384; it += NGW) {
        const int tb = it >> 14, e = it & 16383, l = tb & 1;
        if (tb < 2) (void)row_to_bf16(P.peer_u + ((size_t)l * 16384 + e) * 2048, P.g_ffn + l * 2048, (bf16*)(ws + WS_U) + ((size_t)l * 16384 + e) * 2048, lane);
        else        (void)row_to_bf16(P.peer_v + ((size_t)l * 16384 + e) * 2048, nullptr, (bf16*)(ws + WS_V) + ((size_t)l * 16384 + e) * 2048, lane);
    }
    float* rowssA = (float*)(ws + WS_ROWSSA);
    for (int m = gw; m < M; m += NGW) { const float ss = row_to_bf16(P.x + (size_t)m * 2048, nullptr, (bf16*)(ws + WS_XB) + (size_t)m * 2048, lane); if (lane == 0) rowssA[m] = ss; }
    float* biasd = (float*)(ws + WS_BIASD);
    for (int i = gw * 64 + lane; i < 32 * 2048; i += NGW * 64) { const int hh = i >> 11, d = i & 2047; biasd[i] = P.rel_bias[rel_bucket(d) * 32 + hh]; }
}
__device__ __forceinline__ void sel_item(const bf16* PA, unsigned long long* MASK, int b_, int t_, LAS unsigned* scr, int lane) {
    const int b = __builtin_amdgcn_readfirstlane(b_), t = __builtin_amdgcn_readfirstlane(t_);
    const int row = b * T + t;
    unsigned long long* mrow = MASK + (size_t)row * 32;
    if (t < 256) {
        if (lane < 32) { const int lo = 64 * lane; unsigned long long m = 0ull; if (t >= lo + 63) m = ~0ull; else if (t >= lo) m = (2ull << (t - lo)) - 1ull; mrow[lane] = m; }
        return;
    }
    const bf16* prow = PA + (size_t)row * PA_LD;
    { const unsigned* qsrc = (const unsigned*)(prow + C_IQ); scr[lane] = qsrc[lane]; scr[64 + lane] = qsrc[64 + lane];
      if (lane < 4) scr[128 + lane] = ((const unsigned*)(prow + C_IW))[lane]; }
    LDS_WAIT(); asm volatile("" ::: "memory");
    float iw[8];
    { const v4u w = *(const LAS v4u*)(scr + 128); iw[0] = bflo(w.x); iw[1] = bfhi(w.x); iw[2] = bflo(w.y); iw[3] = bfhi(w.y); iw[4] = bflo(w.z); iw[5] = bfhi(w.z); iw[6] = bflo(w.w); iw[7] = bfhi(w.w); }
    const int ng = (t >> 6) + 1;
    LAS unsigned* KL = scr + 256;
#pragma unroll 2
    for (int j = 0; j < ng; ++j) {
        const int s = 64 * j + lane;
        const v4u* kp = (const v4u*)(PA + (size_t)(b * T + s) * PA_LD + C_IK);
        const v4u k0 = kp[0], k1 = kp[1], k2 = kp[2], k3 = kp[3];
        float sc = 0.f;
#pragma unroll
        for (int h = 0; h < 8; ++h) { const LAS v4u* qp = (const LAS v4u*)(scr + h * 16);
            float a = dot8(k0, qp[0], 0.f); a = dot8(k1, qp[1], a); a = dot8(k2, qp[2], a); a = dot8(k3, qp[3], a);
            sc = fmaf(iw[h], fmaxf(a, 0.f), sc); }
        KL[s] = (s <= t) ? fkey(sc) : 0u;
    }
    LDS_WAIT(); asm volatile("" ::: "memory");
    unsigned keys[32];
#pragma unroll
    for (int j = 0; j < 32; ++j) keys[j] = (j < ng) ? KL[64 * j + lane] : 0u;
    LDS_WAIT(); asm volatile("" ::: "memory");
    unsigned tau = 0u;
    for (int bit = 31; bit >= 0; --bit) {
        const unsigned cand = tau | (1u << bit); int cnt = 0;
#pragma unroll
        for (int j = 0; j < 32; ++j) cnt += __popcll(__ballot(keys[j] >= cand));
        if (cnt >= 256) tau = cand;
    }
    int need = 256;
#pragma unroll
    for (int j = 0; j < 32; ++j) need -= __popcll(__ballot(keys[j] > tau));
#pragma unroll
    for (int j = 0; j < 32; ++j) {
        const bool e = keys[j] == tau; const unsigned long long eq = __ballot(e), gt = __ballot(keys[j] > tau); const int c = __popcll(eq); unsigned long long take;
        if (c <= need) { take = eq; need -= c; } else { take = __ballot(e && (mbcnt64(eq) < need)); need = 0; }
        if (lane == 0) mrow[j] = gt | take;
    }
    asm volatile("" ::: "memory");
}
__device__ __forceinline__ void cn_item(const bf16* PA, const float* gain, bf16* CN, int row, int lane) {
    const unsigned cv = ((const unsigned*)(PA + (size_t)row * PA_LD + C_CL))[lane];
    const float f0 = bflo(cv), f1 = bfhi(cv);
    const float ss = wave_sum(f0 * f0 + f1 * f1);
    const float r = rsqrtf(ss * (1.0f / 128.0f) + EPS);
    ((unsigned*)(CN + (size_t)row * 128))[lane] = pk2(f0 * r * gain[2 * lane], f1 * r * gain[2 * lane + 1]);
}
__device__ __forceinline__ void kmean_item(const bf16* PA, float* KM, int b, int n, int h, int lane) {
    const bf16* p = PA + (size_t)(b * T + n * 256) * PA_LD + C_KB + h * 64 + lane; float s = 0.f;
#pragma unroll 8
    for (int i = 0; i < 256; ++i) s += bf1(p[(size_t)i * PA_LD]);
    KM[((b * 8 + n) * 8 + h) * 64 + lane] = s * (1.0f / 256.0f);
}
__device__ __forceinline__ void swa_item(const bf16* PA, const float* biasd, const float* sinks, bf16* YA, int b_, int t_, int kvh_, LAS unsigned* scr, int lane) {
    const int b = __builtin_amdgcn_readfirstlane(b_), t = __builtin_amdgcn_readfirstlane(t_), kvh = __builtin_amdgcn_readfirstlane(kvh_);
    const int row = b * T + t;
    const int s0 = t - lane, s1 = t - 64 - lane; const bool v0 = s0 >= 0, v1 = s1 >= 0;
    const v4u* kp0 = (const v4u*)(PA + (size_t)(b * T + (v0 ? s0 : 0)) * PA_LD + C_KA + kvh * 64);
    const v4u* kp1 = (const v4u*)(PA + (size_t)(b * T + (v1 ? s1 : 0)) * PA_LD + C_KA + kvh * 64);
    v4u ka[8], kb[8];
#pragma unroll
    for (int i = 0; i < 8; ++i) { ka[i] = kp0[i]; kb[i] = kp1[i]; }
    float P0[4], P1[4];
#pragma unroll
    for (int g = 0; g < 4; ++g) {
        const int h = kvh * 4 + g;
        if (lane < 32) scr[lane] = ((const unsigned*)(PA + (size_t)row * PA_LD + C_QA + h * 64))[lane];
        LDS_WAIT(); asm volatile("" ::: "memory");
        float a0 = 0.f, a1 = 0.f;
#pragma unroll
        for (int i = 0; i < 8; ++i) { const v4u q = ((const LAS v4u*)scr)[i]; a0 = dot8(ka[i], q, a0); a1 = dot8(kb[i], q, a1); }
        LDS_WAIT(); asm volatile("" ::: "memory");
        const float sc0 = v0 ? a0 * 0.125f + biasd[h * 2048 + lane] : -INFINITY;
        const float sc1 = v1 ? a1 * 0.125f + biasd[h * 2048 + 64 + lane] : -INFINITY;
        const float sk = sinks[h];
        const float mx = fmaxf(wave_max(fmaxf(sc0, sc1)), sk);
        const float p0 = __expf(sc0 - mx), p1 = __expf(sc1 - mx);
        const float den = wave_sum(p0 + p1) + __expf(sk - mx);
        const float inv = 1.0f / den; P0[g] = p0 * inv; P1[g] = p1 * inv;
    }
    float o[4] = {0.f, 0.f, 0.f, 0.f};
    const bf16* vb = PA + (size_t)row * PA_LD + C_VA + kvh * 64 + lane;
    const int nd = (t < 127 ? t : 127) + 1, n0 = nd < 64 ? nd : 64;
#pragma unroll 8
    for (int d = 0; d < n0; ++d) { const float v = bf1(*(vb - (size_t)d * PA_LD));
#pragma unroll
        for (int g = 0; g < 4; ++g) o[g] = fmaf(rdlane(P0[g], d), v, o[g]); }
#pragma unroll 8
    for (int d = 64; d < nd; ++d) { const float v = bf1(*(vb - (size_t)d * PA_LD));
#pragma unroll
        for (int g = 0; g < 4; ++g) o[g] = fmaf(rdlane(P1[g], d - 64), v, o[g]); }
#pragma unroll
    for (int g = 0; g < 4; ++g) YA[(size_t)row * 1024 + (kvh * 4 + g) * 64 + lane] = (bf16)f2bf(o[g]);
}
__device__ __forceinline__ void moba_item(const bf16* PA, const float* biasd, const float* KM, bf16* YB, int b_, int t_, int h_, LAS unsigned* scr, int lane) {
    const int b = __builtin_amdgcn_readfirstlane(b_), t = __builtin_amdgcn_readfirstlane(t_), h = __builtin_amdgcn_readfirstlane(h_);
    const int row = b * T + t, qblk = t >> 8;
    const bf16* qp = PA + (size_t)row * PA_LD + C_QB + h * 64;
    if (lane < 32) scr[lane] = ((const unsigned*)qp)[lane];
    const float ql = bf1(qp[lane]);
    int blk[4] = {0, 1, 2, 3}; int nb = qblk + 1;
    if (qblk > 3) {
        float gv[8];
#pragma unroll
        for (int n = 0; n < 8; ++n) gv[n] = (n < qblk) ? wave_sum(ql * KM[((b * 8 + n) * 8 + h) * 64 + lane]) : -INFINITY;
#pragma unroll
        for (int r = 0; r < 3; ++r) { int bi = 0; float bv = gv[0];
#pragma unroll
            for (int n = 1; n < 8; ++n) if (gv[n] > bv) { bv = gv[n]; bi = n; }
            blk[r] = bi;
#pragma unroll
            for (int n = 0; n < 8; ++n) if (n == bi) gv[n] = -INFINITY; }
        blk[3] = qblk; nb = 4;
    }
    LDS_WAIT(); asm volatile("" ::: "memory");
    v4u q[8];
#pragma unroll
    for (int i = 0; i < 8; ++i) q[i] = ((const LAS v4u*)scr)[i];
    LDS_WAIT(); asm volatile("" ::: "memory");
    float sc[4][4]; float mx = -INFINITY;
    const float* bh = biasd + (16 + h) * 2048;
#pragma unroll
    for (int bi = 0; bi < 4; ++bi)
#pragma unroll
        for (int g = 0; g < 4; ++g) {
            float v = -INFINITY;
            if (bi < nb) { const int s = blk[bi] * 256 + 64 * g + lane;
                if (s <= t) { const v4u* kp = (const v4u*)(PA + (size_t)(b * T + s) * PA_LD + C_KB + h * 64); float a = 0.f;
#pragma unroll
                    for (int i = 0; i < 8; ++i) a = dot8(kp[i], q[i], a);
                    v = a * 0.125f + bh[t - s]; } }
            sc[bi][g] = v; mx = fmaxf(mx, v);
        }
    mx = wave_max(mx);
    float sm = 0.f;
#pragma unroll
    for (int bi = 0; bi < 4; ++bi)
#pragma unroll
        for (int g = 0; g < 4; ++g) { const float p = __expf(sc[bi][g] - mx); sc[bi][g] = p; sm += p; }
    const float inv = 1.0f / wave_sum(sm);
    float o = 0.f;
#pragma unroll
    for (int bi = 0; bi < 4; ++bi) {
        if (bi < nb) {
#pragma unroll
            for (int g = 0; g < 4; ++g) {
                const int sbase = blk[bi] * 256 + 64 * g; int cnt = t - sbase + 1; cnt = cnt > 64 ? 64 : cnt;
                const bf16* vp = PA + (size_t)(b * T + sbase) * PA_LD + C_VB + h * 64 + lane;
#pragma unroll 8
                for (int kk = 0; kk < cnt; ++kk) o = fmaf(rdlane(sc[bi][g], kk), bf1(vp[(size_t)kk * PA_LD]), o);
            }
        }
    }
    YB[(size_t)row * 512 + h * 64 + lane] = (bf16)f2bf(o * inv);
}
__device__ __forceinline__ void dsa_item(const bf16* PA, const bf16* CN, const unsigned long long* MASK, const float* biasd, const float* w_uk, const float* w_uv, bf16* YC, int b_, int t_, LAS unsigned char* scrb, int lane) {
    const int b = __builtin_amdgcn_readfirstlane(b_), t = __builtin_amdgcn_readfirstlane(t_);
    LAS float* qf = (LAS float*)scrb;
    LAS bf16* QA = (LAS bf16*)(scrb + 256);
    LAS unsigned short* list = (LAS unsigned short*)(scrb + 256 + 2048);
    LAS float* OL = (LAS float*)(scrb + 256 + 2048 + 512);
    const int row = b * T + t;
    const bf16* prow = PA + (size_t)row * PA_LD;
#pragma unroll 1
    for (int h = 0; h < 8; ++h) {
        qf[lane] = bf1(prow[C_QC + h * 64 + lane]) * 0.125f;
        LDS_WAIT(); asm volatile("" ::: "memory");
        const f32x4* w0 = (const f32x4*)(w_uk + ((size_t)lane * 8 + h) * 64); const f32x4* w1 = (const f32x4*)(w_uk + ((size_t)(lane + 64) * 8 + h) * 64);
        float a0 = 0.f, a1 = 0.f;
#pragma unroll
        for (int i = 0; i < 16; ++i) { const f32x4 qv = ((const LAS f32x4*)qf)[i]; const f32x4 x0 = w0[i], x1 = w1[i];
            a0 += (qv.x * x0.x + qv.y * x0.y) + (qv.z * x0.z + qv.w * x0.w); a1 += (qv.x * x1.x + qv.y * x1.y) + (qv.z * x1.z + qv.w * x1.w); }
        QA[h * 128 + lane] = (bf16)f2bf(a0); QA[h * 128 + 64 + lane] = (bf16)f2bf(a1);
        LDS_WAIT(); asm volatile("" ::: "memory");
    }
    int nsel = 0;
    { const unsigned long long* mrow = MASK + (size_t)row * 32;
#pragma unroll 4
      for (int j = 0; j < 32; ++j) { const unsigned long long mv = mrow[j];
          const unsigned lo = __builtin_amdgcn_readfirstlane((unsigned)mv), hi = __builtin_amdgcn_readfirstlane((unsigned)(mv >> 32)); const unsigned long long m = ((unsigned long long)hi << 32) | lo;
          if ((m >> lane) & 1ull) list[nsel + mbcnt64(m)] = (unsigned short)(64 * j + lane);
          nsel += __popcll(m); } }
    LDS_WAIT(); asm volatile("" ::: "memory");
    float sc[8][4];
    const float* bh = biasd + 24 * 2048;
#pragma unroll
    for (int g = 0; g < 4; ++g) {
        const int idx = 64 * g + lane; const bool valid = idx < nsel; const int s = valid ? (int)list[idx] : 0;
        v4u c[16];
        if (64 * g < nsel) { const v4u* cp = (const v4u*)(CN + (size_t)(b * T + s) * 128);
#pragma unroll
            for (int i = 0; i < 16; ++i) c[i] = cp[i]; }
        else {
#pragma unroll
            for (int i = 0; i < 16; ++i) c[i] = (v4u){0u, 0u, 0u, 0u}; }
#pragma unroll
        for (int h = 0; h < 8; ++h) { float a = 0.f;
#pragma unroll
            for (int i = 0; i < 16; ++i) a = dot8(c[i], ((const LAS v4u*)(QA + h * 128))[i], a);
            sc[h][g] = valid ? a + bh[h * 2048 + (t - s)] : -INFINITY; }
    }
#pragma unroll
    for (int h = 0; h < 8; ++h) {
        const float mx = wave_max(fmaxf(fmaxf(sc[h][0], sc[h][1]), fmaxf(sc[h][2], sc[h][3])));
        float sm = 0.f;
#pragma unroll
        for (int g = 0; g < 4; ++g) { const float p = __expf(sc[h][g] - mx); sc[h][g] = p; sm += p; }
        const float inv = 1.0f / wave_sum(sm);
#pragma unroll
        for (int g = 0; g < 4; ++g) sc[h][g] *= inv;
    }
    float o0[8], o1[8];
#pragma unroll
    for (int h = 0; h < 8; ++h) { o0[h] = 0.f; o1[h] = 0.f; }
#pragma unroll
    for (int g = 0; g < 4; ++g) {
        int cnt = nsel - 64 * g; cnt = cnt > 64 ? 64 : cnt;
#pragma unroll 4
        for (int kk = 0; kk < cnt; ++kk) {
            const int s = __builtin_amdgcn_readfirstlane((int)list[64 * g + kk]);
            const unsigned cv = ((const unsigned*)(CN + (size_t)(b * T + s) * 128))[lane]; const float c0 = bflo(cv), c1 = bfhi(cv);
#pragma unroll
            for (int h = 0; h < 8; ++h) { const float p = rdlane(sc[h][g], kk); o0[h] = fmaf(p, c0, o0[h]); o1[h] = fmaf(p, c1, o1[h]); }
        }
    }
#pragma unroll
    for (int h = 0; h < 8; ++h) { OL[h * 128 + 2 * lane] = o0[h]; OL[h * 128 + 2 * lane + 1] = o1[h]; }
    LDS_WAIT(); asm volatile("" ::: "memory");
#pragma unroll 1
    for (int h = 0; h < 8; ++h) { float y = 0.f;
#pragma unroll 4
        for (int c4 = 0; c4 < 32; ++c4) { const f32x4 ov = ((const LAS f32x4*)(OL + h * 128))[c4]; const float* wp = w_uv + ((size_t)(4 * c4) * 8 + h) * 64 + lane;
            y = fmaf(ov.x, wp[0], y); y = fmaf(ov.y, wp[512], y); y = fmaf(ov.z, wp[1024], y); y = fmaf(ov.w, wp[1536], y); }
        YC[(size_t)row * 512 + h * 64 + lane] = (bf16)f2bf(y); }
    LDS_WAIT(); asm volatile("" ::: "memory");
}
constexpr int PU_SK = 0, PU_QT = 66048, PU_TS = 82432, PU_TI = 86528, PU_RI = 90624, PU_RG = 107008, PU_END = 123392;
static_assert(PU_END <= RING_BYTES, "PEER unit LDS map");
__device__ __forceinline__ void peer_unit(const Ptrs& P, int l, int unit, LAS unsigned char* lds, int tid, int wave, int lane) {
    LAS float* SK = (LAS float*)(lds + PU_SK);
    LAS float* QT = (LAS float*)(lds + PU_QT);
    LAS float* TS = (LAS float*)(lds + PU_TS);
    LAS int*   TI = (LAS int*)(lds + PU_TI);
    LAS int*   RI = (LAS int*)(lds + PU_RI);
    LAS float* RG = (LAS float*)(lds + PU_RG);
    unsigned char* ws = P.ws;
    const bf16* QP = (const bf16*)(ws + WS_QP);
    const int r0 = unit * 32;
    const float* rowssB = (const float*)(ws + WS_ROWSSB);
    float rstd4[4];
#pragma unroll
    for (int tk = 0; tk < 4; ++tk) { const float pv = lane < 32 ? rowssB[(size_t)(r0 + 4 * wave + tk) * 32 + lane] : 0.f; rstd4[tk] = rsqrtf(wave_sum(pv) * (1.0f / 2048.0f) + EPS); }
#pragma unroll 1
    for (int hp = 0; hp < 16; ++hp) {
        const int h = hp >> 1, p = hp & 1;
        __syncthreads();
        { const float* skg = P.sub_keys + ((size_t)((l * 8 + h) * 2 + p)) * 16384;
#pragma unroll
          for (int j = 0; j < 8; ++j) { const int idx = 4 * (tid + 512 * j); const f32x4 v = *(const f32x4*)(skg + idx); LAS float* dst = SK + (idx >> 7) * 129 + (idx & 127); dst[0] = v.x; dst[1] = v.y; dst[2] = v.z; dst[3] = v.w; }
          const int tok = tid >> 4, d8 = (tid & 15) * 8; const v4u qv = *(const v4u*)(QP + (size_t)(r0 + tok) * 2048 + h * 256 + p * 128 + d8);
          LAS float* dq = QT + tok * 128 + d8; dq[0] = bflo(qv.x); dq[1] = bfhi(qv.x); dq[2] = bflo(qv.y); dq[3] = bfhi(qv.y); dq[4] = bflo(qv.z); dq[5] = bfhi(qv.z); dq[6] = bflo(qv.w); dq[7] = bfhi(qv.w); }
        __syncthreads();
        float a0[4] = {0.f, 0.f, 0.f, 0.f}, a1[4] = {0.f, 0.f, 0.f, 0.f};
        const LAS float* sk0 = SK + lane * 129; const LAS float* sk1 = SK + (lane + 64) * 129;
#pragma unroll 4
        for (int d = 0; d < 128; d += 4) {
            const float s00 = sk0[d], s01 = sk0[d + 1], s02 = sk0[d + 2], s03 = sk0[d + 3], s10 = sk1[d], s11 = sk1[d + 1], s12 = sk1[d + 2], s13 = sk1[d + 3];
#pragma unroll
            for (int tk = 0; tk < 4; ++tk) { const f32x4 q = *(const LAS f32x4*)(QT + (4 * wave + tk) * 128 + d);
                a0[tk] += (q.x * s00 + q.y * s01) + (q.z * s02 + q.w * s03); a1[tk] += (q.x * s10 + q.y * s11) + (q.z * s12 + q.w * s13); }
        }
#pragma unroll
        for (int tk = 0; tk < 4; ++tk) {
            const int tok = 4 * wave + tk;
            a0[tk] *= rstd4[tk]; a1[tk] *= rstd4[tk];
            const unsigned keys[2] = {fkey(a0[tk]), fkey(a1[tk])}; bool sel[2];
            wave_topk_select<2>(keys, 16, sel);
            const unsigned long long m0 = __ballot(sel[0]), m1 = __ballot(sel[1]); const int c0 = __popcll(m0);
            if (sel[0]) { const int pos = mbcnt64(m0); TS[(tok * 2 + p) * 16 + pos] = a0[tk]; TI[(tok * 2 + p) * 16 + pos] = lane; }
            if (sel[1]) { const int pos = c0 + mbcnt64(m1); TS[(tok * 2 + p) * 16 + pos] = a1[tk]; TI[(tok * 2 + p) * 16 + pos] = 64 + lane; }
        }
        if (p == 1) {
            LDS_WAIT(); asm volatile("" ::: "memory");
#pragma unroll
            for (int tk = 0; tk < 4; ++tk) {
                const int tok = 4 * wave + tk, a = lane >> 2;
                const float sa = TS[(tok * 2 + 0) * 16 + a]; const int ia = TI[(tok * 2 + 0) * 16 + a];
                float cs[4]; int ce[4]; unsigned keys[4]; bool sel[4];
#pragma unroll
                for (int j = 0; j < 4; ++j) { const int bb = 4 * (lane & 3) + j; cs[j] = sa + TS[(tok * 2 + 1) * 16 + bb]; ce[j] = ia * 128 + TI[(tok * 2 + 1) * 16 + bb]; keys[j] = fkey(cs[j]); }
                wave_topk_select<4>(keys, 16, sel);
                int base = 0;
#pragma unroll
                for (int j = 0; j < 4; ++j) { const unsigned long long m = __ballot(sel[j]); if (sel[j]) { const int pos = base + mbcnt64(m); RI[tok * 128 + h * 16 + pos] = ce[j]; RG[tok * 128 + h * 16 + pos] = cs[j]; } base += __popcll(m); }
                LDS_WAIT(); asm volatile("" ::: "memory");
                const float s = RG[tok * 128 + h * 16 + (lane & 15)];
                float mx = s;
#pragma unroll
                for (int o = 1; o < 16; o <<= 1) mx = fmaxf(mx, __shfl_xor(mx, o));
                const float e = __expf(s - mx); float sm = e;
#pragma unroll
                for (int o = 1; o < 16; o <<= 1) sm += __shfl_xor(sm, o);
                LDS_WAIT(); asm volatile("" ::: "memory");
                if (lane < 16) RG[tok * 128 + h * 16 + lane] = e / sm;
            }
        }
    }
    LDS_WAIT(); asm volatile("" ::: "memory");
    const bf16* U = (const bf16*)(ws + WS_U) + (size_t)l * 16384 * 2048; const bf16* V = (const bf16*)(ws + WS_V) + (size_t)l * 16384 * 2048;
    bf16* XB = (bf16*)(ws + WS_XB); float* rowssA = (float*)(ws + WS_ROWSSA);
#pragma unroll 1
    for (int tk = 0; tk < 4; ++tk) {
        const int tok = 4 * wave + tk, row = r0 + tok;
        const float rstd = tk == 0 ? rstd4[0] : tk == 1 ? rstd4[1] : tk == 2 ? rstd4[2] : rstd4[3];
        v4u xq[4];
#pragma unroll
        for (int i = 0; i < 4; ++i) xq[i] = ((const v4u*)(XB + (size_t)row * 2048))[lane + 64 * i];
#pragma unroll 1
        for (int k0 = 0; k0 < 128; k0 += 4) {
            v4u uv[4][4];
#pragma unroll
            for (int kk = 0; kk < 4; ++kk) { const int e = __builtin_amdgcn_readfirstlane(RI[tok * 128 + k0 + kk]); const v4u* up = (const v4u*)(U + (size_t)e * 2048) + lane;
#pragma unroll
                for (int i = 0; i < 4; ++i) uv[kk][i] = up[64 * i]; }
            float dsum[4];
#pragma unroll
            for (int kk = 0; kk < 4; ++kk) { float d = 0.f;
#pragma unroll
                for (int i = 0; i < 4; ++i) d = dot8(uv[kk][i], xq[i], d);
                dsum[kk] = d; }
#pragma unroll
            for (int o = 1; o < 64; o <<= 1) {
#pragma unroll
                for (int kk = 0; kk < 4; ++kk) dsum[kk] += __shfl_xor(dsum[kk], o); }
            if (lane < 4) { const float d = lane == 0 ? dsum[0] : lane == 1 ? dsum[1] : lane == 2 ? dsum[2] : dsum[3];
                const float g = RG[tok * 128 + k0 + lane]; RG[tok * 128 + k0 + lane] = g * gelu_tanh(d * rstd); }
        }
        LDS_WAIT(); asm volatile("" ::: "memory");
        float o[32];
#pragma unroll
        for (int i = 0; i < 32; ++i) o[i] = 0.f;
#pragma unroll 1
        for (int k0 = 0; k0 < 128; k0 += 4) {
            v4u vv[4][4]; float w[4];
#pragma unroll
            for (int kk = 0; kk < 4; ++kk) { const int e = __builtin_amdgcn_readfirstlane(RI[tok * 128 + k0 + kk]); const v4u* vp = (const v4u*)(V + (size_t)e * 2048) + lane; w[kk] = RG[tok * 128 + k0 + kk];
#pragma unroll
                for (int i = 0; i < 4; ++i) vv[kk][i] = vp[64 * i]; }
#pragma unroll
            for (int kk = 0; kk < 4; ++kk)
#pragma unroll
                for (int i = 0; i < 4; ++i) { const v4u t4 = vv[kk][i]; const float wk = w[kk];
                    o[8 * i + 0] = fmaf(wk, bflo(t4.x), o[8 * i + 0]); o[8 * i + 1] = fmaf(wk, bfhi(t4.x), o[8 * i + 1]); o[8 * i + 2] = fmaf(wk, bflo(t4.y), o[8 * i + 2]); o[8 * i + 3] = fmaf(wk, bfhi(t4.y), o[8 * i + 3]);
                    o[8 * i + 4] = fmaf(wk, bflo(t4.z), o[8 * i + 4]); o[8 * i + 5] = fmaf(wk, bfhi(t4.z), o[8 * i + 5]); o[8 * i + 6] = fmaf(wk, bflo(t4.w), o[8 * i + 6]); o[8 * i + 7] = fmaf(wk, bfhi(t4.w), o[8 * i + 7]); }
        }
        float* xr = P.out + (size_t)row * 2048; float ss = 0.f;
#pragma unroll
        for (int i = 0; i < 4; ++i) { const int e0 = 8 * (lane + 64 * i); const f32x4 xa = *(const f32x4*)(xr + e0), xb4 = *(const f32x4*)(xr + e0 + 4);
            o[8 * i + 0] += xa.x; o[8 * i + 1] += xa.y; o[8 * i + 2] += xa.z; o[8 * i + 3] += xa.w; o[8 * i + 4] += xb4.x; o[8 * i + 5] += xb4.y; o[8 * i + 6] += xb4.z; o[8 * i + 7] += xb4.w;
#pragma unroll
            for (int j = 0; j < 8; ++j) ss += o[8 * i + j] * o[8 * i + j]; }
        ss = wave_sum(ss);
        if (l == DEPTH - 1) {
            const float rf = rsqrtf(ss * (1.0f / 2048.0f) + EPS);
#pragma unroll
            for (int i = 0; i < 4; ++i) { const int e0 = 8 * (lane + 64 * i); const f32x4 ga = *(const f32x4*)(P.g_final + e0), gb = *(const f32x4*)(P.g_final + e0 + 4);
                *(f32x4*)(xr + e0) = (f32x4){o[8 * i + 0] * rf * ga.x, o[8 * i + 1] * rf * ga.y, o[8 * i + 2] * rf * ga.z, o[8 * i + 3] * rf * ga.w};
                *(f32x4*)(xr + e0 + 4) = (f32x4){o[8 * i + 4] * rf * gb.x, o[8 * i + 5] * rf * gb.y, o[8 * i + 6] * rf * gb.z, o[8 * i + 7] * rf * gb.w}; }
        } else {
#pragma unroll
            for (int i = 0; i < 4; ++i) { const int e0 = 8 * (lane + 64 * i);
                *(f32x4*)(xr + e0) = (f32x4){o[8 * i + 0], o[8 * i + 1], o[8 * i + 2], o[8 * i + 3]}; *(f32x4*)(xr + e0 + 4) = (f32x4){o[8 * i + 4], o[8 * i + 5], o[8 * i + 6], o[8 * i + 7]};
                v4u pk; pk.x = pk2(o[8 * i + 0], o[8 * i + 1]); pk.y = pk2(o[8 * i + 2], o[8 * i + 3]); pk.z = pk2(o[8 * i + 4], o[8 * i + 5]); pk.w = pk2(o[8 * i + 6], o[8 * i + 7]);
                ((v4u*)(XB + (size_t)row * 2048))[lane + 64 * i] = pk; }
            if (lane == 0) rowssA[row] = ss;
        }
    }
}
#ifndef MK_PER_PHASE
#define MK_PER_PHASE 0
#endif
struct Args { const float* in[18]; float* out; unsigned char* ws; int ph_lo, ph_hi; };
__global__ void __launch_bounds__(NWAVES * 64, 2) mega_fwd(Args args) {
    extern __shared__ __attribute__((aligned(16))) unsigned char lds_raw[];
    LAS unsigned char* lds = (LAS unsigned char*)lds_raw;
    const int tid0 = threadIdx.x, lane0 = tid0 & 63, wave = __builtin_amdgcn_readfirstlane(tid0 >> 6);
    const int G = gridDim.x, bx = blockIdx.x; const int vcu = (G % 8 == 0) ? (bx % 8) * (G / 8) + bx / 8 : bx;
    const int gw = vcu * NWAVES + wave, NGW = G * NWAVES;
    Ptrs P;
    P.x = args.in[0]; P.rel_bias = args.in[1]; P.g_mix = args.in[2]; P.w_in = args.in[3]; P.a_sinks = args.in[4]; P.c_gain = args.in[5]; P.w_uk = args.in[6]; P.w_uv = args.in[7];
    P.w_a = args.in[8]; P.w_b = args.in[9]; P.w_c = args.in[10]; P.w_out = args.in[11]; P.g_ffn = args.in[12]; P.w_q = args.in[13]; P.sub_keys = args.in[14]; P.peer_u = args.in[15]; P.peer_v = args.in[16]; P.g_final = args.in[17];
    P.out = args.out; P.ws = args.ws;
    unsigned char* ws = args.ws;
    gu32* ctl = (gu32*)(ws + WS_CTL);
    for (int u = tid0; u < (LDS_BYTES - LDSCTL_OFF) / 4; u += NWAVES * 64) ((LAS unsigned*)(lds + LDSCTL_OFF))[u] = 0u;
    __syncthreads();
    volatile LAS unsigned* MISC = (volatile LAS unsigned*)(lds + MISC_OFF);
    XcdBarrier bar; bar.bar = (unsigned*)(ctl + CW_BAR); bar.x = 0; bar.st = nullptr;
    if (!MK_PER_PHASE) bar = xcd_barrier_post((unsigned*)(ctl + CW_BAR), MISC + 8);
    const int lo = args.ph_lo, hi = args.ph_hi;
#ifndef PH_MASK
#define PH_MASK 0xffff
#endif
#define IN(k) (lo <= (k) && (k) < hi)
#define EN(j) ((PH_MASK >> (j)) & 1)
#define SEAM(k) do { if (IN(k) && IN((k) + 1)) xcd_barrier(bar); } while (0)
    bf16* XB = (bf16*)(ws + WS_XB); bf16* PA = (bf16*)(ws + WS_PA); bf16* GT = (bf16*)(ws + WS_GT); bf16* MG = (bf16*)(ws + WS_MG); bf16* QP = (bf16*)(ws + WS_QP);
    bf16* YA = (bf16*)(ws + WS_YA); bf16* YB = (bf16*)(ws + WS_YB); bf16* YC = (bf16*)(ws + WS_YC); bf16* CN = (bf16*)(ws + WS_CN);
    unsigned long long* MASK = (unsigned long long*)(ws + WS_MASK);
    float* rowssA = (float*)(ws + WS_ROWSSA); float* KM = (float*)(ws + WS_KMEAN); const float* biasd = (const float*)(ws + WS_BIASD);
    LAS unsigned char* wscr = lds + wave * 16384;

#define FRESH() int lane = lane0, tid = tid0; asm volatile("" : "+v"(lane), "+v"(tid)); (void)tid
    if (EN(0) && IN(0)) { FRESH(); p0_prologue(P, lds, gw, NGW, wave, lane); }
    SEAM(0);
#pragma unroll 1
    for (int l = 0; l < DEPTH; ++l) {
        const int pb = 1 + 7 * l;
        float* rowssB = (float*)(ws + WS_ROWSSB);
        if (EN(1) && IN(pb + 0)) {
            pg8::Gemm g{XB, (const bf16*)(ws + WS_WIN) + (size_t)l * NPROJ * 2048, M, NPROJ, 2048}; pg8::StaticOrder S; S.init(M, NPROJ, G, bx);
            pg8::EpiProj E{PA, GT, rowssA};
            pg8::gemm_phase<pg8::EpiProj, pg8::StaticOrder, true, true>(lds, g, S, E);
        }
        SEAM(pb + 0);
        if (EN(2) && IN(pb + 1)) { FRESH();
            for (int i = gw; i < M; i += NGW) sel_item(PA, MASK, i & 7, i >> 3, (LAS unsigned*)wscr, lane);
            for (int i = gw; i < M; i += NGW) cn_item(PA, P.c_gain + l * 128, CN, i, lane);
            for (int i = gw; i < 512; i += NGW) kmean_item(PA, KM, i >> 6, (i >> 3) & 7, i & 7, lane);
            for (int i = gw; i < M * 4; i += NGW) swa_item(PA, biasd, P.a_sinks + l * 16, YA, (i >> 2) & 7, i >> 5, i & 3, (LAS unsigned*)wscr, lane);
        }
        SEAM(pb + 1);
        if (EN(3) && IN(pb + 2)) { FRESH();
            for (int i = gw; i < M; i += NGW) dsa_item(PA, CN, MASK, biasd, P.w_uk + (size_t)l * 65536, P.w_uv + (size_t)l * 65536, YC, i & 7, i >> 3, wscr, lane);
            for (int i = gw; i < M * 8; i += NGW) moba_item(PA, biasd, KM, YB, (i >> 3) & 7, i >> 6, i & 7, (LAS unsigned*)wscr, lane);
        }
        SEAM(pb + 2);
        if (EN(4) && IN(pb + 3)) {
            pg8::StaticOrder S; S.init(M, 2048, G, bx);
#pragma unroll 1
            for (int br = 0; br < 3; ++br) {
                const bf16* Ab = br == 0 ? YA : br == 1 ? YB : YC; const int Kb = br == 0 ? 1024 : 512;
                const bf16* Wb = br == 0 ? (const bf16*)(ws + WS_WA) + (size_t)l * 2048 * 1024 : br == 1 ? (const bf16*)(ws + WS_WB) + (size_t)l * 2048 * 512 : (const bf16*)(ws + WS_WC) + (size_t)l * 2048 * 512;
                pg8::Gemm g{Ab, Wb, M, 2048, Kb}; pg8::EpiGate E{MG, GT, 2048 * br, br == 0 ? 1 : 0};
                pg8::gemm_phase<pg8::EpiGate, pg8::StaticOrder, true, true>(lds, g, S, E);
            }
        }
        SEAM(pb + 3);
        if (EN(5) && IN(pb + 4)) {
            pg8::Gemm g{MG, (const bf16*)(ws + WS_WOUT) + (size_t)l * 2048 * 2048, M, 2048, 2048}; pg8::StaticOrder S; S.init(M, 2048, G, bx);
            pg8::EpiResid E{l == 0 ? P.x : P.out, P.out, XB, rowssB};
            pg8::gemm_phase<pg8::EpiResid, pg8::StaticOrder, true, true>(lds, g, S, E);
        }
        SEAM(pb + 4);
        if (EN(6) && IN(pb + 5)) {
            pg8::Gemm g{XB, (const bf16*)(ws + WS_WQ) + (size_t)l * 2048 * 2048, M, 2048, 2048}; pg8::StaticOrder S; S.init(M, 2048, G, bx);
            pg8::EpiQ E{QP};
            pg8::gemm_phase<pg8::EpiQ, pg8::StaticOrder, true, true>(lds, g, S, E);
        }
        SEAM(pb + 5);
        if (EN(7) && IN(pb + 6)) { FRESH();
            for (int u = vcu; u < M / 32; u += G) peer_unit(P, l, u, lds, tid, wave, lane);
            __syncthreads();
        }
        SEAM(pb + 6);
    }
#undef IN
#undef SEAM
}

extern "C" void kernel_launch(void* const* d_in, const int* in_sizes, int n_in, void* d_out, int out_size, void* d_ws, size_t ws_size, hipStream_t stream) {
    static int grid = 0;
    if (grid == 0) {
        if (n_in != 18 || out_size != M * D || ws_size < WS_END) { fprintf(stderr, "kernel_launch: unexpected problem (n_in %d, out %d, ws %zu); nothing launched\n", n_in, out_size, ws_size); grid = -1; return; }
        int dev = 0, cus = 0, per_cu = 0;
        if (hipGetDevice(&dev) != hipSuccess || hipDeviceGetAttribute(&cus, hipDeviceAttributeMultiprocessorCount, dev) != hipSuccess) { grid = -1; return; }
        if (hipFuncSetAttribute((const void*)mega_fwd, hipFuncAttributeMaxDynamicSharedMemorySize, LDS_BYTES) != hipSuccess) { fprintf(stderr, "kernel_launch: hipFuncSetAttribute failed\n"); grid = -1; return; }
        if (hipOccupancyMaxActiveBlocksPerMultiprocessor(&per_cu, (const void*)mega_fwd, NWAVES * 64, LDS_BYTES) != hipSuccess || per_cu < 1) { fprintf(stderr, "kernel_launch: occupancy query reports %d workgroups per CU\n", per_cu); }
        (void)hipGetLastError();
        grid = cus;
    }
    if (grid < 0) return;
    if (hipMemsetAsync((char*)d_ws + WS_CTL, 0, CTL_ZERO_BYTES, stream) != hipSuccess) { fprintf(stderr, "kernel_launch: hipMemsetAsync failed\n"); return; }
    Args a{};
    for (int i = 0; i < 18; ++i) a.in[i] = (const float*)d_in[i];
    a.out = (float*)d_out; a.ws = (unsigned char*)d_ws;
#if MK_PER_PHASE
    for (int p = 0; p < NPHASE; ++p) { a.ph_lo = p; a.ph_hi = p + 1; hipLaunchKernelGGL(mega_fwd, dim3(grid), dim3(NWAVES * 64), LDS_BYTES, stream, a); }
#else
    a.ph_lo = 0; a.ph_hi = NPHASE;
    hipLaunchKernelGGL(mega_fwd, dim3(grid), dim3(NWAVES * 64), LDS_BYTES, stream, a);
#endif
    const hipError_t le = hipPeekAtLastError();
    if (le != hipSuccess) fprintf(stderr, "kernel_launch: launch failed: %s\n", hipGetErrorName(le));
}
```

```cpp
#include <hip/hip_runtime.h>
#include <cstdio>
#include <cstdint>
__device__ __forceinline__ int lane_id_() { return (int)__builtin_amdgcn_mbcnt_hi(~0u, __builtin_amdgcn_mbcnt_lo(~0u, 0u)); }
template <int K> __device__ __forceinline__ float lane_xor(float v) {
    static_assert(K == 1 || K == 2 || K == 4 || K == 8 || K == 16, "lane_xor: 1, 2, 4, 8, 16");
    if constexpr (K == 16) return __builtin_bit_cast(float, __builtin_amdgcn_ds_swizzle(__builtin_bit_cast(int, v), (16 << 10) | 0x1F));
    else return __builtin_bit_cast(float, __builtin_amdgcn_mov_dpp(__builtin_bit_cast(int, v), K == 1 ? 0xB1 : K == 2 ? 0x4E : K == 4 ? 0x124 : 0x128, 0xF, 0xF, true));
}
__device__ __forceinline__ float half_sum(float v) { const unsigned u = __builtin_bit_cast(unsigned, v); auto rr = __builtin_amdgcn_permlane32_swap(u, u, false, false); return __builtin_bit_cast(float, (unsigned)rr[0]) + __builtin_bit_cast(float, (unsigned)rr[1]); }
__device__ __forceinline__ float half_max(float v) { const unsigned u = __builtin_bit_cast(unsigned, v); auto rr = __builtin_amdgcn_permlane32_swap(u, u, false, false); return fmaxf(__builtin_bit_cast(float, (unsigned)rr[0]), __builtin_bit_cast(float, (unsigned)rr[1])); }
namespace pg8 {
#define PG8_LAS __attribute__((address_space(3)))
typedef unsigned short bf16_t;
typedef short bf16x8 __attribute__((ext_vector_type(8)));
typedef float f32x4 __attribute__((ext_vector_type(4)));
typedef unsigned u32x4 __attribute__((ext_vector_type(4)));
constexpr int BM = 256, BK = 64, HALF = 128, HTB = HALF * BK * 2  , STAGE_BYTES = 8 * HTB, NXCD = 8, WGM = 8;

__host__ __device__ __forceinline__ int lds_byte(int r, int c) { const int st = (r >> 4) * 2 + (c >> 5), rr = r & 15, cc = c & 31, ob = rr * 64 + cc * 2; return st * 1024 + (ob ^ (((ob >> 9) & 1) << 5)); }
__host__ __device__ __forceinline__ void stage_rc(int b, int& R, int& C) { const int st = b / 1024, sb = b % 1024, swz = sb ^ (((sb >> 9) & 1) << 5); R = (st >> 1) * 16 + swz / 64; C = (st & 1) * 32 + (swz % 64) / 2; }
__host__ __device__ __forceinline__ int perm32(int rho) { const int n = rho >> 4, i = rho & 15; return 8 * (i >> 2) + 4 * n + (i & 3); }

struct Unit { int pm, pn; };
struct Gemm { const bf16_t* A; const bf16_t* Bt; int M, N, K; };

struct StaticOrder {
    int nM, nN, nwg, G, c;
    __host__ __device__ void init(int M, int N, int G_, int c_) { nM = M / BM; nN = N / BM; nwg = nM * nN; G = G_; c = c_; }
    __host__ __device__ bool next(int i, Unit& u) const {
        const long L = (long)i * G + c; if (L >= nwg) return false;
        int wgid = (int)L; { const int q = nwg / NXCD, r = nwg % NXCD, xcd = wgid % NXCD, off = wgid / NXCD; wgid = (xcd < r ? xcd * (q + 1) : r * (q + 1) + (xcd - r) * q) + off; }
        const int nig = WGM * nN, gid = wgid / nig, fm = gid * WGM, gsz = (nM - fm) < WGM ? (nM - fm) : WGM;
        u.pm = fm + ((wgid % nig) % gsz); u.pn = (wgid % nig) / gsz; return true;
    }
    __device__ __forceinline__ void a_ready(const Unit&) const {}
    __device__ __forceinline__ void done(const Unit&) const {}
};

struct SplitOrder {
    int x, j, G, c; bool bf;
    __host__ __device__ void init(int G_, int c_, bool bf_) { G = G_; c = c_; x = c_ & 7; j = c_ >> 3; bf = bf_; }
    __host__ __device__ bool next(int i, Unit& u) const {
        const int ncol = bf ? 6 : 34; int pm, pk;
        if (G == 256) { const int nA = bf ? 2 : 8, nB = bf ? 0 : 10; const int cnt = j < 24 ? nA : nB; if (i >= cnt) return false;
            const int t = (j < 24 ? nA * j : 24 * nA + nB * (j - 24)) + i; pm = 8 * x + (t & 7); pk = t >> 3; }
        else { const long t = (long)i * G + c; if (t >= 64L * ncol) return false; pm = (int)(t & 63); pk = (int)(t >> 6); }
        u.pm = pm; u.pn = bf ? (pk < 4 ? 6 + pk : 10 + pk) : (pk < 6 ? pk : pk < 10 ? pk + 4 : pk + 6);
        return true;
    }
    __device__ __forceinline__ void a_ready(const Unit&) const {}
    __device__ __forceinline__ void done(const Unit&) const {}
};

typedef float f32x2c __attribute__((ext_vector_type(2))); typedef __bf16 bf16x2c __attribute__((ext_vector_type(2)));
__device__ __forceinline__ unsigned cvt_pk_bf16(float lo, float hi) { const f32x2c v = {lo, hi}; return __builtin_bit_cast(unsigned, __builtin_convertvector(v, bf16x2c)); }
typedef float f32x2 __attribute__((ext_vector_type(2)));
typedef unsigned u32x2 __attribute__((ext_vector_type(2)));
__device__ __forceinline__ float bf_lo(unsigned u) { return __builtin_bit_cast(float, u << 16); }
__device__ __forceinline__ float bf_hi(unsigned u) { return __builtin_bit_cast(float, u & 0xffff0000u); }
__device__ __forceinline__ float sigmoidf_(float v) { return 1.0f / (1.0f + __expf(-v)); }

__device__ __forceinline__ void rstd8(const float* rowss, int row0, float scale, float (&rsv)[8]) {
#pragma unroll
    for (int h = 0; h < 2; ++h) {
#pragma unroll
        for (int m = 0; m < 4; ++m) { const int row = row0 + h * HALF + m * 16; const f32x4* rp = (const f32x4*)(rowss + (size_t)row * 16); const f32x4 a = rp[0], b = rp[1];
            const float rsum = ((a[0] + a[1]) + (a[2] + a[3])) + ((b[0] + b[1]) + (b[2] + b[3]));
            rsv[4 * h + m] = rsqrtf(rsum * (1.0f / 2048.0f) + 1e-6f) * scale; }
        asm volatile("" ::: "memory"); }
}
struct EpiProj {
    static constexpr bool PERM = true, AFTER_DRAIN = false, MIDK = false;
    bf16_t* PA; float* KMS; const float* rowss;
    __device__ __forceinline__ void operator()(const f32x4 (&acc)[2][2][4][2], const Unit& u, int wr, int wc, int fr, int fq) const {
        asm volatile("" : "+v"(fr), "+v"(fq));
        const int row0 = u.pm * BM + wr * 64 + fr;
        const int col0 = u.pn * BM + wc * 32 + 8 * fq;
        float rsv[8]; rstd8(rowss, row0, 1.0f, rsv);
#pragma unroll
        for (int ai = 0; ai < 2; ++ai)
#pragma unroll
            for (int m = 0; m < 4; ++m) { const int row = row0 + ai * HALF + m * 16;
                const float rs = rsv[4 * ai + m];
                bf16_t* rowp = PA + (size_t)row * 4096 + col0;
#pragma unroll
                for (int bj = 0; bj < 2; ++bj) { const f32x4 v0 = acc[ai][bj][m][0] * rs, v1 = acc[ai][bj][m][1] * rs;
                    u32x4 w; w.x = cvt_pk_bf16(v0[0], v0[1]); w.y = cvt_pk_bf16(v0[2], v0[3]); w.z = cvt_pk_bf16(v1[0], v1[1]); w.w = cvt_pk_bf16(v1[2], v1[3]);
                    *(u32x4*)(rowp + bj * HALF) = w; } }
        if ((u.pn == 8) || (u.pn == 9)) {
            float* kp = KMS + (size_t)u.pm * 512 + (u.pn - 8) * BM + wc * 32 + 8 * fq;
#pragma unroll
            for (int bj = 0; bj < 2; ++bj)
#pragma unroll
                for (int n = 0; n < 2; ++n) { f32x4 cs = (f32x4){0.f, 0.f, 0.f, 0.f};
#pragma unroll
                    for (int ai = 0; ai < 2; ++ai)
#pragma unroll
                        for (int m = 0; m < 4; ++m) cs = cs + acc[ai][bj][m][n] * rsv[4 * ai + m];
#pragma unroll
                    for (int e = 0; e < 4; ++e) { float v = cs[e];
                        v += lane_xor<1>(v); v += lane_xor<2>(v); v += lane_xor<4>(v); v += lane_xor<8>(v);
                        if (fr == 0) atomicAdd(kp + bj * HALF + 4 * n + e, v); } }
        }
    }
};
struct EpiGate3 {
    static constexpr bool PERM = true, AFTER_DRAIN = false, MIDK = true;
    static constexpr int KB1 = 8, KB2 = 12;
    unsigned char* MG; const unsigned char* GT;
    static __device__ __forceinline__ float fl(float g) { return fmaxf(g, 2.4318695068359375e-04f); }
    static __device__ __forceinline__ float b0(unsigned w) { return (float)(w & 0xffu); }
    static __device__ __forceinline__ float b1(unsigned w) { return (float)((w >> 8) & 0xffu); }
    static __device__ __forceinline__ float b2(unsigned w) { return (float)((w >> 16) & 0xffu); }
    static __device__ __forceinline__ float b3(unsigned w) { return (float)(w >> 24); }
    __device__ __forceinline__ void mid(f32x4 (&acc)[2][2][4][2], const Unit& u, int t, int wr, int wc, int fr, int fq) const {
        asm volatile("" : "+v"(fr), "+v"(fq));
        const int gnum = (t == KB1) ? 0 : 2048;
        const int row0 = u.pm * BM + wr * 64 + fr; const int col0 = u.pn * BM + wc * 32 + 8 * fq;
        u32x2 nv[2][4][2], dv[2][4][2];
#pragma unroll
        for (int ai = 0; ai < 2; ++ai)
#pragma unroll
            for (int m = 0; m < 4; ++m) { const unsigned char* gp = GT + (size_t)(row0 + ai * HALF + m * 16) * 6144 + gnum + col0;
#pragma unroll
                for (int bj = 0; bj < 2; ++bj) { nv[ai][m][bj] = *(const u32x2*)(gp + bj * HALF); dv[ai][m][bj] = *(const u32x2*)(gp + 2048 + bj * HALF); } }
#pragma unroll
        for (int ai = 0; ai < 2; ++ai) {
#pragma unroll
            for (int m = 0; m < 4; ++m)
#pragma unroll
                for (int bj = 0; bj < 2; ++bj) { const u32x2 n_ = nv[ai][m][bj], d_ = dv[ai][m][bj];
                    const f32x4 r0 = (f32x4){fl(b0(n_.x)) * __builtin_amdgcn_rcpf(fl(b0(d_.x))), fl(b1(n_.x)) * __builtin_amdgcn_rcpf(fl(b1(d_.x))), fl(b2(n_.x)) * __builtin_amdgcn_rcpf(fl(b2(d_.x))), fl(b3(n_.x)) * __builtin_amdgcn_rcpf(fl(b3(d_.x)))};
                    const f32x4 r1 = (f32x4){fl(b0(n_.y)) * __builtin_amdgcn_rcpf(fl(b0(d_.y))), fl(b1(n_.y)) * __builtin_amdgcn_rcpf(fl(b1(d_.y))), fl(b2(n_.y)) * __builtin_amdgcn_rcpf(fl(b2(d_.y))), fl(b3(n_.y)) * __builtin_amdgcn_rcpf(fl(b3(d_.y)))};
                    acc[ai][bj][m][0] = acc[ai][bj][m][0] * r0; acc[ai][bj][m][1] = acc[ai][bj][m][1] * r1; }
            asm volatile("" ::: "memory");
        }
    }
    __device__ __forceinline__ void operator()(const f32x4 (&acc)[2][2][4][2], const Unit& u, int wr, int wc, int fr, int fq) const {
        asm volatile("" : "+v"(fr), "+v"(fq));
        const int row0 = u.pm * BM + wr * 64 + fr; const int col0 = u.pn * BM + wc * 32 + 8 * fq;
        constexpr float GS = 0.0078125f / 255.0f;
#pragma unroll
        for (int ai = 0; ai < 2; ++ai)
#pragma unroll
            for (int m = 0; m < 4; ++m) { const int row = row0 + ai * HALF + m * 16;
                const unsigned char* gp = GT + (size_t)row * 6144 + 4096 + col0; unsigned char* op = MG + (size_t)row * 2048 + col0;
#pragma unroll
                for (int bj = 0; bj < 2; ++bj) { const u32x2 gv = *(const u32x2*)(gp + bj * HALF);
                    const f32x4 v0 = acc[ai][bj][m][0] * ((f32x4){fl(b0(gv.x)), fl(b1(gv.x)), fl(b2(gv.x)), fl(b3(gv.x))} * GS);
                    const f32x4 v1 = acc[ai][bj][m][1] * ((f32x4){fl(b0(gv.y)), fl(b1(gv.y)), fl(b2(gv.y)), fl(b3(gv.y))} * GS);
                    int w0 = __builtin_amdgcn_cvt_pk_fp8_f32(v0[0], v0[1], 0, false); w0 = __builtin_amdgcn_cvt_pk_fp8_f32(v0[2], v0[3], w0, true);
                    int w1 = __builtin_amdgcn_cvt_pk_fp8_f32(v1[0], v1[1], 0, false); w1 = __builtin_amdgcn_cvt_pk_fp8_f32(v1[2], v1[3], w1, true);
                    u32x2 w; w.x = (unsigned)w0; w.y = (unsigned)w1; *(u32x2*)(op + bj * HALF) = w; }
                asm volatile("" ::: "memory"); }
    }
};
struct EpiIn8 {
    static constexpr bool PERM = true, AFTER_DRAIN = false, MIDK = false;
    bf16_t* PA; unsigned char* GT; const float* rowss;
    static __device__ __forceinline__ float g255(float v) { return __builtin_rintf(255.0f * __builtin_amdgcn_rcpf(1.0f + __expf(-v))); }
    static __device__ __forceinline__ unsigned pk4(const f32x4& v) { unsigned w = __builtin_amdgcn_cvt_pk_u8_f32(g255(v[0]), 0, 0u); w = __builtin_amdgcn_cvt_pk_u8_f32(g255(v[1]), 1, w); w = __builtin_amdgcn_cvt_pk_u8_f32(g255(v[2]), 2, w); return __builtin_amdgcn_cvt_pk_u8_f32(g255(v[3]), 3, w); }
    __device__ __forceinline__ void operator()(const f32x4 (&acc)[2][2][4][2], const Unit& u, int wr, int wc, int fr, int fq) const {
        asm volatile("" : "+v"(fr), "+v"(fq));
        const bool gate = u.pn >= 16;
        const int row0 = u.pm * BM + wr * 64 + fr; const int col0 = (gate ? u.pn - 16 : u.pn) * BM + wc * 32 + 8 * fq;
        float rsv[8]; rstd8(rowss, row0, 0.00390625f, rsv);
#pragma unroll
        for (int ai = 0; ai < 2; ++ai)
#pragma unroll
            for (int m = 0; m < 4; ++m) { const int row = row0 + ai * HALF + m * 16;
                const float rs = rsv[4 * ai + m];
                if (gate) { unsigned char* rowp = GT + (size_t)row * 6144 + col0;
#pragma unroll
                    for (int bj = 0; bj < 2; ++bj) { const f32x4 v0 = acc[ai][bj][m][0] * rs, v1 = acc[ai][bj][m][1] * rs;
                        u32x2 w; w.x = pk4(v0); w.y = pk4(v1);
                        *(u32x2*)(rowp + bj * HALF) = w; } }
                else { bf16_t* rowp = PA + (size_t)row * 4096 + col0;
#pragma unroll
                    for (int bj = 0; bj < 2; ++bj) { const f32x4 v0 = acc[ai][bj][m][0] * rs, v1 = acc[ai][bj][m][1] * rs;
                        u32x4 w; w.x = cvt_pk_bf16(v0[0], v0[1]); w.y = cvt_pk_bf16(v0[2], v0[3]); w.z = cvt_pk_bf16(v1[0], v1[1]); w.w = cvt_pk_bf16(v1[2], v1[3]);
                        *(u32x4*)(rowp + bj * HALF) = w; } } }
    }
};
struct EpiResid {
    static constexpr bool PERM = false, AFTER_DRAIN = false, MIDK = false;
    bf16_t* xb; float* rowss; float ascale;
    __device__ __forceinline__ void operator()(const f32x4 (&acc)[2][2][4][2], const Unit& u, int wr, int wc, int fr, int fq) const {
        const int col0 = u.pn * BM + wc * 32 + 4 * fq;
#pragma unroll
        for (int ai = 0; ai < 2; ++ai)
#pragma unroll
            for (int m = 0; m < 4; ++m) { const int r = u.pm * BM + ai * HALF + wr * 64 + m * 16 + fr; const size_t off = (size_t)r * 2048 + col0; float ss = 0.f;
#pragma unroll
                for (int bj = 0; bj < 2; ++bj)
#pragma unroll
                    for (int n = 0; n < 2; ++n) { const size_t o = off + bj * HALF + n * 16; const u32x2 xo = *(const u32x2*)(xb + o); const f32x4 v = (f32x4){bf_lo(xo.x), bf_hi(xo.x), bf_lo(xo.y), bf_hi(xo.y)} + acc[ai][bj][m][n] * ascale;
                        ss += (v[0] * v[0] + v[1] * v[1]) + (v[2] * v[2] + v[3] * v[3]);
                        u32x2 w; w.x = cvt_pk_bf16(v[0], v[1]); w.y = cvt_pk_bf16(v[2], v[3]); *(u32x2*)(xb + o) = w; }
                ss += lane_xor<16>(ss); ss = half_sum(ss);
                if (fq == 0) rowss[(size_t)r * 32 + u.pn * 4 + wc] = ss; }
    }
};
struct EpiQ {
    static constexpr bool PERM = true, AFTER_DRAIN = false, MIDK = false;
    bf16_t* Q;
    __device__ __forceinline__ void operator()(const f32x4 (&acc)[2][2][4][2], const Unit& u, int wr, int wc, int fr, int fq) const {
        const int row0 = u.pm * BM + wr * 64 + fr; const int col0 = u.pn * BM + wc * 32 + 8 * fq;
#pragma unroll
        for (int ai = 0; ai < 2; ++ai)
#pragma unroll
            for (int m = 0; m < 4; ++m) { const int row = row0 + ai * HALF + m * 16;
                bf16_t* rowp = Q + (size_t)row * 2048 + col0;
#pragma unroll
                for (int bj = 0; bj < 2; ++bj) { const f32x4 v0 = acc[ai][bj][m][0], v1 = acc[ai][bj][m][1];
                    u32x4 w; w.x = cvt_pk_bf16(v0[0], v0[1]); w.y = cvt_pk_bf16(v0[2], v0[3]); w.z = cvt_pk_bf16(v1[0], v1[1]); w.w = cvt_pk_bf16(v1[2], v1[3]);
                    *(u32x4*)(rowp + bj * HALF) = w; } }
    }
};
typedef int v8i_t __attribute__((ext_vector_type(8)));
template <class Epi, class Sched, bool ALIGN_EPI = false, bool SP2 = false, bool F8 = false>
__device__ __forceinline__ void gemm_phase(PG8_LAS unsigned char* lds, const Gemm g, const Sched& S, const Epi& E, const int wave_in) {
    int tid_ = wave_in * 64 + lane_id_(); asm volatile("" : "+v"(tid_));
    const int tid = tid_, wid = __builtin_amdgcn_readfirstlane(tid >> 6), lane = tid & 63, wr = wid >> 2, wc = wid & 3, fr = lane & 15, fq = lane >> 4;
    const int K = g.K, nt = F8 ? K / 128 : K / BK;
    unsigned voffA[2], voffB[2];
#pragma unroll
    for (int i = 0; i < 2; ++i) { int R, C; stage_rc(tid * 16 + i * 8192, R, C); const int Rb = Epi::PERM ? ((R & ~31) + perm32(R & 31)) : R;
        if constexpr (F8) { voffA[i] = (unsigned)(R * K + 2 * C); voffB[i] = (unsigned)(Rb * K + 2 * C); } else { voffA[i] = (unsigned)(R * K + C) * 2u; voffB[i] = (unsigned)(Rb * K + C) * 2u; } }
    const size_t kstep = (size_t)(BK * 2);
    const size_t hstep = (size_t)HALF * K * (F8 ? 1 : 2);
    const size_t tstep = 2 * hstep;
    const unsigned ldsw = (unsigned)wid * 1024u;
    const int aoff = lds_byte(wr * 64 + fr, fq * 8), boff = lds_byte(wc * 32 + fr, fq * 8);
    const int aoff1 = aoff + 1024, boff1 = boff + 1024;
#define PG8_SA(b, h) (((b) * 2 + (h)) * HTB)
#define PG8_SB(b, h) ((4 + (b) * 2 + (h)) * HTB)
#define PG8_STAGE(bufoff, gbase, voff) do { _Pragma("unroll") for (int _i = 0; _i < 2; ++_i) \
        __builtin_amdgcn_global_load_lds((const unsigned*)((const char*)(gbase) + (voff)[_i]), (PG8_LAS unsigned*)(lds + (bufoff) + ldsw + _i * 8192), 16, 0, 0); } while (0)
#define PG8_LDA(dst, b, h) do { if constexpr (F8) { _Pragma("unroll") for (int m = 0; m < 4; ++m) { const u32x4 x0_ = *(const PG8_LAS u32x4*)(lds + PG8_SA(b, h) + aoff + m * 2048), x1_ = *(const PG8_LAS u32x4*)(lds + PG8_SA(b, h) + aoff1 + m * 2048); \
        dst##8[m] = (v8i_t){(int)x0_.x, (int)x0_.y, (int)x0_.z, (int)x0_.w, (int)x1_.x, (int)x1_.y, (int)x1_.z, (int)x1_.w}; } } else { \
        _Pragma("unroll") for (int m = 0; m < 4; ++m) _Pragma("unroll") for (int k = 0; k < 2; ++k) dst[m][k] = *(const PG8_LAS bf16x8*)(lds + PG8_SA(b, h) + aoff + m * 2048 + k * 1024); } } while (0)
#define PG8_LDB(dst, b, h) do { if constexpr (F8) { _Pragma("unroll") for (int n = 0; n < 2; ++n) { const u32x4 x0_ = *(const PG8_LAS u32x4*)(lds + PG8_SB(b, h) + boff + n * 2048), x1_ = *(const PG8_LAS u32x4*)(lds + PG8_SB(b, h) + boff1 + n * 2048); \
        dst##8[n] = (v8i_t){(int)x0_.x, (int)x0_.y, (int)x0_.z, (int)x0_.w, (int)x1_.x, (int)x1_.y, (int)x1_.z, (int)x1_.w}; } } else { \
        _Pragma("unroll") for (int n = 0; n < 2; ++n) _Pragma("unroll") for (int k = 0; k < 2; ++k) dst[n][k] = *(const PG8_LAS bf16x8*)(lds + PG8_SB(b, h) + boff + n * 2048 + k * 1024); } } while (0)
#define PG8_MMA(ai, bj, At, Bt) do { __builtin_amdgcn_s_setprio(1); if constexpr (F8) { _Pragma("unroll") for (int m = 0; m < 4; ++m) _Pragma("unroll") for (int n = 0; n < 2; ++n) \
        asm volatile("v_mfma_scale_f32_16x16x128_f8f6f4 %0, %1, %2, %0, %3, %3 op_sel_hi:[0,0,0]" : "+v"(acc[ai][bj][m][n]) : "v"(Bt##8[n]), "v"(At##8[m]), "v"(sc1_)); } else { \
        _Pragma("unroll") for (int m = 0; m < 4; ++m) _Pragma("unroll") for (int n = 0; n < 2; ++n) _Pragma("unroll") for (int k = 0; k < 2; ++k) \
        acc[ai][bj][m][n] = __builtin_amdgcn_mfma_f32_16x16x32_bf16(Bt[n][k], At[m][k], acc[ai][bj][m][n], 0, 0, 0); } __builtin_amdgcn_s_setprio(0); } while (0)
#define PG8_WAIT_V(n) asm volatile("s_waitcnt vmcnt(" #n ")" ::: "memory")
#define PG8_WAIT_L(n) asm volatile("s_waitcnt lgkmcnt(" #n ")" ::: "memory")
#define PG8_BAR __builtin_amdgcn_s_barrier()
#define PG8_SCHED __builtin_amdgcn_sched_barrier(0)
    Unit cur, nxt; int ui = 0;
    if (!S.next(0, cur)) return;
    f32x4 acc[2][2][4][2];
#pragma unroll
    for (int a = 0; a < 2; ++a)
#pragma unroll
        for (int b = 0; b < 2; ++b)
#pragma unroll
            for (int m = 0; m < 4; ++m)
#pragma unroll
                for (int n = 0; n < 2; ++n) acc[a][b][m][n] = (f32x4){0.f, 0.f, 0.f, 0.f};
    bf16x8 At[4][2], B0[2][2], B1[2][2]; v8i_t At8[4], B08[2], B18[2];
    int sc1_ = 0x7F7F7F7F; asm volatile("" : "+v"(sc1_));
    const char* cA = (const char*)g.A + (size_t)cur.pm * tstep; const char* cB = (const char*)g.Bt + (size_t)cur.pn * tstep;
    S.a_ready(cur);
    if constexpr (SP2) {
        PG8_STAGE(PG8_SB(0, 0), cB, voffB); PG8_STAGE(PG8_SB(0, 1), cB + hstep, voffB); PG8_STAGE(PG8_SA(0, 0), cA, voffA); PG8_STAGE(PG8_SA(0, 1), cA + hstep, voffA);
        if (wr == 1) PG8_BAR;
        PG8_WAIT_V(2); PG8_BAR;
        PG8_STAGE(PG8_SB(1, 0), cB + kstep, voffB); PG8_STAGE(PG8_SA(1, 0), cA + kstep, voffA); PG8_STAGE(PG8_SB(1, 1), cB + hstep + kstep, voffB);
        PG8_WAIT_V(6); PG8_BAR;
    } else {
        PG8_STAGE(PG8_SB(0, 0), cB, voffB); PG8_STAGE(PG8_SA(0, 0), cA, voffA); PG8_STAGE(PG8_SB(0, 1), cB + hstep, voffB); PG8_STAGE(PG8_SA(0, 1), cA + hstep, voffA);
        if (wr == 1) PG8_BAR;
        PG8_WAIT_V(4); PG8_BAR;
        PG8_STAGE(PG8_SB(1, 0), cB + kstep, voffB); PG8_STAGE(PG8_SA(1, 0), cA + kstep, voffA); PG8_STAGE(PG8_SB(1, 1), cB + hstep + kstep, voffB);
        PG8_WAIT_V(6); PG8_BAR;
    }
    for (;;) {
        const bool has_next = S.next(ui + 1, nxt);
        const char* nA = has_next ? (const char*)g.A + (size_t)nxt.pm * tstep : cA; const char* nB = has_next ? (const char*)g.Bt + (size_t)nxt.pn * tstep : cB;
        for (int t = 0; t < nt; t += 2) {
            if constexpr (Epi::MIDK) { if (t == Epi::KB1 || t == Epi::KB2) E.mid(acc, cur, t, wr, wc, fr, fq); }
            const bool last = (t == nt - 2);
            const char* a1 = cA + (size_t)(t + 1) * kstep;
            const char* a2 = last ? nA : cA + (size_t)(t + 2) * kstep; const char* b2 = last ? nB : cB + (size_t)(t + 2) * kstep;
            const char* a3 = a2 + kstep; const char* b3 = b2 + kstep;
            if (last && has_next) S.a_ready(nxt);
            if constexpr (SP2) {
            PG8_LDB(B0, 0, 0); PG8_LDB(B1, 0, 1); PG8_SCHED; PG8_LDA(At, 0, 0); PG8_STAGE(PG8_SA(1, 1), a1 + hstep, voffA);
            PG8_WAIT_V(8); PG8_WAIT_L(0); PG8_BAR; PG8_MMA(0, 0, At, B0); PG8_MMA(0, 1, At, B1); PG8_BAR; PG8_SCHED;
            PG8_LDA(At, 0, 1); PG8_STAGE(PG8_SB(0, 0), b2, voffB); PG8_STAGE(PG8_SB(0, 1), b2 + hstep, voffB); PG8_STAGE(PG8_SA(0, 0), a2, voffA);
            PG8_WAIT_V(8); PG8_WAIT_L(0); PG8_BAR; PG8_MMA(1, 0, At, B0); PG8_MMA(1, 1, At, B1); PG8_BAR; PG8_SCHED;
            PG8_LDB(B0, 1, 0); PG8_LDB(B1, 1, 1); PG8_SCHED; PG8_LDA(At, 1, 0); PG8_STAGE(PG8_SA(0, 1), a2 + hstep, voffA);
            PG8_WAIT_V(8); PG8_WAIT_L(0); PG8_BAR; PG8_MMA(0, 0, At, B0); PG8_MMA(0, 1, At, B1); PG8_BAR; PG8_SCHED;
            PG8_LDA(At, 1, 1); PG8_STAGE(PG8_SB(1, 0), b3, voffB); PG8_STAGE(PG8_SB(1, 1), b3 + hstep, voffB); PG8_STAGE(PG8_SA(1, 0), a3, voffA);
            PG8_WAIT_V(8); PG8_WAIT_L(0); PG8_BAR; PG8_MMA(1, 0, At, B0); PG8_MMA(1, 1, At, B1); PG8_BAR; PG8_SCHED;
            } else {
            PG8_LDB(B0, 0, 0); PG8_SCHED; PG8_LDA(At, 0, 0); PG8_STAGE(PG8_SA(1, 1), a1 + hstep, voffA);
            PG8_WAIT_L(8); PG8_BAR; PG8_WAIT_L(0); PG8_MMA(0, 0, At, B0); PG8_BAR; PG8_SCHED;
            PG8_LDB(B1, 0, 1); PG8_STAGE(PG8_SB(0, 0), b2, voffB);
            PG8_BAR; PG8_WAIT_L(0); PG8_MMA(0, 1, At, B1); PG8_BAR;
            PG8_LDA(At, 0, 1); PG8_STAGE(PG8_SA(0, 0), a2, voffA);
            PG8_BAR; PG8_WAIT_L(0); PG8_MMA(1, 0, At, B0); PG8_BAR; PG8_SCHED;
            PG8_STAGE(PG8_SB(0, 1), b2 + hstep, voffB);
            PG8_WAIT_V(6); PG8_BAR; PG8_MMA(1, 1, At, B1); PG8_BAR;
            PG8_LDB(B0, 1, 0); PG8_SCHED; PG8_LDA(At, 1, 0); PG8_STAGE(PG8_SA(0, 1), a2 + hstep, voffA);
            PG8_WAIT_L(8); PG8_BAR; PG8_WAIT_L(0); PG8_MMA(0, 0, At, B0); PG8_BAR; PG8_SCHED;
            PG8_LDB(B1, 1, 1); PG8_STAGE(PG8_SB(1, 0), b3, voffB);
            PG8_BAR; PG8_WAIT_L(0); PG8_MMA(0, 1, At, B1); PG8_BAR;
            PG8_LDA(At, 1, 1); PG8_STAGE(PG8_SA(1, 0), a3, voffA);
            PG8_BAR; PG8_WAIT_L(0); PG8_MMA(1, 0, At, B0); PG8_BAR; PG8_SCHED;
            PG8_STAGE(PG8_SB(1, 1), b3 + hstep, voffB);
            PG8_WAIT_V(6); PG8_BAR; PG8_MMA(1, 1, At, B1); PG8_BAR;
            }
        }
        if constexpr (ALIGN_EPI) { if (wr == 0) PG8_BAR; }
        if constexpr (F8) asm volatile("s_nop 15\n\ts_nop 15" ::: "memory");
        if constexpr (!Epi::AFTER_DRAIN) { E(acc, cur, wr, wc, fr, fq); S.done(cur); }
        if (!has_next) break;
#pragma unroll
        for (int a = 0; a < 2; ++a)
#pragma unroll
            for (int b = 0; b < 2; ++b)
#pragma unroll
                for (int m = 0; m < 4; ++m)
#pragma unroll
                    for (int n = 0; n < 2; ++n) acc[a][b][m][n] = (f32x4){0.f, 0.f, 0.f, 0.f};
        cur = nxt; cA = nA; cB = nB; ++ui;
        if constexpr (ALIGN_EPI) { if (wr == 1) PG8_BAR; }
    }
    PG8_WAIT_V(0);
    if constexpr (!ALIGN_EPI) { if (wr == 0) PG8_BAR; }
    PG8_BAR;
    if constexpr (Epi::AFTER_DRAIN) { E.fused(acc, cur, wr, wc, fr, fq, lds, wid, lane); S.done(cur); }
#undef PG8_SA
#undef PG8_SB
#undef PG8_STAGE
#undef PG8_LDA
#undef PG8_LDB
#undef PG8_MMA
#undef PG8_WAIT_V
#undef PG8_WAIT_L
#undef PG8_BAR
#undef PG8_SCHED
}
}
#define PG8_SP2 true
#define GAS __attribute__((address_space(1)))
#define LAS __attribute__((address_space(3)))
typedef unsigned short bf16;
typedef unsigned v4u __attribute__((ext_vector_type(4)));
typedef float f32x4 __attribute__((ext_vector_type(4)));
typedef short bf16x8 __attribute__((ext_vector_type(8)));
typedef GAS unsigned gu32;
typedef GAS unsigned long long gu64;
#define RLX_AGENT __ATOMIC_RELAXED, __HIP_MEMORY_SCOPE_AGENT
#define LDS_WAIT() asm volatile("s_waitcnt lgkmcnt(0)" ::: "memory")
#define VM_WAIT() asm volatile("s_waitcnt vmcnt(0)" ::: "memory")
__device__ __forceinline__ unsigned long long rt() { return __builtin_amdgcn_s_memrealtime(); }
__device__ __forceinline__ unsigned f2bf(float f) { unsigned u = __builtin_bit_cast(unsigned, f); return (u + 0x7fffu + ((u >> 16) & 1u)) >> 16; }
__device__ __forceinline__ unsigned pk2(float lo, float hi) { return f2bf(lo) | (f2bf(hi) << 16); }

#define XB_TMO      128
#define XB_XCNT(j)  (256  + 64 * (j))
#define XB_XSUB(j)  (1280 + 64 * (j))
#define XB_XGEN(j)  (2304 + 64 * (j))
#define XB_TOP      3328
#define XB_TOPGEN   3392
#define XCD_BAR_WORDS 3456
#define XB_SPIN_CAP (1u << 18)

__device__ __forceinline__ unsigned xb_ld(unsigned* p)              { return __hip_atomic_load(p, __ATOMIC_RELAXED, __HIP_MEMORY_SCOPE_AGENT); }
__device__ __forceinline__ unsigned xb_add(unsigned* p, unsigned v) { return __hip_atomic_fetch_add(p, v, __ATOMIC_RELAXED, __HIP_MEMORY_SCOPE_AGENT); }
__device__ __forceinline__ unsigned xb_xcc_id() { return (unsigned)__builtin_amdgcn_s_getreg((3 << 11) | 20) & 0xFu; }
#define XB_SPIN(cond, bar) do { unsigned _sp = 0; while (cond) { __builtin_amdgcn_s_sleep(1); \
    if ((++_sp & 255u) == 0u) { if (xb_ld(&(bar)[XB_TMO])) break; if (_sp > XB_SPIN_CAP) { atomicAdd(&(bar)[XB_TMO], 1u); break; } } } } while (0)

struct XcdBarrier {
    unsigned* bar; unsigned x;
    volatile LAS unsigned* st;
};

__device__ __forceinline__ XcdBarrier xcd_barrier_post(unsigned* bar, volatile LAS unsigned* st) {
    XcdBarrier b; b.bar = bar; b.x = xb_xcc_id(); b.st = st;
    if (threadIdx.x == 0) st[3] = xb_add(&bar[XB_XCNT(b.x)], 1u);
    return b;
}
__device__ __forceinline__ void xcd_barrier_complete(unsigned* bar, unsigned x, unsigned& nloc, unsigned& nx, unsigned& uni) {
    const unsigned G = gridDim.x * gridDim.y * gridDim.z;
    unsigned sum, cnt, mine, bad, sp = 0u;
    for (;;) {
        sum = 0u; cnt = 0u; mine = 0u; bad = 0u;
#pragma unroll
        for (unsigned j = 0; j < 16; ++j) { const unsigned c = xb_ld(&bar[XB_XCNT(j)]); sum += c; cnt += (c > 0u) ? 1u : 0u; mine = (j == x) ? c : mine; bad += (c != 0u && c != 32u) ? 1u : 0u; }
        if (sum == G) break;
        __builtin_amdgcn_s_sleep(1);
        if ((++sp & 255u) == 0u) { if (xb_ld(&bar[XB_TMO])) break; if (sp > XB_SPIN_CAP) { atomicAdd(&bar[XB_TMO], 1u); break; } }
    }
    nloc = mine > 0u ? mine : 1u; nx = cnt > 0u ? cnt : 1u;
    uni = (sum == G && G == 256u && cnt == 8u && bad == 0u) ? 1u : 2u;
}

__device__ __forceinline__ void xcd_barrier(const XcdBarrier& b) {
    asm volatile("s_waitcnt vmcnt(0)" ::: "memory");
    __syncthreads();
    if (threadIdx.x == 0) {
        unsigned* bar = b.bar;
        __builtin_amdgcn_s_waitcnt(0);
        unsigned nloc = b.st[0], nx = b.st[1];
        if (nloc == 0u) { unsigned uni; xcd_barrier_complete(bar, b.x, nloc, nx, uni); b.st[0] = nloc; b.st[1] = nx; b.st[2] = uni; }
        const unsigned old = xb_add(&bar[XB_XSUB(b.x)], 1u);
        const unsigned gen = old / nloc;
        if (old + 1u == (gen + 1u) * nloc) {
            __builtin_amdgcn_fence(__ATOMIC_RELEASE, "agent");
            asm volatile("s_waitcnt vmcnt(0)" ::: "memory");
            const unsigned og = xb_add(&bar[XB_TOP], 1u);
            const unsigned tg = og / nx;
            if (og + 1u == (tg + 1u) * nx) xb_add(&bar[XB_TOPGEN], 1u);
            else XB_SPIN(xb_ld(&bar[XB_TOPGEN]) == tg, bar);
            __builtin_amdgcn_fence(__ATOMIC_ACQUIRE, "agent");
            xb_add(&bar[XB_XGEN(b.x)], 1u);
            asm volatile("s_waitcnt vmcnt(0)" ::: "memory");
        } else {
            XB_SPIN(xb_ld(&bar[XB_XGEN(b.x)]) == gen, bar);
            __builtin_amdgcn_fence(__ATOMIC_ACQUIRE, "agent");
            asm volatile("s_waitcnt vmcnt(0)" ::: "memory");
        }
    }
    __syncthreads();
}
__device__ __forceinline__ void xcd_barrier_local(const XcdBarrier& b) {
    asm volatile("s_waitcnt vmcnt(0)" ::: "memory");
    __syncthreads();
    if (threadIdx.x == 0) {
        unsigned* bar = b.bar;
        __builtin_amdgcn_s_waitcnt(0);
        const unsigned nloc = b.st[0];
        const unsigned old = xb_add(&bar[XB_XSUB(b.x)], 1u);
        const unsigned gen = old / nloc;
        if (old + 1u == (gen + 1u) * nloc) xb_add(&bar[XB_XGEN(b.x)], 1u);
        else XB_SPIN(xb_ld(&bar[XB_XGEN(b.x)]) == gen, bar);
        __builtin_amdgcn_fence(__ATOMIC_ACQUIRE, "agent");
        asm volatile("s_waitcnt vmcnt(0)" ::: "memory");
    }
    __syncthreads();
}
namespace cfg {
constexpr int NWAVES = 8;
constexpr int M = 16384, D = 2048, T = 2048, NBATCH = 8, DEPTH = 2;
constexpr int IN_COLS = 10152, NPROJ = 10240, PA_LD = 4096, GT_LD = 6144;
constexpr int C_QA = 0, C_KA = 1024, C_VA = 1280, C_QB = 1536, C_KB = 2048, C_VB = 2560, C_QC = 3072, C_CL = 3584, C_IQ = 3712, C_IK = 3968, C_IW = 4000;
constexpr float EPS = 1e-6f;
constexpr size_t MiB = 1u << 20;
constexpr size_t WS_CTL = 0, CTL_ZERO_BYTES = 1 * MiB;
constexpr size_t WS_ROWSSB = 842 * MiB;
constexpr size_t WS_ROWSSA = 1 * MiB;
constexpr size_t WS_KMEAN = 512 * 1024;
constexpr size_t WS_BIASD = 1 * MiB + 256 * 1024;
constexpr size_t WS_WUKB = 1 * MiB + 512 * 1024;
constexpr size_t WS_WUVT = 1 * MiB + 768 * 1024;
constexpr size_t WS_CN = 2 * MiB;
constexpr size_t WS_MASK = 6 * MiB;
constexpr size_t WS_WA = 10 * MiB, WS_WB = 18 * MiB, WS_WC = 22 * MiB, WS_WOUT = 26 * MiB, WS_WQ = 42 * MiB, WS_WIN = 58 * MiB;
constexpr size_t WS_U = 138 * MiB, WS_V = 266 * MiB;
constexpr size_t WS_USC = WS_U + 64 * MiB;
constexpr size_t WS_XB8 = WS_U + 80 * MiB;
constexpr size_t WS_WG8 = WS_V + 80 * MiB;
constexpr size_t WS_XB = 394 * MiB;
constexpr size_t WS_PA = 458 * MiB;
constexpr size_t WS_MG = 682 * MiB, WS_QP = 714 * MiB;
constexpr size_t WS_GT = 586 * MiB;
constexpr size_t WS_YA = 778 * MiB, WS_YB = 810 * MiB, WS_YC = 826 * MiB;
constexpr size_t WS_SKB = 844 * MiB;
constexpr size_t WS_SC = 845 * MiB;
constexpr size_t WS_PD = WS_SC;
constexpr size_t WS_RI = 973 * MiB, WS_RG = 981 * MiB, WS_W = 989 * MiB;
constexpr size_t WS_RSTD = 997 * MiB;
constexpr size_t WS_RS = 998 * MiB;
constexpr size_t WS_END = 999 * MiB;
constexpr int CW_BAR = 4096;
constexpr int RING_BYTES = 131072, LDS_BYTES = 147456, LDSCTL_OFF = LDS_BYTES - 512, MISC_OFF = LDSCTL_OFF + 320;
constexpr int NPHASE = 22;
}
using namespace cfg;
typedef unsigned u32x4v __attribute__((ext_vector_type(4)));
typedef unsigned u32x2v __attribute__((ext_vector_type(2)));
typedef float f32x2v __attribute__((ext_vector_type(2)));
typedef __bf16 bf16x2_t __attribute__((ext_vector_type(2)));
__device__ __forceinline__ float bflo(unsigned u) { return __builtin_bit_cast(float, u << 16); }
__device__ __forceinline__ float bfhi(unsigned u) { return __builtin_bit_cast(float, u & 0xffff0000u); }
__device__ __forceinline__ float bf1(bf16 v) { return __builtin_bit_cast(float, (unsigned)v << 16); }
__device__ __forceinline__ float dot2(unsigned a, unsigned b, float c) { return __builtin_amdgcn_fdot2_f32_bf16(__builtin_bit_cast(bf16x2_t, a), __builtin_bit_cast(bf16x2_t, b), c, false); }
__device__ __forceinline__ float dot8(v4u a, v4u b, float c) { c = dot2(a.x, b.x, c); c = dot2(a.y, b.y, c); c = dot2(a.z, b.z, c); c = dot2(a.w, b.w, c); return c; }
__device__ __forceinline__ float wave_sum(float v) {
    v += lane_xor<1>(v); v += lane_xor<2>(v); v += lane_xor<4>(v); v += lane_xor<8>(v); v += lane_xor<16>(v); v = half_sum(v);
    return v;
}
__device__ __forceinline__ float wave_max(float v) {
    v = fmaxf(v, lane_xor<1>(v)); v = fmaxf(v, lane_xor<2>(v)); v = fmaxf(v, lane_xor<4>(v)); v = fmaxf(v, lane_xor<8>(v)); v = fmaxf(v, lane_xor<16>(v)); v = half_max(v);
    return v;
}
__device__ __forceinline__ unsigned fkey(float f) { const unsigned u = __builtin_bit_cast(unsigned, f); return u ^ ((unsigned)((int)u >> 31) | 0x80000000u); }
__device__ __forceinline__ float funkey(unsigned k) { return __builtin_bit_cast(float, (k & 0x80000000u) ? (k ^ 0x80000000u) : ~k); }
__device__ __forceinline__ int mbcnt64(unsigned long long m) { return (int)__builtin_amdgcn_mbcnt_hi((unsigned)(m >> 32), __builtin_amdgcn_mbcnt_lo((unsigned)m, 0u)); }
__device__ __forceinline__ float rdlane(float v, int l) { return __builtin_bit_cast(float, __builtin_amdgcn_readlane(__builtin_bit_cast(int, v), l)); }
__device__ __forceinline__ float gelu_tanh(float x) { const float u = 0.7978845608028654f * (x + 0.044715f * x * x * x); const float e = __expf(2.0f * u); const float th = 1.0f - 2.0f / (e + 1.0f); return 0.5f * x * (1.0f + th); }
typedef int v6i_t __attribute__((ext_vector_type(6)));
typedef __bf16 v32b_t __attribute__((ext_vector_type(32)));
typedef float v32f_t __attribute__((ext_vector_type(32)));
typedef unsigned v16u_t __attribute__((ext_vector_type(16)));
constexpr size_t TBL_SLICE = (size_t)16384 * 192, TBL_LAYER = 8 * TBL_SLICE;
__device__ __forceinline__ void row6_load(const float* src, f32x4 (&a)[8], int lane) {
    const int s = lane >> 3, b = lane & 7;
#pragma unroll
    for (int k = 0; k < 8; ++k) a[k] = *(const f32x4*)(src + 256 * s + 32 * k + 4 * b);
}
template <bool UL>
__device__ __forceinline__ float row_to_fp6(f32x4 (&a)[8], const float* g, unsigned char* dst, int lane) {
    const int s = lane >> 3, b = lane & 7;
    float amax = 0.f;
#pragma unroll
    for (int k = 0; k < 8; ++k) { const int e0 = 256 * s + 32 * k + 4 * b;
        if (g) a[k] = a[k] * *(const f32x4*)(g + e0);
        amax = fmaxf(amax, fmaxf(fmaxf(fabsf(a[k].x), fabsf(a[k].y)), fmaxf(fabsf(a[k].z), fabsf(a[k].w)))); }
    amax = wave_max(amax);
    const float enc = amax > 0.f ? 7.5f / amax : 1.f;
    v32b_t v;
#pragma unroll
    for (int k = 0; k < 8; ++k) { v[4 * k] = (__bf16)(a[k].x * enc); v[4 * k + 1] = (__bf16)(a[k].y * enc); v[4 * k + 2] = (__bf16)(a[k].z * enc); v[4 * k + 3] = (__bf16)(a[k].w * enc); }
    const v6i_t w = __builtin_amdgcn_cvt_scalef32_pk32_fp6_bf16(v, 1.0f);
    unsigned* row = (unsigned*)(dst + (size_t)s * TBL_SLICE);
    if (UL) { const int p = b >> 1; const bool h = b & 1;
        v4u q4; q4.x = (unsigned)(h ? w[2] : w[0]); q4.y = (unsigned)(h ? w[3] : w[1]); q4.z = (unsigned)(h ? w[4] : w[2]); q4.w = (unsigned)(h ? w[5] : w[3]);
        u32x2v q2; q2.x = (unsigned)(h ? w[0] : w[4]); q2.y = (unsigned)(h ? w[1] : w[5]);
        *(v4u*)(row + (h ? 32 : 0) + 4 * p) = q4; *(u32x2v*)(row + 16 + 4 * p + (h ? 2 : 0)) = q2; }
    else {
#pragma unroll
        for (int j = 0; j < 3; ++j) { u32x2v q2; q2.x = (unsigned)w[2 * j]; q2.y = (unsigned)w[2 * j + 1]; *(u32x2v*)(row + 16 * j + 2 * b) = q2; } }
    return amax > 0.f ? amax / 7.5f : 1.f;
}
struct TItem { const float* W; const float* g; void* WT; float scale; int ldw, c0, ncv, row_off, ldk, koff, k0, n0; bool f8; };
__device__ __forceinline__ void titem_load(const TItem& d, f32x4 (&v)[8], int lane) {
    const int cj = lane & 7, ks = lane >> 3; const bool ok = d.n0 + 4 * cj < d.ncv;
#pragma unroll
    for (int i = 0; i < 8; ++i) v[i] = ok ? *(const f32x4*)(d.W + (size_t)(d.k0 + 8 * i + ks) * d.ldw + d.c0 + d.n0 + 4 * cj) : (f32x4){0.f, 0.f, 0.f, 0.f};
}
__device__ __forceinline__ void titem_finish(const TItem& d, const f32x4 (&v)[8], LAS float* scr, int lane) {
    const int cj = lane & 7, ks = lane >> 3;
#pragma unroll
    for (int i = 0; i < 8; ++i) { const int kk = 8 * i + ks; const f32x4 w = v[i] * (d.g ? d.g[d.k0 + kk] * d.scale : d.scale);
        LAS float* p = scr + kk * 33 + 4 * cj; p[0] = w.x; p[1] = w.y; p[2] = w.z; p[3] = w.w; }
    LDS_WAIT(); asm volatile("" ::: "memory");
    if (!d.f8) { const int c = lane & 7; bf16* WT = (bf16*)d.WT;
#pragma unroll
        for (int j = 0; j < 4; ++j) { const int n = (lane >> 3) + 8 * j; const LAS float* sp = scr + (8 * c) * 33 + n;
            v4u o; o.x = pk2(sp[0 * 33], sp[1 * 33]); o.y = pk2(sp[2 * 33], sp[3 * 33]); o.z = pk2(sp[4 * 33], sp[5 * 33]); o.w = pk2(sp[6 * 33], sp[7 * 33]);
            *(v4u*)(WT + (size_t)(d.row_off + d.n0 + n) * d.ldk + d.koff + d.k0 + 8 * c) = o; } }
    else { const int n = lane >> 1, hf = lane & 1; const LAS float* sp = scr + (32 * hf) * 33 + n;
        unsigned w[8];
#pragma unroll
        for (int q = 0; q < 8; ++q) { int t = __builtin_amdgcn_cvt_pk_fp8_f32(sp[(4 * q) * 33], sp[(4 * q + 1) * 33], 0, false); t = __builtin_amdgcn_cvt_pk_fp8_f32(sp[(4 * q + 2) * 33], sp[(4 * q + 3) * 33], t, true); w[q] = (unsigned)t; }
        unsigned char* dp = (unsigned char*)d.WT + (size_t)(d.row_off + d.n0 + n) * d.ldk + d.koff + d.k0 + 32 * hf;
        *(v4u*)dp = (v4u){w[0], w[1], w[2], w[3]}; *(v4u*)(dp + 16) = (v4u){w[4], w[5], w[6], w[7]}; }
    LDS_WAIT(); asm volatile("" ::: "memory");
}
__device__ __forceinline__ int rel_bucket(int d) {
    if (d < 16) return d;
    const int v = 16 + (int)(logf((float)d / 16.0f) / 4.852030263919617f * 16.0f);
    return v < 31 ? v : 31;
}
struct Ptrs {
    const float *x, *rel_bias, *g_mix, *w_in, *a_sinks, *c_gain, *w_uk, *w_uv, *w_a, *w_b, *w_c, *w_out, *g_ffn, *w_q, *sub_keys, *peer_u, *peer_v, *g_final;
    float* out; unsigned char* ws;
};
__device__ __forceinline__ void p0_prologue(const Ptrs& P, LAS unsigned char* lds, int gw, int NGW, int wave, int lane) {
    LAS float* scr = (LAS float*)(lds + wave * 16384);
    unsigned char* ws = P.ws;
    constexpr int I_IN1 = 32 * 32, I_IN1B = 32 * 16, I_IN8A = 32 * 48, I_IN8B = 32 * 32, I_IN2 = 32 * 192, I_A = 16 * 64, I_B = 8 * 64, I_C = 8 * 64, I_O = 32 * 64, I_Q = 32 * 64;
    constexpr int I_LAYER = I_IN1 + I_IN1B + I_IN8A + I_IN8B + I_IN2 + I_A + I_B + I_C + I_O + I_Q;
    auto mk = [&](int it) -> TItem {
        const int l = it / I_LAYER; int r = it % I_LAYER; TItem d;
        const float* win = P.w_in + (size_t)l * 2048 * IN_COLS; const float* gm = P.g_mix + l * 2048;
        auto set = [&](const float* W, int ldw, int c0, int ncv, const float* g, float scale, void* WT, int nblk, int ldk, int koff, bool f8) {
            d.W = W; d.ldw = ldw; d.c0 = c0; d.ncv = ncv; d.g = g; d.scale = scale; d.WT = WT; d.row_off = 0; d.ldk = ldk; d.koff = koff; d.k0 = 64 * (r / nblk); d.n0 = 32 * (r % nblk); d.f8 = f8; };
        bf16* WinT = (bf16*)(ws + WS_WIN) + (size_t)l * NPROJ * 2048; unsigned char* Win8 = ws + WS_WG8 + (size_t)l * NPROJ * 2048;
        if (r < I_IN1) { set(win, IN_COLS, 1536, 1024, gm, 1.0f, WinT, 32, 2048, 0, false); d.row_off = 1536; return d; } r -= I_IN1;
        if (r < I_IN1B) { set(win, IN_COLS, 3584, 424, gm, 1.0f, WinT, 16, 2048, 0, false); d.row_off = 3584; return d; } r -= I_IN1B;
        if (r < I_IN8A) { set(win, IN_COLS, 0, 1536, gm, 256.0f, Win8, 48, 2048, 0, true); return d; } r -= I_IN8A;
        if (r < I_IN8B) { set(win, IN_COLS, 2560, 1024, gm, 256.0f, Win8, 32, 2048, 0, true); d.row_off = 2560; return d; } r -= I_IN8B;
        if (r < I_IN2) { set(win, IN_COLS, 4008, 6144, gm, 256.0f, Win8, 192, 2048, 0, true); d.row_off = 4096; return d; } r -= I_IN2;
        if (r < I_A) { set(P.w_a + (size_t)l * 1024 * 2048, 2048, 0, 2048, nullptr, 128.0f, ws + WS_WA + (size_t)l * 2048 * 2048, 64, 2048, 0, true); return d; } r -= I_A;
        if (r < I_B) { set(P.w_b + (size_t)l * 512 * 2048, 2048, 0, 2048, nullptr, 128.0f, ws + WS_WA + (size_t)l * 2048 * 2048, 64, 2048, 1024, true); return d; } r -= I_B;
        if (r < I_C) { set(P.w_c + (size_t)l * 512 * 2048, 2048, 0, 2048, nullptr, 128.0f, ws + WS_WA + (size_t)l * 2048 * 2048, 64, 2048, 1536, true); return d; } r -= I_C;
        if (r < I_O) { set(P.w_out + (size_t)l * 2048 * 2048, 2048, 0, 2048, nullptr, 256.0f, ws + WS_WOUT + (size_t)l * 2048 * 2048, 64, 2048, 0, true); return d; } r -= I_O;
        set(P.w_q + (size_t)l * 2048 * 2048, 2048, 0, 2048, P.g_ffn + l * 2048, 1.0f, (bf16*)(ws + WS_WQ) + (size_t)l * 2048 * 2048, 64, 2048, 0, false); return d; };
    { f32x4 nx[8];
      if (gw < 2 * I_LAYER) { const TItem d0 = mk(gw); titem_load(d0, nx, lane); }
#pragma unroll 1
      for (int it = gw; it < 2 * I_LAYER; it += NGW) {
          const TItem d = mk(it);
          f32x4 a[8];
#pragma unroll
          for (int k = 0; k < 8; ++k) a[k] = nx[k];
          { const TItem dn = mk((it + NGW < 2 * I_LAYER) ? it + NGW : it); titem_load(dn, nx, lane); }
          titem_finish(d, a, scr, lane);
      } }
    { f32x4 nx[8];
      if (gw < 4 * 16384) { const int tb = gw >> 14, e = gw & 16383, l = tb & 1; row6_load((tb < 2 ? P.peer_u : P.peer_v) + ((size_t)l * 16384 + e) * 2048, nx, lane); }
#pragma unroll 1
      for (int it = gw; it < 4 * 16384; it += NGW) {
        const int tb = it >> 14, e = it & 16383, l = tb & 1;
        f32x4 a[8];
#pragma unroll
        for (int k = 0; k < 8; ++k) a[k] = nx[k];
        { const int itn = (it + NGW < 4 * 16384) ? it + NGW : it; const int tbn = itn >> 14, en = itn & 16383, ln = tbn & 1; row6_load((tbn < 2 ? P.peer_u : P.peer_v) + ((size_t)ln * 16384 + en) * 2048, nx, lane); }
        if (tb < 2) { const float sc = row_to_fp6<true>(a, P.g_ffn + l * 2048, ws + WS_U + (size_t)l * TBL_LAYER + (size_t)e * 192, lane); if (lane == 0) ((float*)(ws + WS_USC))[2 * (l * 16384 + e)] = sc; }
        else        { const float sc = row_to_fp6<false>(a, nullptr, ws + WS_V + (size_t)l * TBL_LAYER + (size_t)e * 192, lane); if (lane == 0) ((float*)(ws + WS_USC))[2 * (l * 16384 + e) + 1] = sc; }
      } }
    float* RS = (float*)(ws + WS_RS);
    { f32x4 nx[8];
      if (gw < M) {
#pragma unroll
          for (int i = 0; i < 4; ++i) { const float* p = P.x + (size_t)gw * 2048 + 8 * (lane + 64 * i); nx[2 * i] = *(const f32x4*)p; nx[2 * i + 1] = *(const f32x4*)(p + 4); } }
#pragma unroll 1
      for (int m = gw; m < M; m += NGW) {
          f32x4 a[8];
#pragma unroll
          for (int k = 0; k < 8; ++k) a[k] = nx[k];
          { const int mn = (m + NGW < M) ? m + NGW : m;
#pragma unroll
            for (int i = 0; i < 4; ++i) { const float* p = P.x + (size_t)mn * 2048 + 8 * (lane + 64 * i); nx[2 * i] = *(const f32x4*)p; nx[2 * i + 1] = *(const f32x4*)(p + 4); } }
          float ss = 0.f; bf16* dst = (bf16*)(ws + WS_XB) + (size_t)m * 2048; unsigned char* dst8 = ws + WS_XB8 + (size_t)m * 2048;
#pragma unroll
          for (int i = 0; i < 4; ++i) { const int e0 = 8 * (lane + 64 * i); const f32x4 p = a[2 * i], q = a[2 * i + 1];
              ss += (p.x * p.x + p.y * p.y) + (p.z * p.z + p.w * p.w) + (q.x * q.x + q.y * q.y) + (q.z * q.z + q.w * q.w);
              v4u o; o.x = pk2(p.x, p.y); o.y = pk2(p.z, p.w); o.z = pk2(q.x, q.y); o.w = pk2(q.z, q.w); *(v4u*)(dst + e0) = o;
              int w0 = __builtin_amdgcn_cvt_pk_fp8_f32(p.x, p.y, 0, false); w0 = __builtin_amdgcn_cvt_pk_fp8_f32(p.z, p.w, w0, true); int w1 = __builtin_amdgcn_cvt_pk_fp8_f32(q.x, q.y, 0, false); w1 = __builtin_amdgcn_cvt_pk_fp8_f32(q.z, q.w, w1, true);
              u32x2v o8; o8.x = (unsigned)w0; o8.y = (unsigned)w1; *(u32x2v*)(dst8 + e0) = o8; }
          ss = wave_sum(ss);
          if (lane < 16) RS[m * 16 + lane] = lane == 0 ? ss : 0.f; } }
    { bf16* SKB = (bf16*)(ws + WS_SKB);
      for (int i = gw * 64 + lane; i < 2 * 262144 / 4; i += NGW * 64) { const f32x4 v = *(const f32x4*)(P.sub_keys + 4 * (size_t)i); u32x2v o; o.x = pk2(v.x, v.y); o.y = pk2(v.z, v.w); *(u32x2v*)(SKB + 4 * (size_t)i) = o; } }
    { bf16* WUKB = (bf16*)(ws + WS_WUKB); bf16* WUVT = (bf16*)(ws + WS_WUVT);
      for (int i = gw * 64 + lane; i < 2 * 65536; i += NGW * 64) { const int l = i >> 16, c = (i >> 9) & 127, h = (i >> 6) & 7, d = i & 63;
          WUKB[((size_t)(l * 8 + h) * 128 + c) * 64 + d] = (bf16)f2bf(P.w_uk[i]); WUVT[((size_t)(l * 8 + h) * 64 + d) * 128 + c] = (bf16)f2bf(P.w_uv[i]); } }
    float* biasd = (float*)(ws + WS_BIASD);
    for (int i = gw * 64 + lane; i < 32 * 2048; i += NGW * 64) { const int hh = i >> 11, d = i & 2047; biasd[i] = P.rel_bias[rel_bucket(d) * 32 + hh]; }
}
__device__ __forceinline__ void cn_item(const bf16* PA, const float* gain, bf16* CN, int item, int lane) {
    const int row = 4 * item + (lane >> 4), c8 = 8 * (lane & 15);
    const v4u cv = *(const v4u*)(PA + (size_t)row * PA_LD + C_CL + c8);
    const float f0 = bflo(cv.x), f1 = bfhi(cv.x), f2 = bflo(cv.y), f3 = bfhi(cv.y), f4 = bflo(cv.z), f5 = bfhi(cv.z), f6 = bflo(cv.w), f7 = bfhi(cv.w);
    float ss = ((f0 * f0 + f1 * f1) + (f2 * f2 + f3 * f3)) + ((f4 * f4 + f5 * f5) + (f6 * f6 + f7 * f7));
    ss += lane_xor<1>(ss); ss += lane_xor<2>(ss); ss += lane_xor<4>(ss); ss += lane_xor<8>(ss);
    const float r = rsqrtf(ss * (1.0f / 128.0f) + EPS);
    const f32x4 g0 = *(const f32x4*)(gain + c8), g1 = *(const f32x4*)(gain + c8 + 4);
    v4u o; o.x = pk2(f0 * r * g0.x, f1 * r * g0.y); o.y = pk2(f2 * r * g0.z, f3 * r * g0.w); o.z = pk2(f4 * r * g1.x, f5 * r * g1.y); o.w = pk2(f6 * r * g1.z, f7 * r * g1.w);
    *(v4u*)(CN + (size_t)row * 128 + c8) = o;
}
typedef float f32x16 __attribute__((ext_vector_type(16)));
typedef short s16x4 __attribute__((ext_vector_type(4)));
#define MFMA32(a, b, c) __builtin_amdgcn_mfma_f32_32x32x16_bf16((a), (b), (c), 0, 0, 0)
__device__ __forceinline__ s16x4 vtr(const LAS unsigned char* p) { return __builtin_bit_cast(s16x4, __builtin_amdgcn_ds_read_tr16_b64_v4i16((LAS s16x4*)p)); }
__device__ __forceinline__ float xhalf_max(float v) { const unsigned u = __builtin_bit_cast(unsigned, v); auto rr = __builtin_amdgcn_permlane32_swap(u, u, false, false); return fmaxf(__builtin_bit_cast(float, (unsigned)rr[0]), __builtin_bit_cast(float, (unsigned)rr[1])); }
__device__ __forceinline__ float xhalf_sum(float v) { const unsigned u = __builtin_bit_cast(unsigned, v); auto rr = __builtin_amdgcn_permlane32_swap(u, u, false, false); return __builtin_bit_cast(float, (unsigned)rr[0]) + __builtin_bit_cast(float, (unsigned)rr[1]); }
__device__ __forceinline__ unsigned pkbf(float lo, float hi) { return pg8::cvt_pk_bf16(lo, hi); }
__device__ __forceinline__ unsigned pk4f8(float a, float b, float c, float d) { int w = __builtin_amdgcn_cvt_pk_fp8_f32(a * 16.0f, b * 16.0f, 0, false); return (unsigned)__builtin_amdgcn_cvt_pk_fp8_f32(c * 16.0f, d * 16.0f, w, true); }
template <int DK> __device__ __forceinline__ void qk_tile(const LAS unsigned char* Kt, const bf16x8 (&qf)[DK / 16], f32x16& p0, f32x16& p1, int r, int hh) {
#pragma unroll
    for (int i = 0; i < 16; ++i) { p0[i] = 0.f; p1[i] = 0.f; }
#pragma unroll
    for (int st = 0; st < DK / 16; ++st) {
        const bf16x8 k0 = *(const LAS bf16x8*)(Kt + ((2 * st + hh) * 64 + r) * 16);
        const bf16x8 k1 = *(const LAS bf16x8*)(Kt + ((2 * st + hh) * 64 + 32 + r) * 16);
        p0 = MFMA32(k0, qf[st], p0); p1 = MFMA32(k1, qf[st], p1);
    }
}
__device__ __forceinline__ float softmax_tile(f32x16& p0, f32x16& p1, float& m, float& l) {
    float mt = fmaxf(p0[0], p1[0]);
#pragma unroll
    for (int i = 1; i < 16; ++i) mt = fmaxf(mt, fmaxf(p0[i], p1[i]));
    mt = xhalf_max(mt);
    const float mn = fmaxf(m, mt);
    const float mu = (mn == -INFINITY) ? 0.f : mn;
    const float alpha = __builtin_amdgcn_exp2f(m - mu);
    float s = 0.f;
#pragma unroll
    for (int i = 0; i < 16; ++i) { p0[i] = __builtin_amdgcn_exp2f(p0[i] - mu); p1[i] = __builtin_amdgcn_exp2f(p1[i] - mu); s += p0[i] + p1[i]; }
    l = l * alpha + s; m = mn;
    return alpha;
}
constexpr float LOG2E = 1.4426950408889634f, QK_SCALE2 = 0.125f * LOG2E;
template <int DV> __device__ __forceinline__ void pv_tile(const LAS unsigned char* Vt, const f32x16& p0, const f32x16& p1, f32x16 (&o)[DV / 32], int lane) {
    const LAS unsigned char* vb = Vt + ((lane >> 4) & 1) * 32 + (lane & 3) * 8 + (4 * (lane >> 5) + ((lane & 15) >> 2)) * 64;
#pragma unroll
    for (int s = 0; s < 4; ++s) {
        const f32x16& p = (s < 2) ? p0 : p1; const int b0 = 8 * (s & 1);
        u32x4v pw; pw.x = pkbf(p[b0 + 0], p[b0 + 1]); pw.y = pkbf(p[b0 + 2], p[b0 + 3]); pw.z = pkbf(p[b0 + 4], p[b0 + 5]); pw.w = pkbf(p[b0 + 6], p[b0 + 7]);
        const bf16x8 pf = __builtin_bit_cast(bf16x8, pw);
#pragma unroll
        for (int db = 0; db < DV / 32; ++db) {
            const s16x4 lo = vtr(vb + db * 4096 + s * 1024), hi = vtr(vb + db * 4096 + s * 1024 + 512);
            const bf16x8 vf = (bf16x8){lo[0], lo[1], lo[2], lo[3], hi[0], hi[1], hi[2], hi[3]};
            o[db] = MFMA32(vf, pf, o[db]);
        }
    }
}
__device__ __forceinline__ void sel_unit(const bf16* PA, float* SC, unsigned long long* MASK, int b, int qt, LAS unsigned char* lds, int tid, int wave, int lane) {
    const int r = lane & 31, hh = lane >> 5;
    if (qt >= 8) {
        const int t = 32 * qt + r, row = b * T + t;
        LAS unsigned char* qs = lds + 65536;
        { int tq = tid; asm volatile("" : "+v"(tq));
          v4u tq4[3];
#pragma unroll
          for (int k = 0; k < 3; ++k) { const int c = tq + NWAVES * 64 * k, cc = c < 32 * 33 ? c : 0; const int rr = cc / 33, j = cc - 33 * rr;
              tq4[k] = *(const v4u*)(PA + (size_t)(b * T + 32 * qt + rr) * PA_LD + (j < 32 ? C_IQ + 8 * j : C_IW)); }
#pragma unroll
          for (int k = 0; k < 3; ++k) { const int c = tq + NWAVES * 64 * k; if (c < 32 * 33) { const int rr = c / 33, j = c - 33 * rr; *(LAS v4u*)(qs + rr * 528 + 16 * j) = tq4[k]; } } }
        __syncthreads();
        const int NT = (qt >> 1) + 1;
        int rk = r; asm volatile("" : "+v"(rk));
        const LAS unsigned char* qr = qs + rk * 528 + 16 * hh;
        bf16x8 k00, k01, k10, k11;
        if (wave < NT) { const bf16* kp = PA + (size_t)(b * T + 64 * wave + rk) * PA_LD + C_IK + 8 * hh;
            k00 = *(const bf16x8*)kp; k01 = *(const bf16x8*)(kp + 16); k10 = *(const bf16x8*)(kp + (size_t)32 * PA_LD); k11 = *(const bf16x8*)(kp + (size_t)32 * PA_LD + 16); }
#pragma unroll 1
        for (int tt = wave; tt < NT; tt += NWAVES) {
            const int s0 = 64 * tt;
            const bf16x8 c00 = k00, c01 = k01, c10 = k10, c11 = k11;
            { const int tn = (tt + NWAVES < NT) ? tt + NWAVES : tt;
              const bf16* kp = PA + (size_t)(b * T + 64 * tn + rk) * PA_LD + C_IK + 8 * hh;
              k00 = *(const bf16x8*)kp; k01 = *(const bf16x8*)(kp + 16); k10 = *(const bf16x8*)(kp + (size_t)32 * PA_LD); k11 = *(const bf16x8*)(kp + (size_t)32 * PA_LD + 16); }
            f32x16 s0a, s1a;
#pragma unroll
            for (int i = 0; i < 16; ++i) { s0a[i] = 0.f; s1a[i] = 0.f; }
            bf16x8 q0 = *(const LAS bf16x8*)qr, q1 = *(const LAS bf16x8*)(qr + 32); unsigned iwb = *(const LAS unsigned short*)(qs + rk * 528 + 512);
#pragma unroll 1
            for (int h = 0; h < 8; ++h) {
                const int hn = (h + 1) & 7;
                const bf16x8 q0n = *(const LAS bf16x8*)(qr + 64 * hn), q1n = *(const LAS bf16x8*)(qr + 64 * hn + 32); const unsigned iwn = *(const LAS unsigned short*)(qs + rk * 528 + 512 + 2 * hn);
                const float iwh = __builtin_bit_cast(float, iwb << 16);
                f32x16 a0, a1;
#pragma unroll
                for (int i = 0; i < 16; ++i) { a0[i] = 0.f; a1[i] = 0.f; }
                a0 = MFMA32(c00, q0, a0); a0 = MFMA32(c01, q1, a0);
                a1 = MFMA32(c10, q0, a1); a1 = MFMA32(c11, q1, a1);
#pragma unroll
                for (int i = 0; i < 16; ++i) { s0a[i] = fmaf(iwh, fmaxf(a0[i], 0.f), s0a[i]); s1a[i] = fmaf(iwh, fmaxf(a1[i], 0.f), s1a[i]); }
                q0 = q0n; q1 = q1n; iwb = iwn;
            }
            float* sp = SC + (size_t)row * 2048 + s0 + 4 * hh;
#pragma unroll
            for (int g = 0; g < 4; ++g) { *(f32x4*)(sp + 8 * g) = (f32x4){s0a[4 * g], s0a[4 * g + 1], s0a[4 * g + 2], s0a[4 * g + 3]}; *(f32x4*)(sp + 32 + 8 * g) = (f32x4){s1a[4 * g], s1a[4 * g + 1], s1a[4 * g + 2], s1a[4 * g + 3]}; }
        }
    }
    __syncthreads();
#define SEL_CNT4(pred, a0_, a1_, a2_, a3_, thr_, acc_) do { unsigned long long m0_, m1_, m2_, m3_; \
        asm("v_cmp_" pred "_u32_e64 %0, %4, %8\n\tv_cmp_" pred "_u32_e64 %1, %5, %8\n\tv_cmp_" pred "_u32_e64 %2, %6, %8\n\tv_cmp_" pred "_u32_e64 %3, %7, %8" \
            : "=&s"(m0_), "=&s"(m1_), "=&s"(m2_), "=&s"(m3_) : "v"(a0_), "v"(a1_), "v"(a2_), "v"(a3_), "v"(thr_)); \
        acc_ += (__popcll(m0_) + __popcll(m1_)) + (__popcll(m2_) + __popcll(m3_)); } while (0)
    float nv[32];
    { const int t0 = 32 * qt + 4 * wave; int ls0 = lane; asm volatile("" : "+v"(ls0));
      if (t0 >= 256) { const float* srow = SC + (size_t)(b * T + t0) * 2048 + ls0; const int ng0 = (t0 >> 6) + 1;
#pragma unroll
          for (int g = 0; g < 4; ++g) if (8 * g < ng0) {
#pragma unroll
              for (int jj = 0; jj < 8; ++jj) nv[8 * g + jj] = srow[64 * (8 * g + jj)]; } } }
#pragma unroll 1
    for (int qi = 0; qi < 4; ++qi) {
        const int t = 32 * qt + 4 * wave + qi, row = b * T + t;
        unsigned long long* mrow = MASK + (size_t)row * 32;
        if (t < 256) {
            if (lane < 32) { const int lo = 64 * lane; unsigned long long m = 0ull; if (t >= lo + 63) m = ~0ull; else if (t >= lo) m = (2ull << (t - lo)) - 1ull; mrow[lane] = m; }
            continue;
        }
        int ls = lane; asm volatile("" : "+v"(ls));
        const int ng = (t >> 6) + 1;
        unsigned keys[32];
#pragma unroll
        for (int j = 0; j < 32; ++j) keys[j] = (64 * j + ls <= t) ? fkey(nv[j]) : 0u;
        if (qi < 3) { const float* srow = SC + (size_t)(row + 1) * 2048 + ls; const int ngn = ((t + 1) >> 6) + 1;
#pragma unroll
            for (int g = 0; g < 4; ++g) if (8 * g < ngn) {
#pragma unroll
                for (int jj = 0; jj < 8; ++jj) nv[8 * g + jj] = srow[64 * (8 * g + jj)]; } }
        unsigned tau = 0u;
#pragma unroll 1
        for (int bit = 31; bit >= 0; --bit) {
            const unsigned cand = tau | (1u << bit); int cnt = 0;
#pragma unroll
            for (int g = 0; g < 8; ++g) if (4 * g < ng) SEL_CNT4("ge", keys[4 * g], keys[4 * g + 1], keys[4 * g + 2], keys[4 * g + 3], cand, cnt);
            if (cnt >= 256) tau = cand;
            if (cnt == 256) break;
        }
        int need = 256;
#pragma unroll
        for (int g = 0; g < 8; ++g) if (4 * g < ng) { int c_ = 0; SEL_CNT4("gt", keys[4 * g], keys[4 * g + 1], keys[4 * g + 2], keys[4 * g + 3], tau, c_); need -= c_; }
#pragma unroll
        for (int j = 0; j < 32; ++j) {
            if (j >= ng) { if (lane == 0) mrow[j] = 0ull; continue; }
            unsigned long long eq, gt;
            asm("v_cmp_eq_u32_e64 %0, %2, %3\n\tv_cmp_gt_u32_e64 %1, %2, %3" : "=&s"(eq), "=&s"(gt) : "v"(keys[j]), "v"(tau));
            const int c = __popcll(eq); unsigned long long take;
            if (c <= need) { take = eq; need -= c; } else { take = __ballot((keys[j] == tau) && (mbcnt64(eq) < need)); need = 0; }
            if (lane == 0) mrow[j] = gt | take;
        }
    }
#undef SEL_CNT4
    __syncthreads();
}
constexpr int AT_K0 = 0, AT_K1 = 8192, AT_V0 = 16384, AT_V1 = 24576, AT_RB = 32768, MOBA_RBN = 2048 + 320;
__device__ __forceinline__ void moba_unit(const bf16* PA, const float* biasd, const float* KM, bf16* YB, int b, int h, int n, LAS unsigned char* lds, int tid, int wave, int lane) {
    const int r = lane & 31, hh = lane >> 5;
    const int t = 256 * n + 32 * wave + r, row = b * T + t;
    LAS float* RB = (LAS float*)(lds + AT_RB);
    __syncthreads();
    { int tf = tid; asm volatile("" : "+v"(tf)); float tv[4];
#pragma unroll
      for (int k = 0; k < 4; ++k) tv[k] = biasd[(16 + h) * 2048 + 2047 - (tf + NWAVES * 64 * k)];
#pragma unroll
      for (int k = 0; k < 4; ++k) RB[tf + NWAVES * 64 * k] = tv[k] * LOG2E;
      if (tf + 2048 < MOBA_RBN) RB[tf + 2048] = -INFINITY; }
    bf16x8 qf[4];
    const bf16* qp = PA + (size_t)row * PA_LD + C_QB + h * 64;
#pragma unroll
    for (int st = 0; st < 4; ++st) qf[st] = *(const bf16x8*)(qp + 16 * st + 8 * hh);
    unsigned selmask = (1u << n) - 1u;
    if (n > 3) {
        int z = 0; asm volatile("" : "+v"(z));
        float gv[8];
#pragma unroll
        for (int nn = 0; nn < 8; ++nn) gv[nn] = 0.f;
#pragma unroll 1
        for (int d8 = 0; d8 < 8; ++d8) {
            const v4u qv = *(const v4u*)(qp + 8 * d8);
            const float q0 = bflo(qv.x), q1 = bfhi(qv.x), q2 = bflo(qv.y), q3 = bfhi(qv.y), q4 = bflo(qv.z), q5 = bfhi(qv.z), q6 = bflo(qv.w), q7 = bfhi(qv.w);
#pragma unroll
            for (int nn = 0; nn < 7; ++nn) { const float* kmp = KM + ((b * 8 + nn) * 8 + h) * 64 + 8 * d8 + z; const f32x4 ka = *(const f32x4*)kmp, kb = *(const f32x4*)(kmp + 4);
                gv[nn] += (q0 * ka.x + q1 * ka.y) + (q2 * ka.z + q3 * ka.w) + (q4 * kb.x + q5 * kb.y) + (q6 * kb.z + q7 * kb.w); }
        }
#pragma unroll
        for (int nn = 0; nn < 8; ++nn) if (nn >= n) gv[nn] = -INFINITY;
        selmask = 0u;
#pragma unroll
        for (int rr = 0; rr < 3; ++rr) { int bi = 0; float bv = gv[0];
#pragma unroll
            for (int nn = 1; nn < 8; ++nn) if (gv[nn] > bv) { bv = gv[nn]; bi = nn; }
            selmask |= 1u << bi;
#pragma unroll
            for (int nn = 0; nn < 8; ++nn) if (nn == bi) gv[nn] = -INFINITY; }
    }
    f32x16 o[2];
#pragma unroll
    for (int i = 0; i < 16; ++i) { o[0][i] = 0.f; o[1][i] = 0.f; }
    float m = -INFINITY, l = 0.f;
    const int NT = 4 * (n + 1);
    const int skey = tid >> 3, sc = tid & 7;
    const bf16* Kg = PA + (size_t)(b * T + skey) * PA_LD + C_KB + h * 64 + sc * 8;
    const bf16* Vg = PA + (size_t)(b * T + skey) * PA_LD + C_VB + h * 64 + sc * 8;
    const int kwo = (sc * 64 + skey) * 16, vwo = (sc >> 2) * 4096 + skey * 64 + (sc & 3) * 16;
    v4u kreg = *(const v4u*)Kg, vreg = *(const v4u*)Vg;
    *(LAS v4u*)(lds + AT_K0 + kwo) = kreg; *(LAS v4u*)(lds + AT_V0 + vwo) = vreg;
    __syncthreads();
#pragma unroll 1
    for (int tt = 0; tt < NT; ++tt) {
        const int s0 = 64 * tt, buf = tt & 1;
        if (tt + 1 < NT) { kreg = *(const v4u*)(Kg + (size_t)(s0 + 64) * PA_LD); vreg = *(const v4u*)(Vg + (size_t)(s0 + 64) * PA_LD); }
        const bool own = (tt >> 2) == n;
        if (!own || s0 <= 256 * n + 32 * wave + 31) {
            f32x16 p0, p1;
            qk_tile<64>(lds + (buf ? AT_K1 : AT_K0), qf, p0, p1, r, hh);
            const int dl = t - s0 - 4 * hh;
            const bool selv = own || ((selmask >> (tt >> 2)) & 1u);
            const LAS float* rb = selv ? RB + (2047 - dl) : RB + 2176;
#pragma unroll
            for (int i = 0; i < 16; ++i) { const int c0 = (i & 3) + 8 * (i >> 2); p0[i] = fmaf(p0[i], QK_SCALE2, rb[c0]); p1[i] = fmaf(p1[i], QK_SCALE2, rb[c0 + 32]); }
            const float alpha = softmax_tile(p0, p1, m, l);
            if (__any(alpha != 1.0f)) {
#pragma unroll
                for (int i = 0; i < 16; ++i) { o[0][i] *= alpha; o[1][i] *= alpha; } }
            pv_tile<64>(lds + (buf ? AT_V1 : AT_V0), p0, p1, o, lane);
        }
        if (tt + 1 < NT) { *(LAS v4u*)(lds + (buf ? AT_K0 : AT_K1) + kwo) = kreg; *(LAS v4u*)(lds + (buf ? AT_V0 : AT_V1) + vwo) = vreg; }
        __syncthreads();
    }
    const float inv = 1.0f / xhalf_sum(l);
    unsigned char* yp = (unsigned char*)YB + (size_t)row * 2048 + 1024 + h * 64 + 4 * hh;
#pragma unroll
    for (int db = 0; db < 2; ++db)
#pragma unroll
        for (int g = 0; g < 4; ++g) *(unsigned*)(yp + 32 * db + 8 * g) = pk4f8(o[db][4 * g] * inv, o[db][4 * g + 1] * inv, o[db][4 * g + 2] * inv, o[db][4 * g + 3] * inv);
}
constexpr int SWA_RBN = 260;
__device__ __forceinline__ void swa_unit(const bf16* PA, const float* biasd, const float* sinks, bf16* YA, int b, int kvh, int qb, LAS unsigned char* lds, int tid, int wave, int lane) {
    const int r = lane & 31, hh = lane >> 5, g = wave >> 1, hq = kvh * 4 + g;
    const int t = 64 * qb + 32 * (wave & 1) + r, row = b * T + t;
    LAS float* RBall = (LAS float*)(lds + AT_RB);
    __syncthreads();
    { int tf = tid; asm volatile("" : "+v"(tf)); float tv[3];
#pragma unroll
      for (int k = 0; k < 3; ++k) { const int j = tf + NWAVES * 64 * k; const int jc = j < 4 * SWA_RBN ? j : 0; const int gg = jc / SWA_RBN, jj = jc - gg * SWA_RBN; tv[k] = biasd[(kvh * 4 + gg) * 2048 + ((jj >= 64 && jj < 192) ? 191 - jj : 0)]; }
#pragma unroll
      for (int k = 0; k < 3; ++k) { const int j = tf + NWAVES * 64 * k; if (j < 4 * SWA_RBN) { const int gg = j / SWA_RBN, jj = j - gg * SWA_RBN; RBall[j] = (jj >= 64 && jj < 192) ? tv[k] * LOG2E : -INFINITY; } } }
    const LAS float* RB = RBall + g * SWA_RBN;
    bf16x8 qf[4];
    const bf16* qp = PA + (size_t)row * PA_LD + C_QA + hq * 64;
#pragma unroll
    for (int st = 0; st < 4; ++st) qf[st] = *(const bf16x8*)(qp + 16 * st + 8 * hh);
    f32x16 o[2];
#pragma unroll
    for (int i = 0; i < 16; ++i) { o[0][i] = 0.f; o[1][i] = 0.f; }
    float m = -INFINITY, l = 0.f;
    const int tt0 = qb >= 2 ? qb - 2 : 0;
    const int skey = tid >> 3, sc = tid & 7;
    const bf16* Kg = PA + (size_t)(b * T + skey) * PA_LD + C_KA + kvh * 64 + sc * 8;
    const bf16* Vg = PA + (size_t)(b * T + skey) * PA_LD + C_VA + kvh * 64 + sc * 8;
    const int kwo = (sc * 64 + skey) * 16, vwo = (sc >> 2) * 4096 + skey * 64 + (sc & 3) * 16;
    v4u kreg = *(const v4u*)(Kg + (size_t)(64 * tt0) * PA_LD), vreg = *(const v4u*)(Vg + (size_t)(64 * tt0) * PA_LD);
    *(LAS v4u*)(lds + AT_K0 + kwo) = kreg; *(LAS v4u*)(lds + AT_V0 + vwo) = vreg;
    __syncthreads();
#pragma unroll 1
    for (int tt = tt0; tt <= qb; ++tt) {
        const int s0 = 64 * tt, buf = (tt - tt0) & 1;
        if (tt < qb) { kreg = *(const v4u*)(Kg + (size_t)(s0 + 64) * PA_LD); vreg = *(const v4u*)(Vg + (size_t)(s0 + 64) * PA_LD); }
        {
            f32x16 p0, p1;
            qk_tile<64>(lds + (buf ? AT_K1 : AT_K0), qf, p0, p1, r, hh);
            const int dl = t - s0 - 4 * hh;
            const LAS float* rb = RB + (191 - dl);
#pragma unroll
            for (int i = 0; i < 16; ++i) { const int c0 = (i & 3) + 8 * (i >> 2); p0[i] = fmaf(p0[i], QK_SCALE2, rb[c0]); p1[i] = fmaf(p1[i], QK_SCALE2, rb[c0 + 32]); }
            const float alpha = softmax_tile(p0, p1, m, l);
            if (__any(alpha != 1.0f)) {
#pragma unroll
                for (int i = 0; i < 16; ++i) { o[0][i] *= alpha; o[1][i] *= alpha; } }
            pv_tile<64>(lds + (buf ? AT_V1 : AT_V0), p0, p1, o, lane);
        }
        if (tt < qb) { *(LAS v4u*)(lds + (buf ? AT_K0 : AT_K1) + kwo) = kreg; *(LAS v4u*)(lds + (buf ? AT_V0 : AT_V1) + vwo) = vreg; }
        __syncthreads();
    }
    const float inv = 1.0f / (xhalf_sum(l) + __builtin_amdgcn_exp2f(sinks[hq] * LOG2E - m));
    unsigned char* yp = (unsigned char*)YA + (size_t)row * 2048 + hq * 64 + 4 * hh;
#pragma unroll
    for (int db = 0; db < 2; ++db)
#pragma unroll
        for (int gq = 0; gq < 4; ++gq) *(unsigned*)(yp + 32 * db + 8 * gq) = pk4f8(o[db][4 * gq] * inv, o[db][4 * gq + 1] * inv, o[db][4 * gq + 2] * inv, o[db][4 * gq + 3] * inv);
}
constexpr int DS_K0 = 0, DS_V0 = 16384, DS_K1 = 32768, DS_V1 = 49152, DS_RB = 65536, DS_RBN = 2048 + 128;
static_assert(DS_RB + 8 * DS_RBN * 4 <= LDSCTL_OFF, "DSA LDS map");
__device__ __forceinline__ bf16x8 pack8(const f32x4 a, const f32x4 b) { u32x4v w; w.x = pkbf(a.x, a.y); w.y = pkbf(a.z, a.w); w.z = pkbf(b.x, b.y); w.w = pkbf(b.z, b.w); return __builtin_bit_cast(bf16x8, w); }
__device__ __forceinline__ void dsa_unit(const bf16* CN, const bf16* PA, const unsigned long long* MASK, const float* biasd, const bf16* WUKB, const bf16* WUVT, bf16* YC, int b, int qt, LAS unsigned char* lds, int tid, int wave, int lane) {
    const int r = lane & 31, hh = lane >> 5, h = wave;
    const int t = 32 * qt + r, row = b * T + t;
    __syncthreads();
    static_assert(8 * DS_RBN == 34 * NWAVES * 64, "DSA bias table fill");
    { int tf = tid; asm volatile("" : "+v"(tf));
#pragma unroll 1
      for (int hfill = 0; hfill < 2; ++hfill) { float tv[17];
#pragma unroll
          for (int k = 0; k < 17; ++k) { const int j = tf + NWAVES * 64 * (17 * hfill + k); const int hd = j / DS_RBN, jj = j - hd * DS_RBN; tv[k] = biasd[(24 + hd) * 2048 + (jj < 2048 ? 2047 - jj : 0)]; }
#pragma unroll
          for (int k = 0; k < 17; ++k) { const int j = tf + NWAVES * 64 * (17 * hfill + k); const int hd = j / DS_RBN, jj = j - hd * DS_RBN; ((LAS float*)(lds + DS_RB))[j] = jj < 2048 ? tv[k] * LOG2E : 0.f; } } }
    const LAS float* RB = (const LAS float*)(lds + DS_RB) + h * DS_RBN;
    bf16x8 qa[8];
    { const bf16* qp = PA + (size_t)row * PA_LD + C_QC + h * 64;
      int rq = r; asm volatile("" : "+v"(rq));
      bf16x8 qh[4];
#pragma unroll
      for (int st = 0; st < 4; ++st) qh[st] = *(const bf16x8*)(qp + 16 * st + 8 * hh);
      bf16x8 wf[4];
#pragma unroll
      for (int st = 0; st < 4; ++st) wf[st] = *(const bf16x8*)(WUKB + ((size_t)h * 128 + rq) * 64 + 16 * st + 8 * hh);
#pragma unroll
      for (int cb = 0; cb < 4; ++cb) { f32x16 acc;
#pragma unroll
          for (int i = 0; i < 16; ++i) acc[i] = 0.f;
          bf16x8 cw[4];
#pragma unroll
          for (int st = 0; st < 4; ++st) cw[st] = wf[st];
          if (cb < 3) {
#pragma unroll
              for (int st = 0; st < 4; ++st) wf[st] = *(const bf16x8*)(WUKB + ((size_t)h * 128 + 32 * (cb + 1) + rq) * 64 + 16 * st + 8 * hh); }
#pragma unroll
          for (int st = 0; st < 4; ++st) acc = MFMA32(cw[st], qh[st], acc);
          qa[2 * cb] = pack8((f32x4){acc[0], acc[1], acc[2], acc[3]}, (f32x4){acc[4], acc[5], acc[6], acc[7]});
          qa[2 * cb + 1] = pack8((f32x4){acc[8], acc[9], acc[10], acc[11]}, (f32x4){acc[12], acc[13], acc[14], acc[15]});
          asm volatile("" ::: "memory"); } }
    f32x16 o[4];
#pragma unroll
    for (int db = 0; db < 4; ++db)
#pragma unroll
        for (int i = 0; i < 16; ++i) o[db][i] = 0.f;
    float m = -INFINITY, l = 0.f;
    const int NT = (qt >> 1) + 1;
    const int skey = tid >> 4, sc = tid & 15;
    const bf16* Cg = CN + (size_t)(b * T + skey) * 128 + sc * 8;
    const int kwo = (sc * 64 + skey) * 16, vwo = (sc >> 2) * 4096 + skey * 64 + (sc & 3) * 16;
    v4u c0r = *(const v4u*)Cg, c1r = *(const v4u*)(Cg + 32 * 128);
    *(LAS v4u*)(lds + DS_K0 + kwo) = c0r; *(LAS v4u*)(lds + DS_K0 + kwo + 512) = c1r; *(LAS v4u*)(lds + DS_V0 + vwo) = c0r; *(LAS v4u*)(lds + DS_V0 + vwo + 2048) = c1r;
    const unsigned long long* mrow = MASK + (size_t)row * 32;
    __syncthreads();
#pragma unroll 1
    for (int tt = 0; tt < NT; ++tt) {
        const int s0 = 64 * tt, buf = tt & 1;
        if (tt + 1 < NT) { c0r = *(const v4u*)(Cg + (size_t)(s0 + 64) * 128); c1r = *(const v4u*)(Cg + (size_t)(s0 + 96) * 128); }
        const unsigned long long mw = mrow[tt];
        {
            const LAS unsigned char* Kt = lds + DS_K0 + buf * 32768;
            f32x16 p0, p1;
#pragma unroll
            for (int i = 0; i < 16; ++i) { p0[i] = 0.f; p1[i] = 0.f; }
#pragma unroll
            for (int ks = 0; ks < 8; ++ks) {
                const LAS unsigned char* ka = Kt + ((2 * ks) * 64 + r) * 16 + 8 * hh;
                const s16x4 a0 = *(const LAS s16x4*)ka, a1 = *(const LAS s16x4*)(ka + 1024), b0 = *(const LAS s16x4*)(ka + 512), b1 = *(const LAS s16x4*)(ka + 1024 + 512);
                p0 = MFMA32(((bf16x8){a0[0], a0[1], a0[2], a0[3], a1[0], a1[1], a1[2], a1[3]}), qa[ks], p0);
                p1 = MFMA32(((bf16x8){b0[0], b0[1], b0[2], b0[3], b1[0], b1[1], b1[2], b1[3]}), qa[ks], p1);
                if ((ks & 3) == 3) asm volatile("" ::: "memory");
            }
            const int dl = t - s0 - 4 * hh;
            const LAS float* rb = RB + (2047 - dl);
            const unsigned wlo = (unsigned)mw >> (4 * hh), whi = (unsigned)(mw >> 32) >> (4 * hh);
#pragma unroll
            for (int i = 0; i < 16; ++i) { const int c0 = (i & 3) + 8 * (i >> 2);
                const float v0 = fmaf(p0[i], QK_SCALE2, rb[c0]), v1 = fmaf(p1[i], QK_SCALE2, rb[c0 + 32]);
                p0[i] = ((wlo >> c0) & 1u) ? v0 : -INFINITY; p1[i] = ((whi >> c0) & 1u) ? v1 : -INFINITY;
                if ((i & 3) == 3) asm volatile("" ::: "memory"); }
            const float alpha = softmax_tile(p0, p1, m, l);
            if (__any(alpha != 1.0f)) {
#pragma unroll
            for (int db = 0; db < 4; ++db)
#pragma unroll
                for (int i = 0; i < 16; ++i) o[db][i] *= alpha; }
            pv_tile<128>(lds + DS_V0 + buf * 32768, p0, p1, o, lane);
        }
        if (tt + 1 < NT) { LAS unsigned char* Kn = lds + DS_K0 + (32768 - buf * 32768); LAS unsigned char* Vn = lds + DS_V0 + (32768 - buf * 32768);
            *(LAS v4u*)(Kn + kwo) = c0r; *(LAS v4u*)(Kn + kwo + 512) = c1r; *(LAS v4u*)(Vn + vwo) = c0r; *(LAS v4u*)(Vn + vwo + 2048) = c1r; }
        __syncthreads();
    }
    const float inv = 1.0f / xhalf_sum(l);
    int re = r; asm volatile("" : "+v"(re));
    unsigned char* yp = (unsigned char*)YC + (size_t)(b * T + 32 * qt + re) * 2048 + 1536 + h * 64 + 4 * hh;
    s16x4 wn[2][2];
#define DS_WLD(dst, step_) do { _Pragma("unroll") for (int q_ = 0; q_ < 2; ++q_) { const int s_ = (step_) + q_, d2_ = s_ >> 3, k_ = s_ & 7; \
        const bf16* wp_ = WUVT + ((size_t)h * 64 + 32 * d2_ + re) * 128 + 16 * k_ + 4 * hh; dst[q_][0] = *(const s16x4*)wp_; dst[q_][1] = *(const s16x4*)(wp_ + 8); } } while (0)
    DS_WLD(wn, 0);
    f32x16 acc;
#pragma unroll
    for (int sp = 0; sp < 8; ++sp) {
        s16x4 wc[2][2];
#pragma unroll
        for (int q = 0; q < 2; ++q) { wc[q][0] = wn[q][0]; wc[q][1] = wn[q][1]; }
        if (sp < 7) DS_WLD(wn, 2 * sp + 2);
        if ((sp & 3) == 0) {
#pragma unroll
            for (int i = 0; i < 16; ++i) acc[i] = 0.f; }
#pragma unroll
        for (int q = 0; q < 2; ++q) { const int ks = 2 * (sp & 3) + q; const int cb = ks >> 1, b0 = 8 * (ks & 1);
            const bf16x8 ob = pack8((f32x4){o[cb][b0] * inv, o[cb][b0 + 1] * inv, o[cb][b0 + 2] * inv, o[cb][b0 + 3] * inv}, (f32x4){o[cb][b0 + 4] * inv, o[cb][b0 + 5] * inv, o[cb][b0 + 6] * inv, o[cb][b0 + 7] * inv});
            const s16x4 w0 = wc[q][0], w1 = wc[q][1];
            const bf16x8 wf = (bf16x8){w0[0], w0[1], w0[2], w0[3], w1[0], w1[1], w1[2], w1[3]};
            acc = MFMA32(wf, ob, acc); }
        asm volatile("" ::: "memory");
        if ((sp & 3) == 3) { const int db2 = sp >> 2;
#pragma unroll
            for (int g = 0; g < 4; ++g) *(unsigned*)(yp + 32 * db2 + 8 * g) = pk4f8(acc[4 * g], acc[4 * g + 1], acc[4 * g + 2], acc[4 * g + 3]); }
    }
#undef DS_WLD
}
#ifndef NREP_ROUTE
#define NREP_ROUTE 1
#endif
constexpr int PU_RI = 0, PU_RG = 16384, PU_RSTD = 32768, PU_TOP = 33024, PU_EX = PU_TOP + 8 * 8192, PU_END = PU_EX + 8 * 4096;
static_assert(PU_END <= LDSCTL_OFF, "PEER unit LDS map");
#define CE_DESC(a, b) do { const unsigned hi_ = (a) > (b) ? (a) : (b); (b) = (a) > (b) ? (b) : (a); (a) = hi_; } while (0)
template <int B, typename A> __device__ __forceinline__ void sort16_desc(A& v) {
#pragma unroll
    for (int ks = 1; ks <= 4; ++ks)
#pragma unroll
        for (int js = ks - 1; js >= 0; --js)
#pragma unroll
            for (int i = 0; i < 16; ++i) { const int k = 1 << ks, j = 1 << js, l = i ^ j; if (l > i) { if ((i & k) == 0) CE_DESC(v[B + i], v[B + l]); else CE_DESC(v[B + l], v[B + i]); } }
}
template <int B0, int B1, typename A> __device__ __forceinline__ void merge16_desc(A& v) {
#pragma unroll
    for (int i = 0; i < 16; ++i) v[B0 + i] = v[B0 + i] > v[B1 + 15 - i] ? v[B0 + i] : v[B1 + 15 - i];
#pragma unroll
    for (int js = 3; js >= 0; --js)
#pragma unroll
        for (int i = 0; i < 16; ++i) { const int j = 1 << js, l = i ^ j; if (l > i) CE_DESC(v[B0 + i], v[B0 + l]); }
}
template <typename A> __device__ __forceinline__ void top16_of_64(A& v) {
    sort16_desc<0>(v); sort16_desc<16>(v); merge16_desc<0, 16>(v);
    sort16_desc<32>(v); sort16_desc<48>(v); merge16_desc<32, 48>(v);
    merge16_desc<0, 32>(v);
}
__device__ __forceinline__ void peer_route(const Ptrs& P, int l, int unit, LAS unsigned char* lds, int tid, int wave, int lane) {
    unsigned char* ws = P.ws;
    float* RSTD = (float*)(ws + WS_RSTD) + unit * 32; int* RI = (int*)(ws + WS_RI) + (size_t)unit * 32 * 128; float* RG = (float*)(ws + WS_RG) + (size_t)unit * 32 * 128;
    const bf16* QP = (const bf16*)(ws + WS_QP);
    const int r0 = unit * 32;
    const float* rowssB = (const float*)(ws + WS_ROWSSB);
    __syncthreads();
#pragma unroll 1
    for (int rrep = 0; rrep < NREP_ROUTE; ++rrep)
    {
        const int r = lane & 31, hh = lane >> 5, h = wave;
        const bf16* SKB = (const bf16*)(ws + WS_SKB) + (size_t)(l * 8 + h) * 2 * 16384;
        float rs; { const float* pp = rowssB + (size_t)(r0 + r) * 32; float a = 0.f;
#pragma unroll
            for (int j = 0; j < 8; ++j) { const f32x4 v = *(const f32x4*)(pp + 4 * j); a += (v.x + v.y) + (v.z + v.w); }
            rs = rsqrtf(a * (1.0f / 2048.0f) + EPS); }
        if (hh == 0 && h == 0) RSTD[r] = rs;
        LAS float* EXL = (LAS float*)(lds + PU_EX) + wave * 1024;
        LAS unsigned* TOPL = (LAS unsigned*)(lds + PU_TOP) + wave * 2048;
#pragma unroll 1
        for (int p = 0; p < 2; ++p) {
            bf16x8 qf[8];
            { int rq = r; asm volatile("" : "+v"(rq)); const bf16* qr2 = QP + (size_t)(r0 + rq) * 2048 + h * 256 + p * 128 + 8 * hh;
#pragma unroll
            for (int st = 0; st < 8; ++st) qf[st] = *(const bf16x8*)(qr2 + 16 * st); }
            unsigned kv[64];
            int rk = r; asm volatile("" : "+v"(rk));
            const bf16* skp = SKB + ((size_t)p * 128 + rk) * 128 + 8 * hh;
            bf16x8 sf[8];
#pragma unroll
            for (int st = 0; st < 8; ++st) sf[st] = *(const bf16x8*)(skp + 16 * st);
#pragma unroll
            for (int kb = 0; kb < 4; ++kb) {
                f32x16 acc;
#pragma unroll
                for (int i = 0; i < 16; ++i) acc[i] = 0.f;
                bf16x8 cf[8];
#pragma unroll
                for (int st = 0; st < 8; ++st) cf[st] = sf[st];
                if (kb < 3) {
#pragma unroll
                    for (int st = 0; st < 8; ++st) sf[st] = *(const bf16x8*)(skp + (size_t)(32 * (kb + 1)) * 128 + 16 * st); }
#pragma unroll
                for (int st = 0; st < 8; ++st) acc = MFMA32(cf[st], qf[st], acc);
#pragma unroll
                for (int i = 0; i < 16; ++i) kv[16 * kb + i] = (fkey(acc[i]) & ~127u) | (unsigned)(127 - (32 * kb + (i & 3) + 8 * (i >> 2) + 4 * hh));
                asm volatile("" ::: "memory");
            }
            top16_of_64(kv);
#pragma unroll
            for (int i = 0; i < 16; ++i) { const unsigned own = kv[i]; auto rr = __builtin_amdgcn_permlane32_swap(own, own, false, false); kv[16 + i] = (rr[0] == own) ? rr[1] : rr[0]; }
            merge16_desc<0, 16>(kv);
#pragma unroll
            for (int it = 0; it < 16; ++it) TOPL[(p * 16 + it) * 64 + lane] = kv[it];
        }
        LDS_WAIT(); asm volatile("" ::: "memory");
        unsigned ck[64];
        { float sa[16], sb[16];
#pragma unroll
          for (int j = 0; j < 16; ++j) { sa[j] = funkey(TOPL[j * 64 + lane] & ~127u); sb[j] = funkey(TOPL[(16 + j) * 64 + lane] & ~127u); }
          int pi = 0;
#pragma unroll
          for (int a = 0; a < 16; ++a)
#pragma unroll
              for (int bq = 0; bq < 16; ++bq) if ((a + 1) * (bq + 1) <= 16) { ck[pi] = (fkey(sa[a] + sb[bq]) & ~255u) | (unsigned)(255 - (a * 16 + bq)); ++pi; }
#pragma unroll
          for (int i = 50; i < 64; ++i) ck[i] = 0u; }
        top16_of_64(ck);
        float mx = 0.f, sm = 0.f;
#pragma unroll
        for (int it = 0; it < 16; ++it) {
            const unsigned m = ck[it];
            const int ab = 255 - (int)(m & 255u), a = ab >> 4, bq = ab & 15;
            const unsigned ka = TOPL[a * 64 + lane], kb2 = TOPL[(16 + bq) * 64 + lane];
            const float sc = funkey(m & ~255u) * rs;
            if (it == 0) mx = sc;
            const float e = __expf(sc - mx); sm += e;
            EXL[it * 64 + lane] = e;
            if (hh == 0) RI[r * 128 + h * 16 + it] = (127 - (int)(ka & 127u)) * 128 + (127 - (int)(kb2 & 127u));
        }
        LDS_WAIT(); asm volatile("" ::: "memory");
        const float inv = 1.0f / sm;
        if (hh == 0) {
#pragma unroll
            for (int it = 0; it < 16; ++it) RG[r * 128 + h * 16 + it] = EXL[it * 64 + lane] * inv;
        }
        LDS_WAIT(); asm volatile("" ::: "memory");
    }
}

#define PU_ISSUE(dst, eis, r0_) do { _Pragma("unroll") for (int rd = 0; rd < 4; ++rd) { const v4u* up = (const v4u*)(U6s + ((unsigned)eis[(r0_) + rd] * 192u + 16u * (unsigned)piece)); dst[rd][0] = up[0]; dst[rd][1] = up[4]; dst[rd][2] = up[8]; } } while (0)
#define PU_COMP(src, r0_) do { _Pragma("unroll") for (int rd = 0; rd < 4; ++rd) { \
        const v4u r0 = src[rd][0], r1 = src[rd][1], r2 = src[rd][2]; \
        const v6i_t ca = {(int)r0.x, (int)r0.y, (int)r0.z, (int)r0.w, (int)r1.x, (int)r1.y}, cb = {(int)r1.z, (int)r1.w, (int)r2.x, (int)r2.y, (int)r2.z, (int)r2.w}; \
        const v16u_t ua = __builtin_bit_cast(v16u_t, __builtin_amdgcn_cvt_scalef32_pk32_bf16_fp6(ca, 1.0f)), ub = __builtin_bit_cast(v16u_t, __builtin_amdgcn_cvt_scalef32_pk32_bf16_fp6(cb, 1.0f)); \
        float a0 = 0.f, a1 = 0.f, a2 = 0.f, a3 = 0.f; \
        _Pragma("unroll") for (int k = 0; k < 8; ++k) { a0 = dot2(ua[2 * k], xq[k].x, a0); a1 = dot2(ua[2 * k + 1], xq[k].y, a1); a2 = dot2(ub[2 * k], xq[k].z, a2); a3 = dot2(ub[2 * k + 1], xq[k].w, a3); } \
        float d = (a0 + a1) + (a2 + a3); d += lane_xor<1>(d); d += lane_xor<2>(d); \
        dd[(r0_) + rd] = d; } } while (0)
#define PU_SB() do { asm volatile("" ::: "memory"); __builtin_amdgcn_sched_barrier(0); } while (0)
__device__ __forceinline__ void peer_u_pass(const Ptrs& P, int l, int G, int vbx, int wave, int lane) {
    unsigned char* ws = P.ws;
    const int xs = vbx & 7, wr = vbx >> 3, nW = G >> 3;
    const int* RI = (const int*)(ws + WS_RI); float* PD = (float*)(ws + WS_PD); const bf16* XB = (const bf16*)(ws + WS_XB);
    const int slot = lane >> 2, piece = lane & 3;
    const int tstep = nW * NWAVES;
    const unsigned char* U6s = ws + WS_U + (size_t)l * TBL_LAYER + (size_t)xs * TBL_SLICE;
    int t = wr * NWAVES + wave;
    v4u xq[8], rowsA[4][3], rowsB[4][3]; int ein[8];
    { int e0[8]; const int* ri = RI + (size_t)t * 128 + slot;
#pragma unroll
      for (int rd = 0; rd < 8; ++rd) e0[rd] = ri[16 * rd];
      const int t1 = (t + tstep < M) ? t + tstep : t; const int* rn = RI + (size_t)t1 * 128 + slot; const bf16* xr = XB + (size_t)t * 2048 + 256 * xs + 8 * piece;
#pragma unroll
      for (int rd = 0; rd < 8; ++rd) ein[rd] = rn[16 * rd];
#pragma unroll
      for (int k = 0; k < 8; ++k) xq[k] = *(const v4u*)(xr + 32 * k);
      PU_SB();
      PU_ISSUE(rowsA, e0, 0); PU_ISSUE(rowsB, e0, 4); PU_SB(); }
#pragma unroll 1
    for (; t < M; t += tstep) {
        const int t1 = (t + tstep < M) ? t + tstep : t, t2 = (t + 2 * tstep < M) ? t + 2 * tstep : t1;
        v4u xn[8]; int ei2[8];
        { const int* ri = RI + (size_t)t2 * 128 + slot; const bf16* xr = XB + (size_t)t1 * 2048 + 256 * xs + 8 * piece;
#pragma unroll
          for (int rd = 0; rd < 8; ++rd) ei2[rd] = ri[16 * rd];
#pragma unroll
          for (int k = 0; k < 8; ++k) xn[k] = *(const v4u*)(xr + 32 * k); }
        float* pd = PD + ((size_t)xs * M + t) * 128 + slot;
        float dd[8];
        PU_SB(); PU_COMP(rowsA, 0); PU_SB();
        PU_ISSUE(rowsA, ein, 0); PU_SB();
        PU_COMP(rowsB, 4); PU_SB();
        PU_ISSUE(rowsB, ein, 4); PU_SB();
        if (piece == 0) {
#pragma unroll
            for (int rd = 0; rd < 8; ++rd) pd[16 * rd] = dd[rd]; }
#pragma unroll
        for (int k = 0; k < 8; ++k) xq[k] = xn[k];
#pragma unroll
        for (int rd = 0; rd < 8; ++rd) ein[rd] = ei2[rd];
    }
}
#undef PU_ISSUE
#undef PU_COMP
#undef PU_SB
__device__ __forceinline__ void peer_combine(const Ptrs& P, int l, int gw, int NGW, int lane) {
    unsigned char* ws = P.ws;
    const int* RI = (const int*)(ws + WS_RI); const float* RG = (const float*)(ws + WS_RG); const float* PD = (const float*)(ws + WS_PD); unsigned* W = (unsigned*)(ws + WS_W);
    const f32x2v* SCL = (const f32x2v*)(ws + WS_USC) + l * 16384; const float* RSTD = (const float*)(ws + WS_RSTD);
    float pd[2][8], rg[2], rstd; int ei[2];
    int z = 0; asm volatile("" : "+v"(z));
#define PC_LOAD(t_) do { rstd = RSTD[(t_) + z]; _Pragma("unroll") for (int hf = 0; hf < 2; ++hf) { const int k = lane + 64 * hf; \
        _Pragma("unroll") for (int sl = 0; sl < 8; ++sl) pd[hf][sl] = PD[((size_t)sl * M + (t_)) * 128 + k]; \
        ei[hf] = RI[(size_t)(t_) * 128 + k]; rg[hf] = RG[(size_t)(t_) * 128 + k]; } } while (0)
    if (gw < M) PC_LOAD(gw);
#pragma unroll 1
    for (int t = gw; t < M; t += NGW) {
        const float rs = rstd; const int e0 = ei[0], e1 = ei[1]; const float g0 = rg[0], g1 = rg[1];
        float a0 = 0.f, a1 = 0.f;
#pragma unroll
        for (int sl = 0; sl < 8; ++sl) { a0 += pd[0][sl]; a1 += pd[1][sl]; }
        const f32x2v s0 = SCL[e0], s1 = SCL[e1];
        { const int tn = (t + NGW < M) ? t + NGW : t; PC_LOAD(tn); }
        const float w0 = g0 * gelu_tanh(a0 * s0.x * rs) * s0.y, w1 = g1 * gelu_tanh(a1 * s1.x * rs) * s1.y;
        W[(size_t)t * 128 + lane] = (pk2(w0, 0.f) << 16) | (unsigned)e0; W[(size_t)t * 128 + lane + 64] = (pk2(w1, 0.f) << 16) | (unsigned)e1;
    }
#undef PC_LOAD
}
#define PV_LOAD(dst, k0) do { const v4u eq0_ = *(const LAS v4u*)(ELb + qd * 128 + (k0)), eq1_ = *(const LAS v4u*)(ELb + qd * 128 + (k0) + 4); \
    _Pragma("unroll") for (int kk = 0; kk < 8; ++kk) { const unsigned ei_ = (kk < 4 ? eq0_[kk & 3] : eq1_[kk & 3]) & 0xffffu; const unsigned char* rp_ = V6s + (ei_ * 192u + c8o); \
        dst[kk][0] = *(const u32x2v*)rp_; dst[kk][1] = *(const u32x2v*)(rp_ + 64); dst[kk][2] = *(const u32x2v*)(rp_ + 128); } } while (0)
#define PV_FMA(src, k0) do { const v4u wq0_ = *(const LAS v4u*)(ELb + qd * 128 + (k0)), wq1_ = *(const LAS v4u*)(ELb + qd * 128 + (k0) + 4); \
    _Pragma("unroll") for (int kk = 0; kk < 8; ++kk) { const float w_ = __builtin_bit_cast(float, (kk < 4 ? wq0_[kk & 3] : wq1_[kk & 3]) & 0xffff0000u); const f32x2v wk_ = (f32x2v){w_, w_}; \
        const v6i_t c_ = {(int)src[kk][0].x, (int)src[kk][0].y, (int)src[kk][1].x, (int)src[kk][1].y, (int)src[kk][2].x, (int)src[kk][2].y}; \
        const v32f_t d_ = __builtin_amdgcn_cvt_scalef32_pk32_f32_fp6(c_, 1.0f); \
        _Pragma("unroll") for (int i_ = 0; i_ < 16; ++i_) o[i_] = (f32x2v){d_[2 * i_], d_[2 * i_ + 1]} * wk_ + o[i_]; \
        __builtin_amdgcn_sched_barrier(0); } } while (0)
__device__ __forceinline__ void peer_v_pass(const Ptrs& P, int l, int G, int vbx, LAS unsigned char* lds, int wave, int lane) {
    unsigned char* ws = P.ws;
    const int xs = vbx & 7, wr = vbx >> 3, nW = G >> 3;
    const unsigned* W = (const unsigned*)(ws + WS_W);
    bf16* XB = (bf16*)(ws + WS_XB); float* RS = (float*)(ws + WS_RS);
    const int gstep = nW * NWAVES;
    const unsigned char* V6s = ws + WS_V + (size_t)l * TBL_LAYER + (size_t)xs * TBL_SLICE;
    int tg = wr * NWAVES + wave, par = 0;
    { LAS unsigned* EL0 = (LAS unsigned*)(lds + wave * 8192);
      const unsigned* wp = W + (size_t)(8 * tg) * 128;
      int ln0 = lane; asm volatile("" : "+v"(ln0));
#pragma unroll
      for (int j = 0; j < 16; ++j) EL0[ln0 + 64 * j] = wp[ln0 + 64 * j]; }
    LDS_WAIT(); asm volatile("" ::: "memory");
#pragma unroll 1
    for (; tg < M / 8; tg += gstep, par ^= 1) {
        const LAS unsigned* ELb = (const LAS unsigned*)(lds + wave * 8192 + par * 4096);
        int ln = lane; asm volatile("" : "+v"(ln));
        const int qd = ln >> 3, b8 = ln & 7;
        const unsigned c8o = 8u * (unsigned)b8;
        const int t = 8 * tg + qd;
        u32x2v vA[8][3], vB[8][3];
        PV_LOAD(vA, 0);
        unsigned nel[16];
        { const int tgn = (tg + gstep < M / 8) ? tg + gstep : tg;
          const unsigned* wp = W + (size_t)(8 * tgn) * 128;
#pragma unroll
          for (int j = 0; j < 16; ++j) nel[j] = wp[ln + 64 * j]; }
        const size_t col0 = (size_t)t * 2048 + 256 * xs + 4 * b8;
        u32x2v xres[8];
#pragma unroll
        for (int k = 0; k < 8; ++k) xres[k] = *(const u32x2v*)(XB + col0 + 32 * k);
        f32x2v o[16];
#pragma unroll
        for (int i = 0; i < 16; ++i) o[i] = (f32x2v){0.f, 0.f};
#define PV_SB() do { asm volatile("" ::: "memory"); __builtin_amdgcn_sched_barrier(0); } while (0)
        PV_SB(); PV_LOAD(vB, 8); PV_FMA(vA, 0); PV_SB();
        PV_LOAD(vA, 16); PV_FMA(vB, 8); PV_SB();
        PV_LOAD(vB, 24); PV_FMA(vA, 16); PV_SB();
        PV_LOAD(vA, 32); PV_FMA(vB, 24); PV_SB();
        PV_LOAD(vB, 40); PV_FMA(vA, 32); PV_SB();
        PV_LOAD(vA, 48); PV_FMA(vB, 40); PV_SB();
        PV_LOAD(vB, 56); PV_FMA(vA, 48); PV_SB();
        PV_LOAD(vA, 64); PV_FMA(vB, 56); PV_SB();
        PV_LOAD(vB, 72); PV_FMA(vA, 64); PV_SB();
        PV_LOAD(vA, 80); PV_FMA(vB, 72); PV_SB();
        PV_LOAD(vB, 88); PV_FMA(vA, 80); PV_SB();
        PV_LOAD(vA, 96); PV_FMA(vB, 88); PV_SB();
        PV_LOAD(vB, 104); PV_FMA(vA, 96); PV_SB();
        PV_LOAD(vA, 112); PV_FMA(vB, 104); PV_SB();
        PV_LOAD(vB, 120); PV_FMA(vA, 112); PV_SB();
        PV_FMA(vB, 120); PV_SB();
#undef PV_SB
        { LAS unsigned* ELn = (LAS unsigned*)(lds + wave * 8192 + (par ^ 1) * 4096);
#pragma unroll
          for (int j = 0; j < 16; ++j) ELn[ln + 64 * j] = nel[j]; }
        LDS_WAIT(); asm volatile("" ::: "memory");
        float ss = 0.f;
#pragma unroll
        for (int k = 0; k < 8; ++k) {
            const u32x2v xa = xres[k];
            const f32x4 na = (f32x4){bflo(xa.x) + o[2 * k].x, bfhi(xa.x) + o[2 * k].y, bflo(xa.y) + o[2 * k + 1].x, bfhi(xa.y) + o[2 * k + 1].y};
            u32x2v pk; pk.x = pk2(na.x, na.y); pk.y = pk2(na.z, na.w); *(u32x2v*)(XB + col0 + 32 * k) = pk;
            int w0 = __builtin_amdgcn_cvt_pk_fp8_f32(na.x, na.y, 0, false); w0 = __builtin_amdgcn_cvt_pk_fp8_f32(na.z, na.w, w0, true);
            *(unsigned*)(ws + WS_XB8 + col0 + 32 * k) = (unsigned)w0;
            ss += (na.x * na.x + na.y * na.y) + (na.z * na.z + na.w * na.w); }
        ss += lane_xor<1>(ss); ss += lane_xor<2>(ss); ss += lane_xor<4>(ss);
        if (b8 == 0) RS[t * 16 + xs] = ss;
    }
}
#undef PV_LOAD
#undef PV_FMA
__device__ __forceinline__ void final_norm(const Ptrs& P, int gw, int NGW, int lane) {
    const float* RS = (const float*)(P.ws + WS_RS);
#pragma unroll 1
    for (int t = gw; t < M; t += NGW) {
        const float pv = lane < 16 ? RS[t * 16 + lane] : 0.f;
        const float rf = rsqrtf(wave_sum(pv) * (1.0f / 2048.0f) + EPS);
        const bf16* xr = (const bf16*)(P.ws + WS_XB) + (size_t)t * 2048; float* orow = P.out + (size_t)t * 2048;
#pragma unroll
        for (int i = 0; i < 4; ++i) { const int e0 = 8 * (lane + 64 * i); const v4u v = *(const v4u*)(xr + e0); const f32x4 g0 = *(const f32x4*)(P.g_final + e0), g1 = *(const f32x4*)(P.g_final + e0 + 4);
            *(f32x4*)(orow + e0) = (f32x4){bflo(v.x) * rf * g0.x, bfhi(v.x) * rf * g0.y, bflo(v.y) * rf * g0.z, bfhi(v.y) * rf * g0.w};
            *(f32x4*)(orow + e0 + 4) = (f32x4){bflo(v.z) * rf * g1.x, bfhi(v.z) * rf * g1.y, bflo(v.w) * rf * g1.z, bfhi(v.w) * rf * g1.w}; }
    }
}
#ifndef MK_PER_PHASE
#define MK_PER_PHASE 0
#endif
struct Args { const float* in[18]; float* out; unsigned char* ws; int ph_lo, ph_hi; };
__global__ void __launch_bounds__(NWAVES * 64, 2) mega_fwd(Args args) {
    extern __shared__ __attribute__((aligned(16))) unsigned char lds_raw[];
    LAS unsigned char* lds = (LAS unsigned char*)lds_raw;
    const int tid0 = threadIdx.x, wave = __builtin_amdgcn_readfirstlane(tid0 >> 6);
    const int G = gridDim.x, bx = blockIdx.x; const int vcu0 = (G % 8 == 0) ? (bx % 8) * (G / 8) + bx / 8 : bx;
    const int gw0 = vcu0 * NWAVES + wave, NGW = G * NWAVES;
    Ptrs P;
    P.x = args.in[0]; P.rel_bias = args.in[1]; P.g_mix = args.in[2]; P.w_in = args.in[3]; P.a_sinks = args.in[4]; P.c_gain = args.in[5]; P.w_uk = args.in[6]; P.w_uv = args.in[7];
    P.w_a = args.in[8]; P.w_b = args.in[9]; P.w_c = args.in[10]; P.w_out = args.in[11]; P.g_ffn = args.in[12]; P.w_q = args.in[13]; P.sub_keys = args.in[14]; P.peer_u = args.in[15]; P.peer_v = args.in[16]; P.g_final = args.in[17];
    P.out = args.out; P.ws = args.ws;
    unsigned char* ws = args.ws;
    gu32* ctl = (gu32*)(ws + WS_CTL);
    for (int u = tid0; u < (LDS_BYTES - LDSCTL_OFF) / 4; u += NWAVES * 64) ((LAS unsigned*)(lds + LDSCTL_OFF))[u] = 0u;
    __syncthreads();
    volatile LAS unsigned* MISC = (volatile LAS unsigned*)(lds + MISC_OFF);
    XcdBarrier bar; bar.bar = (unsigned*)(ctl + CW_BAR); bar.x = 0; bar.st = nullptr;
    if (!MK_PER_PHASE) bar = xcd_barrier_post((unsigned*)(ctl + CW_BAR), MISC + 8);
    const int lo = args.ph_lo, hi = args.ph_hi;
#ifndef PH_MASK
#define PH_MASK 0xffff
#endif
#define IN(k) (lo <= (k) && (k) < hi)
#define EN(j) ((PH_MASK >> (j)) & 1)
#ifndef REP_MASK
#define REP_MASK 0
#endif
#define NREP(j) (((REP_MASK >> (j)) & 1) ? 2 : 1)
#define SEAM(k) do { if (IN(k) && IN((k) + 1)) xcd_barrier(bar); } while (0)
    bf16* XB = (bf16*)(ws + WS_XB); bf16* PA = (bf16*)(ws + WS_PA); bf16* GT = (bf16*)(ws + WS_GT); bf16* MG = (bf16*)(ws + WS_MG); bf16* QP = (bf16*)(ws + WS_QP);
    bf16* YA = (bf16*)(ws + WS_YA); bf16* YB = YA; bf16* YC = YA; bf16* CN = (bf16*)(ws + WS_CN);
    unsigned long long* MASK = (unsigned long long*)(ws + WS_MASK);
    float* rowssA = (float*)(ws + WS_RS); const float* biasd = (const float*)(ws + WS_BIASD);
    LAS unsigned char* wscr = lds + wave * 16384;

#define FRESH() int lane = lane_id_(); asm volatile("" : "+v"(lane)); int tid = wave * 64 + lane; (void)tid
    if (EN(0) && IN(0)) { FRESH(); for (int rep = 0; rep < NREP(0); ++rep) p0_prologue(P, lds, gw0, NGW, wave, lane); }
    SEAM(0);
    const bool loc = !MK_PER_PHASE && (G == 256) && (MISC[10] == 1u);
    const int X = __builtin_amdgcn_readfirstlane(loc ? (int)bar.x : (bx & 7)), J = __builtin_amdgcn_readfirstlane(loc ? (int)MISC[11] : (bx >> 3));
    const int vbx = (G == 256) ? J * 8 + X : bx;
    const int vcu = (G == 256) ? X * 32 + J : vcu0;
    const int gw = vcu * NWAVES + wave;
#define SEAML(k) do { if (IN(k) && IN((k) + 1)) { if (loc) xcd_barrier_local(bar); else xcd_barrier(bar); } } while (0)
#pragma unroll 1
    for (int l = 0; l < DEPTH; ++l) {
        const int pb = 1 + 10 * l;
        float* KM = (float*)(ws + WS_KMEAN) + (size_t)l * 32768;
        float* rowssB = (float*)(ws + WS_ROWSSB);
        if (EN(1) && IN(pb + 0)) {
#pragma unroll 1
            for (int rep = 0; rep < NREP(1); ++rep) {
            { pg8::Gemm g{XB, (const bf16*)(ws + WS_WIN) + (size_t)l * NPROJ * 2048, M, 4096, 2048}; pg8::SplitOrder S; S.init(G, vbx, true);
              pg8::EpiProj E{PA, KM, rowssA};
              pg8::gemm_phase<pg8::EpiProj, pg8::SplitOrder, true, true>(lds, g, S, E, wave); }
            { pg8::Gemm g{(const bf16*)(ws + WS_XB8), (const bf16*)(ws + WS_WG8 + (size_t)l * NPROJ * 2048), M, NPROJ, 2048}; pg8::SplitOrder S; S.init(G, vbx, false);
              pg8::EpiIn8 E{PA, (unsigned char*)GT, rowssA};
              pg8::gemm_phase<pg8::EpiIn8, pg8::SplitOrder, true, true, true>(lds, g, S, E, wave); }
            }
        }
        SEAML(pb + 0);
        if (EN(2) && IN(pb + 1)) { FRESH();
#pragma unroll 1
            for (int rep = 0; rep < NREP(2); ++rep)
#pragma unroll 1
            for (int u = vcu; u < 512; u += G) {
                const int bb = (u & 255) >> 5, ii = u & 31, qt = (u < 256) ? ii : 63 - ii;
                sel_unit(PA, (float*)(ws + WS_SC), MASK, bb, qt, lds, tid, wave, lane);
            }
            if (G == 256) { for (int k = 0; k < 2; ++k) cn_item(PA, P.c_gain + l * 128, CN, X * 512 + J * 8 + wave + 256 * k, lane); }
            else for (int i = gw; i < M / 4; i += NGW) cn_item(PA, P.c_gain + l * 128, CN, i, lane);
#pragma unroll 1
            for (int rep = 0; rep < NREP(3); ++rep)
#pragma unroll 1
            for (int u = vcu, k = 0; u < 1024; u += G, ++k) { if (G == 256) swa_unit(PA, biasd, P.a_sinks + l * 16, YA, X, k, J, lds, tid, wave, lane);
                else swa_unit(PA, biasd, P.a_sinks + l * 16, YA, u >> 7, (u >> 5) & 3, u & 31, lds, tid, wave, lane); }
            __syncthreads();
        }
        SEAML(pb + 1);
        if (EN(3) && IN(pb + 2)) { FRESH();
#pragma unroll 1
            for (int rep = 0; rep < NREP(4); ++rep)
#pragma unroll 1
            for (int u = vcu; u < 512; u += G) {
                const int bb = (u & 255) >> 5, ii = u & 31, qt = (u < 256) ? ii : 63 - ii;
                dsa_unit(CN, PA, MASK, biasd, (const bf16*)(ws + WS_WUKB) + (size_t)l * 65536, (const bf16*)(ws + WS_WUVT) + (size_t)l * 65536, YC, bb, qt, lds, tid, wave, lane);
            }
            __syncthreads();
#pragma unroll 1
            for (int rep = 0; rep < NREP(5); ++rep)
#pragma unroll 1
            for (int u = vcu; u < 512; u += G) {
                const int bh = (u & 255) >> 2, pr = u & 3, nblk = (u < 256) ? pr : 7 - pr;
                moba_unit(PA, biasd, KM, YB, bh >> 3, bh & 7, nblk, lds, tid, wave, lane);
            }
            __syncthreads();
        }
        SEAML(pb + 2);
        if (EN(4) && IN(pb + 3)) {
            pg8::StaticOrder S; S.init(M, 2048, G, vbx);
            pg8::Gemm g{YA, (const bf16*)(ws + WS_WA + (size_t)l * 2048 * 2048), M, 2048, 2048}; pg8::EpiGate3 E{(unsigned char*)MG, (const unsigned char*)GT};
#pragma unroll 1
            for (int rep = 0; rep < NREP(6); ++rep) pg8::gemm_phase<pg8::EpiGate3, pg8::StaticOrder, true, true, true>(lds, g, S, E, wave);
        }
        SEAML(pb + 3);
        if (EN(5) && IN(pb + 4)) {
            pg8::Gemm g{MG, (const bf16*)(ws + WS_WOUT + (size_t)l * 2048 * 2048), M, 2048, 2048}; pg8::StaticOrder S; S.init(M, 2048, G, vbx);
            pg8::EpiResid E{XB, rowssB, 0.000244140625f};
            pg8::gemm_phase<pg8::EpiResid, pg8::StaticOrder, true, true, true>(lds, g, S, E, wave);
        }
        SEAML(pb + 4);
        if (EN(6) && IN(pb + 5)) {
            pg8::Gemm g{XB, (const bf16*)(ws + WS_WQ) + (size_t)l * 2048 * 2048, M, 2048, 2048}; pg8::StaticOrder S; S.init(M, 2048, G, vbx);
            pg8::EpiQ E{QP};
#pragma unroll 1
            for (int rep = 0; rep < NREP(7); ++rep) pg8::gemm_phase<pg8::EpiQ, pg8::StaticOrder, true, true>(lds, g, S, E, wave);
        }
        SEAML(pb + 5);
        if (EN(7) && IN(pb + 6)) { FRESH();
            for (int u = vcu, k = 0; u < M / 32; u += G, ++k) peer_route(P, l, (G == 256) ? X * 64 + J + 32 * k : u, lds, tid, wave, lane);
        }
        SEAM(pb + 6);
        if (EN(8) && IN(pb + 7)) { FRESH(); peer_u_pass(P, l, G, vbx, wave, lane); }
        SEAM(pb + 7);
        if (EN(9) && IN(pb + 8)) { FRESH(); peer_combine(P, l, gw, NGW, lane); }
        SEAM(pb + 8);
        if (EN(10) && IN(pb + 9)) { FRESH(); peer_v_pass(P, l, G, vbx, lds, wave, lane); }
        SEAM(pb + 9);
    }
    if (IN(21)) { FRESH(); final_norm(P, gw, NGW, lane); }
#undef IN
#undef SEAM
}

extern "C" void kernel_launch(void* const* d_in, const int* in_sizes, int n_in, void* d_out, int out_size, void* d_ws, size_t ws_size, hipStream_t stream) {
    static int grid = 0;
    if (grid == 0) {
        if (n_in != 18 || out_size != M * D || ws_size < WS_END) { fprintf(stderr, "kernel_launch: unexpected problem (n_in %d, out %d, ws %zu); nothing launched\n", n_in, out_size, ws_size); grid = -1; return; }
        int dev = 0, cus = 0, per_cu = 0;
        if (hipGetDevice(&dev) != hipSuccess || hipDeviceGetAttribute(&cus, hipDeviceAttributeMultiprocessorCount, dev) != hipSuccess) { grid = -1; return; }
        if (hipFuncSetAttribute((const void*)mega_fwd, hipFuncAttributeMaxDynamicSharedMemorySize, LDS_BYTES) != hipSuccess) { fprintf(stderr, "kernel_launch: hipFuncSetAttribute failed\n"); grid = -1; return; }
        if (hipOccupancyMaxActiveBlocksPerMultiprocessor(&per_cu, (const void*)mega_fwd, NWAVES * 64, LDS_BYTES) != hipSuccess || per_cu < 1) { fprintf(stderr, "kernel_launch: occupancy query reports %d workgroups per CU\n", per_cu); }
        (void)hipGetLastError();
        grid = cus;
    }
    if (grid < 0) return;
    if (hipMemsetAsync((char*)d_ws + WS_CTL, 0, CTL_ZERO_BYTES, stream) != hipSuccess) { fprintf(stderr, "kernel_launch: hipMemsetAsync failed\n"); return; }
    Args a{};
    for (int i = 0; i < 18; ++i) a.in[i] = (const float*)d_in[i];
    a.out = (float*)d_out; a.ws = (unsigned char*)d_ws;
#if MK_PER_PHASE
    for (int p = 0; p < NPHASE; ++p) { a.ph_lo = p; a.ph_hi = p + 1; hipLaunchKernelGGL(mega_fwd, dim3(grid), dim3(NWAVES * 64), LDS_BYTES, stream, a); }
#else
    a.ph_lo = 0; a.ph_hi = NPHASE;
    hipLaunchKernelGGL(mega_fwd, dim3(grid), dim3(NWAVES * 64), LDS_BYTES, stream, a);
#endif
    const hipError_t le = hipPeekAtLastError();
    if (le != hipSuccess) fprintf(stderr, "kernel_launch: launch failed: %s\n", hipGetErrorName(le));
}
```

```cpp
#include <hip/hip_runtime.h>
#include <cstdio>
#include <cstdint>
__device__ __forceinline__ int lane_id_() { return (int)__builtin_amdgcn_mbcnt_hi(~0u, __builtin_amdgcn_mbcnt_lo(~0u, 0u)); }
template <int K> __device__ __forceinline__ float lane_xor(float v) {
    static_assert(K == 1 || K == 2 || K == 4 || K == 8 || K == 16, "lane_xor: 1, 2, 4, 8, 16");
    if constexpr (K == 16) return __builtin_bit_cast(float, __builtin_amdgcn_ds_swizzle(__builtin_bit_cast(int, v), (16 << 10) | 0x1F));
    else return __builtin_bit_cast(float, __builtin_amdgcn_mov_dpp(__builtin_bit_cast(int, v), K == 1 ? 0xB1 : K == 2 ? 0x4E : K == 4 ? 0x124 : 0x128, 0xF, 0xF, true));
}
__device__ __forceinline__ float half_sum(float v) { const unsigned u = __builtin_bit_cast(unsigned, v); auto rr = __builtin_amdgcn_permlane32_swap(u, u, false, false); return __builtin_bit_cast(float, (unsigned)rr[0]) + __builtin_bit_cast(float, (unsigned)rr[1]); }
__device__ __forceinline__ float half_max(float v) { const unsigned u = __builtin_bit_cast(unsigned, v); auto rr = __builtin_amdgcn_permlane32_swap(u, u, false, false); return fmaxf(__builtin_bit_cast(float, (unsigned)rr[0]), __builtin_bit_cast(float, (unsigned)rr[1])); }
namespace pg8 {
#define PG8_LAS __attribute__((address_space(3)))
typedef unsigned short bf16_t;
typedef short bf16x8 __attribute__((ext_vector_type(8)));
typedef float f32x4 __attribute__((ext_vector_type(4)));
typedef unsigned u32x4 __attribute__((ext_vector_type(4)));
constexpr int BM = 256, BK = 64, HALF = 128, HTB = HALF * BK * 2  , STAGE_BYTES = 8 * HTB, NXCD = 8, WGM = 8;

__host__ __device__ __forceinline__ int lds_byte(int r, int c) { const int st = (r >> 4) * 2 + (c >> 5), rr = r & 15, cc = c & 31, ob = rr * 64 + cc * 2; return st * 1024 + (ob ^ (((ob >> 9) & 1) << 5)); }
__host__ __device__ __forceinline__ void stage_rc(int b, int& R, int& C) { const int st = b / 1024, sb = b % 1024, swz = sb ^ (((sb >> 9) & 1) << 5); R = (st >> 1) * 16 + swz / 64; C = (st & 1) * 32 + (swz % 64) / 2; }
__host__ __device__ __forceinline__ int perm32(int rho) { const int n = rho >> 4, i = rho & 15; return 8 * (i >> 2) + 4 * n + (i & 3); }

struct Unit { int pm, pn; };
struct Gemm { const bf16_t* A; const bf16_t* Bt; int M, N, K; };

struct StaticOrder {
    int nM, nN, nwg, G, c;
    __host__ __device__ void init(int M, int N, int G_, int c_) { nM = M / BM; nN = N / BM; nwg = nM * nN; G = G_; c = c_; }
    __host__ __device__ bool next(int i, Unit& u) const {
        const long L = (long)i * G + c; if (L >= nwg) return false;
        int wgid = (int)L; { const int q = nwg / NXCD, r = nwg % NXCD, xcd = wgid % NXCD, off = wgid / NXCD; wgid = (xcd < r ? xcd * (q + 1) : r * (q + 1) + (xcd - r) * q) + off; }
        const int nig = WGM * nN, gid = wgid / nig, fm = gid * WGM, gsz = (nM - fm) < WGM ? (nM - fm) : WGM;
        u.pm = fm + ((wgid % nig) % gsz); u.pn = (wgid % nig) / gsz; return true;
    }
    __device__ __forceinline__ void a_ready(const Unit&) const {}
    __device__ __forceinline__ void done(const Unit&) const {}
};

struct SplitOrder {
    int x, j, G, c; bool bf;
    __host__ __device__ void init(int G_, int c_, bool bf_) { G = G_; c = c_; x = c_ & 7; j = c_ >> 3; bf = bf_; }
    __host__ __device__ bool next(int i, Unit& u) const {
        const int ncol = bf ? 6 : 34; int pm, pk;
        if (G == 256) { const int nA = bf ? 3 : 6, nB = bf ? 0 : 11; const int cnt = j < 16 ? nA : nB; if (i >= cnt) return false;
            const int t = (j < 16 ? nA * j : 16 * nA + nB * (j - 16)) + i; pm = 8 * x + (t & 7); pk = t >> 3; }
        else { const long t = (long)i * G + c; if (t >= 64L * ncol) return false; pm = (int)(t & 63); pk = (int)(t >> 6); }
        u.pm = pm; u.pn = bf ? (pk < 4 ? 6 + pk : 10 + pk) : (pk < 6 ? pk : pk < 10 ? pk + 4 : pk + 6);
        return true;
    }
    __device__ __forceinline__ void a_ready(const Unit&) const {}
    __device__ __forceinline__ void done(const Unit&) const {}
};

typedef float f32x2c __attribute__((ext_vector_type(2))); typedef __bf16 bf16x2c __attribute__((ext_vector_type(2)));
__device__ __forceinline__ unsigned cvt_pk_bf16(float lo, float hi) { const f32x2c v = {lo, hi}; return __builtin_bit_cast(unsigned, __builtin_convertvector(v, bf16x2c)); }
typedef float f32x2 __attribute__((ext_vector_type(2)));
typedef unsigned u32x2 __attribute__((ext_vector_type(2)));
__device__ __forceinline__ float bf_lo(unsigned u) { return __builtin_bit_cast(float, u << 16); }
__device__ __forceinline__ float bf_hi(unsigned u) { return __builtin_bit_cast(float, u & 0xffff0000u); }
__device__ __forceinline__ float sigmoidf_(float v) { return 1.0f / (1.0f + __expf(-v)); }

__device__ __forceinline__ void rstd8(const float* rowss, int row0, float scale, float (&rsv)[8]) {
#pragma unroll
    for (int h = 0; h < 2; ++h) {
#pragma unroll
        for (int m = 0; m < 4; ++m) { const int row = row0 + h * HALF + m * 16; const f32x4* rp = (const f32x4*)(rowss + (size_t)row * 16); const f32x4 a = rp[0], b = rp[1];
            const float rsum = ((a[0] + a[1]) + (a[2] + a[3])) + ((b[0] + b[1]) + (b[2] + b[3]));
            rsv[4 * h + m] = rsqrtf(rsum * (1.0f / 2048.0f) + 1e-6f) * scale; }
        asm volatile("" ::: "memory"); }
}
struct EpiProj {
    static constexpr bool PERM = true, AFTER_DRAIN = false, MIDK = false;
    bf16_t* PA; float* KMS; const float* rowss;
    __device__ __forceinline__ void operator()(const f32x4 (&acc)[2][2][4][2], const Unit& u, int wr, int wc, int fr, int fq) const {
        asm volatile("" : "+v"(fr), "+v"(fq));
        const int row0 = u.pm * BM + wr * 64 + fr;
        const int col0 = u.pn * BM + wc * 32 + 8 * fq;
        float rsv[8]; rstd8(rowss, row0, 1.0f, rsv);
#pragma unroll
        for (int ai = 0; ai < 2; ++ai)
#pragma unroll
            for (int m = 0; m < 4; ++m) { const int row = row0 + ai * HALF + m * 16;
                const float rs = rsv[4 * ai + m];
                bf16_t* rowp = PA + (size_t)row * 4096 + col0;
#pragma unroll
                for (int bj = 0; bj < 2; ++bj) { const f32x4 v0 = acc[ai][bj][m][0] * rs, v1 = acc[ai][bj][m][1] * rs;
                    u32x4 w; w.x = cvt_pk_bf16(v0[0], v0[1]); w.y = cvt_pk_bf16(v0[2], v0[3]); w.z = cvt_pk_bf16(v1[0], v1[1]); w.w = cvt_pk_bf16(v1[2], v1[3]);
                    *(u32x4*)(rowp + bj * HALF) = w; } }
        if ((u.pn == 8) || (u.pn == 9)) {
            float* kp = KMS + (size_t)u.pm * 512 + (u.pn - 8) * BM + wc * 32 + 8 * fq;
#pragma unroll
            for (int bj = 0; bj < 2; ++bj)
#pragma unroll
                for (int n = 0; n < 2; ++n) { f32x4 cs = (f32x4){0.f, 0.f, 0.f, 0.f};
#pragma unroll
                    for (int ai = 0; ai < 2; ++ai)
#pragma unroll
                        for (int m = 0; m < 4; ++m) cs = cs + acc[ai][bj][m][n] * rsv[4 * ai + m];
#pragma unroll
                    for (int e = 0; e < 4; ++e) { float v = cs[e];
                        v += lane_xor<1>(v); v += lane_xor<2>(v); v += lane_xor<4>(v); v += lane_xor<8>(v);
                        if (fr == 0) atomicAdd(kp + bj * HALF + 4 * n + e, v); } }
        }
    }
};
struct EpiGate3 {
    static constexpr bool PERM = true, AFTER_DRAIN = false, MIDK = true;
    static constexpr int KB1 = 8, KB2 = 12;
    unsigned char* MG; const unsigned char* GT;
    static __device__ __forceinline__ float fl(float g) { return fmaxf(g, 2.4318695068359375e-04f); }
    static __device__ __forceinline__ float b0(unsigned w) { return (float)(w & 0xffu); }
    static __device__ __forceinline__ float b1(unsigned w) { return (float)((w >> 8) & 0xffu); }
    static __device__ __forceinline__ float b2(unsigned w) { return (float)((w >> 16) & 0xffu); }
    static __device__ __forceinline__ float b3(unsigned w) { return (float)(w >> 24); }
    __device__ __forceinline__ void mid(f32x4 (&acc)[2][2][4][2], const Unit& u, int t, int wr, int wc, int fr, int fq) const {
        asm volatile("" : "+v"(fr), "+v"(fq));
        const int gnum = (t == KB1) ? 0 : 2048;
        const int row0 = u.pm * BM + wr * 64 + fr; const int col0 = u.pn * BM + wc * 32 + 8 * fq;
        u32x2 nv[2][4][2], dv[2][4][2];
#pragma unroll
        for (int ai = 0; ai < 2; ++ai)
#pragma unroll
            for (int m = 0; m < 4; ++m) { const unsigned char* gp = GT + (size_t)(row0 + ai * HALF + m * 16) * 6144 + gnum + col0;
#pragma unroll
                for (int bj = 0; bj < 2; ++bj) { nv[ai][m][bj] = *(const u32x2*)(gp + bj * HALF); dv[ai][m][bj] = *(const u32x2*)(gp + 2048 + bj * HALF); } }
#pragma unroll
        for (int ai = 0; ai < 2; ++ai) {
#pragma unroll
            for (int m = 0; m < 4; ++m)
#pragma unroll
                for (int bj = 0; bj < 2; ++bj) { const u32x2 n_ = nv[ai][m][bj], d_ = dv[ai][m][bj];
                    const f32x4 r0 = (f32x4){fl(b0(n_.x)) * __builtin_amdgcn_rcpf(fl(b0(d_.x))), fl(b1(n_.x)) * __builtin_amdgcn_rcpf(fl(b1(d_.x))), fl(b2(n_.x)) * __builtin_amdgcn_rcpf(fl(b2(d_.x))), fl(b3(n_.x)) * __builtin_amdgcn_rcpf(fl(b3(d_.x)))};
                    const f32x4 r1 = (f32x4){fl(b0(n_.y)) * __builtin_amdgcn_rcpf(fl(b0(d_.y))), fl(b1(n_.y)) * __builtin_amdgcn_rcpf(fl(b1(d_.y))), fl(b2(n_.y)) * __builtin_amdgcn_rcpf(fl(b2(d_.y))), fl(b3(n_.y)) * __builtin_amdgcn_rcpf(fl(b3(d_.y)))};
                    acc[ai][bj][m][0] = acc[ai][bj][m][0] * r0; acc[ai][bj][m][1] = acc[ai][bj][m][1] * r1; }
            asm volatile("" ::: "memory");
        }
    }
    __device__ __forceinline__ void operator()(const f32x4 (&acc)[2][2][4][2], const Unit& u, int wr, int wc, int fr, int fq) const {
        asm volatile("" : "+v"(fr), "+v"(fq));
        const int row0 = u.pm * BM + wr * 64 + fr; const int col0 = u.pn * BM + wc * 32 + 8 * fq;
        constexpr float GS = 0.0078125f / 255.0f;
#pragma unroll
        for (int ai = 0; ai < 2; ++ai)
#pragma unroll
            for (int m = 0; m < 4; ++m) { const int row = row0 + ai * HALF + m * 16;
                const unsigned char* gp = GT + (size_t)row * 6144 + 4096 + col0; unsigned char* op = MG + (size_t)row * 2048 + col0;
#pragma unroll
                for (int bj = 0; bj < 2; ++bj) { const u32x2 gv = *(const u32x2*)(gp + bj * HALF);
                    const f32x4 v0 = acc[ai][bj][m][0] * ((f32x4){fl(b0(gv.x)), fl(b1(gv.x)), fl(b2(gv.x)), fl(b3(gv.x))} * GS);
                    const f32x4 v1 = acc[ai][bj][m][1] * ((f32x4){fl(b0(gv.y)), fl(b1(gv.y)), fl(b2(gv.y)), fl(b3(gv.y))} * GS);
                    int w0 = __builtin_amdgcn_cvt_pk_fp8_f32(v0[0], v0[1], 0, false); w0 = __builtin_amdgcn_cvt_pk_fp8_f32(v0[2], v0[3], w0, true);
                    int w1 = __builtin_amdgcn_cvt_pk_fp8_f32(v1[0], v1[1], 0, false); w1 = __builtin_amdgcn_cvt_pk_fp8_f32(v1[2], v1[3], w1, true);
                    u32x2 w; w.x = (unsigned)w0; w.y = (unsigned)w1; *(u32x2*)(op + bj * HALF) = w; }
                asm volatile("" ::: "memory"); }
    }
};
struct EpiIn8 {
    static constexpr bool PERM = true, AFTER_DRAIN = false, MIDK = false;
    bf16_t* PA; unsigned char* GT; const float* rowss;
    static __device__ __forceinline__ float g255(float v) { return __builtin_rintf(255.0f * __builtin_amdgcn_rcpf(1.0f + __expf(-v))); }
    static __device__ __forceinline__ unsigned pk4(const f32x4& v) { unsigned w = __builtin_amdgcn_cvt_pk_u8_f32(g255(v[0]), 0, 0u); w = __builtin_amdgcn_cvt_pk_u8_f32(g255(v[1]), 1, w); w = __builtin_amdgcn_cvt_pk_u8_f32(g255(v[2]), 2, w); return __builtin_amdgcn_cvt_pk_u8_f32(g255(v[3]), 3, w); }
    __device__ __forceinline__ void operator()(const f32x4 (&acc)[2][2][4][2], const Unit& u, int wr, int wc, int fr, int fq) const {
        asm volatile("" : "+v"(fr), "+v"(fq));
        const bool gate = u.pn >= 16;
        const int row0 = u.pm * BM + wr * 64 + fr; const int col0 = (gate ? u.pn - 16 : u.pn) * BM + wc * 32 + 8 * fq;
        float rsv[8]; rstd8(rowss, row0, 0.00390625f, rsv);
#pragma unroll
        for (int ai = 0; ai < 2; ++ai)
#pragma unroll
            for (int m = 0; m < 4; ++m) { const int row = row0 + ai * HALF + m * 16;
                const float rs = rsv[4 * ai + m];
                if (gate) { unsigned char* rowp = GT + (size_t)row * 6144 + col0;
#pragma unroll
                    for (int bj = 0; bj < 2; ++bj) { const f32x4 v0 = acc[ai][bj][m][0] * rs, v1 = acc[ai][bj][m][1] * rs;
                        u32x2 w; w.x = pk4(v0); w.y = pk4(v1);
                        *(u32x2*)(rowp + bj * HALF) = w; } }
                else { bf16_t* rowp = PA + (size_t)row * 4096 + col0;
#pragma unroll
                    for (int bj = 0; bj < 2; ++bj) { const f32x4 v0 = acc[ai][bj][m][0] * rs, v1 = acc[ai][bj][m][1] * rs;
                        u32x4 w; w.x = cvt_pk_bf16(v0[0], v0[1]); w.y = cvt_pk_bf16(v0[2], v0[3]); w.z = cvt_pk_bf16(v1[0], v1[1]); w.w = cvt_pk_bf16(v1[2], v1[3]);
                        *(u32x4*)(rowp + bj * HALF) = w; } } }
    }
};
struct EpiResid {
    static constexpr bool PERM = false, AFTER_DRAIN = false, MIDK = false;
    bf16_t* xb; float* rowss; float ascale;
    __device__ __forceinline__ void operator()(const f32x4 (&acc)[2][2][4][2], const Unit& u, int wr, int wc, int fr, int fq) const {
        const int col0 = u.pn * BM + wc * 32 + 4 * fq;
#pragma unroll
        for (int ai = 0; ai < 2; ++ai)
#pragma unroll
            for (int m = 0; m < 4; ++m) { const int r = u.pm * BM + ai * HALF + wr * 64 + m * 16 + fr; const size_t off = (size_t)r * 2048 + col0; float ss = 0.f;
#pragma unroll
                for (int bj = 0; bj < 2; ++bj)
#pragma unroll
                    for (int n = 0; n < 2; ++n) { const size_t o = off + bj * HALF + n * 16; const u32x2 xo = *(const u32x2*)(xb + o); const f32x4 v = (f32x4){bf_lo(xo.x), bf_hi(xo.x), bf_lo(xo.y), bf_hi(xo.y)} + acc[ai][bj][m][n] * ascale;
                        ss += (v[0] * v[0] + v[1] * v[1]) + (v[2] * v[2] + v[3] * v[3]);
                        u32x2 w; w.x = cvt_pk_bf16(v[0], v[1]); w.y = cvt_pk_bf16(v[2], v[3]); *(u32x2*)(xb + o) = w; }
                ss += lane_xor<16>(ss); ss = half_sum(ss);
                if (fq == 0) rowss[(size_t)r * 32 + u.pn * 4 + wc] = ss; }
    }
};
struct EpiQ {
    static constexpr bool PERM = true, AFTER_DRAIN = false, MIDK = false;
    bf16_t* Q;
    __device__ __forceinline__ void operator()(const f32x4 (&acc)[2][2][4][2], const Unit& u, int wr, int wc, int fr, int fq) const {
        const int row0 = u.pm * BM + wr * 64 + fr; const int col0 = u.pn * BM + wc * 32 + 8 * fq;
#pragma unroll
        for (int ai = 0; ai < 2; ++ai)
#pragma unroll
            for (int m = 0; m < 4; ++m) { const int row = row0 + ai * HALF + m * 16;
                bf16_t* rowp = Q + (size_t)row * 2048 + col0;
#pragma unroll
                for (int bj = 0; bj < 2; ++bj) { const f32x4 v0 = acc[ai][bj][m][0], v1 = acc[ai][bj][m][1];
                    u32x4 w; w.x = cvt_pk_bf16(v0[0], v0[1]); w.y = cvt_pk_bf16(v0[2], v0[3]); w.z = cvt_pk_bf16(v1[0], v1[1]); w.w = cvt_pk_bf16(v1[2], v1[3]);
                    *(u32x4*)(rowp + bj * HALF) = w; } }
    }
};
typedef int v8i_t __attribute__((ext_vector_type(8)));
template <class Epi, class Sched, bool ALIGN_EPI = false, bool SP2 = false, bool F8 = false>
__device__ __forceinline__ void gemm_phase(PG8_LAS unsigned char* lds, const Gemm g, const Sched& S, const Epi& E, const int wave_in) {
    int tid_ = wave_in * 64 + lane_id_(); asm volatile("" : "+v"(tid_));
    const int tid = tid_, wid = __builtin_amdgcn_readfirstlane(tid >> 6), lane = tid & 63, wr = wid >> 2, wc = wid & 3, fr = lane & 15, fq = lane >> 4;
    const int K = g.K, nt = F8 ? K / 128 : K / BK;
    unsigned voffA[2], voffB[2];
#pragma unroll
    for (int i = 0; i < 2; ++i) { int R, C; stage_rc(tid * 16 + i * 8192, R, C); const int Rb = Epi::PERM ? ((R & ~31) + perm32(R & 31)) : R;
        if constexpr (F8) { voffA[i] = (unsigned)(R * K + 2 * C); voffB[i] = (unsigned)(Rb * K + 2 * C); } else { voffA[i] = (unsigned)(R * K + C) * 2u; voffB[i] = (unsigned)(Rb * K + C) * 2u; } }
    const size_t kstep = (size_t)(BK * 2);
    const size_t hstep = (size_t)HALF * K * (F8 ? 1 : 2);
    const size_t tstep = 2 * hstep;
    const unsigned ldsw = (unsigned)wid * 1024u;
    const int aoff = lds_byte(wr * 64 + fr, fq * 8), boff = lds_byte(wc * 32 + fr, fq * 8);
    const int aoff1 = aoff + 1024, boff1 = boff + 1024;
#define PG8_SA(b, h) (((b) * 2 + (h)) * HTB)
#define PG8_SB(b, h) ((4 + (b) * 2 + (h)) * HTB)
#define PG8_STAGE(bufoff, gbase, voff) do { _Pragma("unroll") for (int _i = 0; _i < 2; ++_i) \
        __builtin_amdgcn_global_load_lds((const unsigned*)((const char*)(gbase) + (voff)[_i]), (PG8_LAS unsigned*)(lds + (bufoff) + ldsw + _i * 8192), 16, 0, 0); } while (0)
#define PG8_LDA(dst, b, h) do { if constexpr (F8) { _Pragma("unroll") for (int m = 0; m < 4; ++m) { const u32x4 x0_ = *(const PG8_LAS u32x4*)(lds + PG8_SA(b, h) + aoff + m * 2048), x1_ = *(const PG8_LAS u32x4*)(lds + PG8_SA(b, h) + aoff1 + m * 2048); \
        dst##8[m] = (v8i_t){(int)x0_.x, (int)x0_.y, (int)x0_.z, (int)x0_.w, (int)x1_.x, (int)x1_.y, (int)x1_.z, (int)x1_.w}; } } else { \
        _Pragma("unroll") for (int m = 0; m < 4; ++m) _Pragma("unroll") for (int k = 0; k < 2; ++k) dst[m][k] = *(const PG8_LAS bf16x8*)(lds + PG8_SA(b, h) + aoff + m * 2048 + k * 1024); } } while (0)
#define PG8_LDB(dst, b, h) do { if constexpr (F8) { _Pragma("unroll") for (int n = 0; n < 2; ++n) { const u32x4 x0_ = *(const PG8_LAS u32x4*)(lds + PG8_SB(b, h) + boff + n * 2048), x1_ = *(const PG8_LAS u32x4*)(lds + PG8_SB(b, h) + boff1 + n * 2048); \
        dst##8[n] = (v8i_t){(int)x0_.x, (int)x0_.y, (int)x0_.z, (int)x0_.w, (int)x1_.x, (int)x1_.y, (int)x1_.z, (int)x1_.w}; } } else { \
        _Pragma("unroll") for (int n = 0; n < 2; ++n) _Pragma("unroll") for (int k = 0; k < 2; ++k) dst[n][k] = *(const PG8_LAS bf16x8*)(lds + PG8_SB(b, h) + boff + n * 2048 + k * 1024); } } while (0)
#define PG8_MMA(ai, bj, At, Bt) do { __builtin_amdgcn_s_setprio(1); if constexpr (F8) { _Pragma("unroll") for (int m = 0; m < 4; ++m) _Pragma("unroll") for (int n = 0; n < 2; ++n) \
        asm volatile("v_mfma_scale_f32_16x16x128_f8f6f4 %0, %1, %2, %0, %3, %3 op_sel_hi:[0,0,0]" : "+v"(acc[ai][bj][m][n]) : "v"(Bt##8[n]), "v"(At##8[m]), "v"(sc1_)); } else { \
        _Pragma("unroll") for (int m = 0; m < 4; ++m) _Pragma("unroll") for (int n = 0; n < 2; ++n) _Pragma("unroll") for (int k = 0; k < 2; ++k) \
        acc[ai][bj][m][n] = __builtin_amdgcn_mfma_f32_16x16x32_bf16(Bt[n][k], At[m][k], acc[ai][bj][m][n], 0, 0, 0); } __builtin_amdgcn_s_setprio(0); } while (0)
#define PG8_WAIT_V(n) asm volatile("s_waitcnt vmcnt(" #n ")" ::: "memory")
#define PG8_WAIT_L(n) asm volatile("s_waitcnt lgkmcnt(" #n ")" ::: "memory")
#define PG8_BAR __builtin_amdgcn_s_barrier()
#define PG8_SCHED __builtin_amdgcn_sched_barrier(0)
    Unit cur, nxt; int ui = 0;
    if (!S.next(0, cur)) return;
    f32x4 acc[2][2][4][2];
#pragma unroll
    for (int a = 0; a < 2; ++a)
#pragma unroll
        for (int b = 0; b < 2; ++b)
#pragma unroll
            for (int m = 0; m < 4; ++m)
#pragma unroll
                for (int n = 0; n < 2; ++n) acc[a][b][m][n] = (f32x4){0.f, 0.f, 0.f, 0.f};
    bf16x8 At[4][2], B0[2][2], B1[2][2]; v8i_t At8[4], B08[2], B18[2];
    int sc1_ = 0x7F7F7F7F; asm volatile("" : "+v"(sc1_));
    const char* cA = (const char*)g.A + (size_t)cur.pm * tstep; const char* cB = (const char*)g.Bt + (size_t)cur.pn * tstep;
    S.a_ready(cur);
    if constexpr (SP2) {
        PG8_STAGE(PG8_SB(0, 0), cB, voffB); PG8_STAGE(PG8_SB(0, 1), cB + hstep, voffB); PG8_STAGE(PG8_SA(0, 0), cA, voffA); PG8_STAGE(PG8_SA(0, 1), cA + hstep, voffA);
        if (wr == 1) PG8_BAR;
        PG8_WAIT_V(2); PG8_BAR;
        PG8_STAGE(PG8_SB(1, 0), cB + kstep, voffB); PG8_STAGE(PG8_SA(1, 0), cA + kstep, voffA); PG8_STAGE(PG8_SB(1, 1), cB + hstep + kstep, voffB);
        PG8_WAIT_V(6); PG8_BAR;
    } else {
        PG8_STAGE(PG8_SB(0, 0), cB, voffB); PG8_STAGE(PG8_SA(0, 0), cA, voffA); PG8_STAGE(PG8_SB(0, 1), cB + hstep, voffB); PG8_STAGE(PG8_SA(0, 1), cA + hstep, voffA);
        if (wr == 1) PG8_BAR;
        PG8_WAIT_V(4); PG8_BAR;
        PG8_STAGE(PG8_SB(1, 0), cB + kstep, voffB); PG8_STAGE(PG8_SA(1, 0), cA + kstep, voffA); PG8_STAGE(PG8_SB(1, 1), cB + hstep + kstep, voffB);
        PG8_WAIT_V(6); PG8_BAR;
    }
    for (;;) {
        const bool has_next = S.next(ui + 1, nxt);
        const char* nA = has_next ? (const char*)g.A + (size_t)nxt.pm * tstep : cA; const char* nB = has_next ? (const char*)g.Bt + (size_t)nxt.pn * tstep : cB;
        for (int t = 0; t < nt; t += 2) {
            if constexpr (Epi::MIDK) { if (t == Epi::KB1 || t == Epi::KB2) E.mid(acc, cur, t, wr, wc, fr, fq); }
            const bool last = (t == nt - 2);
            const char* a1 = cA + (size_t)(t + 1) * kstep;
            const char* a2 = last ? nA : cA + (size_t)(t + 2) * kstep; const char* b2 = last ? nB : cB + (size_t)(t + 2) * kstep;
            const char* a3 = a2 + kstep; const char* b3 = b2 + kstep;
            if (last && has_next) S.a_ready(nxt);
            if constexpr (SP2) {
            PG8_LDB(B0, 0, 0); PG8_LDB(B1, 0, 1); PG8_SCHED; PG8_LDA(At, 0, 0); PG8_STAGE(PG8_SA(1, 1), a1 + hstep, voffA);
            PG8_WAIT_V(8); PG8_WAIT_L(0); PG8_BAR; PG8_MMA(0, 0, At, B0); PG8_MMA(0, 1, At, B1); PG8_BAR; PG8_SCHED;
            PG8_LDA(At, 0, 1); PG8_STAGE(PG8_SB(0, 0), b2, voffB); PG8_STAGE(PG8_SB(0, 1), b2 + hstep, voffB); PG8_STAGE(PG8_SA(0, 0), a2, voffA);
            PG8_WAIT_V(8); PG8_WAIT_L(0); PG8_BAR; PG8_MMA(1, 0, At, B0); PG8_MMA(1, 1, At, B1); PG8_BAR; PG8_SCHED;
            PG8_LDB(B0, 1, 0); PG8_LDB(B1, 1, 1); PG8_SCHED; PG8_LDA(At, 1, 0); PG8_STAGE(PG8_SA(0, 1), a2 + hstep, voffA);
            PG8_WAIT_V(8); PG8_WAIT_L(0); PG8_BAR; PG8_MMA(0, 0, At, B0); PG8_MMA(0, 1, At, B1); PG8_BAR; PG8_SCHED;
            PG8_LDA(At, 1, 1); PG8_STAGE(PG8_SB(1, 0), b3, voffB); PG8_STAGE(PG8_SB(1, 1), b3 + hstep, voffB); PG8_STAGE(PG8_SA(1, 0), a3, voffA);
            PG8_WAIT_V(8); PG8_WAIT_L(0); PG8_BAR; PG8_MMA(1, 0, At, B0); PG8_MMA(1, 1, At, B1); PG8_BAR; PG8_SCHED;
            } else {
            PG8_LDB(B0, 0, 0); PG8_SCHED; PG8_LDA(At, 0, 0); PG8_STAGE(PG8_SA(1, 1), a1 + hstep, voffA);
            PG8_WAIT_L(8); PG8_BAR; PG8_WAIT_L(0); PG8_MMA(0, 0, At, B0); PG8_BAR; PG8_SCHED;
            PG8_LDB(B1, 0, 1); PG8_STAGE(PG8_SB(0, 0), b2, voffB);
            PG8_BAR; PG8_WAIT_L(0); PG8_MMA(0, 1, At, B1); PG8_BAR;
            PG8_LDA(At, 0, 1); PG8_STAGE(PG8_SA(0, 0), a2, voffA);
            PG8_BAR; PG8_WAIT_L(0); PG8_MMA(1, 0, At, B0); PG8_BAR; PG8_SCHED;
            PG8_STAGE(PG8_SB(0, 1), b2 + hstep, voffB);
            PG8_WAIT_V(6); PG8_BAR; PG8_MMA(1, 1, At, B1); PG8_BAR;
            PG8_LDB(B0, 1, 0); PG8_SCHED; PG8_LDA(At, 1, 0); PG8_STAGE(PG8_SA(0, 1), a2 + hstep, voffA);
            PG8_WAIT_L(8); PG8_BAR; PG8_WAIT_L(0); PG8_MMA(0, 0, At, B0); PG8_BAR; PG8_SCHED;
            PG8_LDB(B1, 1, 1); PG8_STAGE(PG8_SB(1, 0), b3, voffB);
            PG8_BAR; PG8_WAIT_L(0); PG8_MMA(0, 1, At, B1); PG8_BAR;
            PG8_LDA(At, 1, 1); PG8_STAGE(PG8_SA(1, 0), a3, voffA);
            PG8_BAR; PG8_WAIT_L(0); PG8_MMA(1, 0, At, B0); PG8_BAR; PG8_SCHED;
            PG8_STAGE(PG8_SB(1, 1), b3 + hstep, voffB);
            PG8_WAIT_V(6); PG8_BAR; PG8_MMA(1, 1, At, B1); PG8_BAR;
            }
        }
        if constexpr (ALIGN_EPI) { if (wr == 0) PG8_BAR; }
        if constexpr (F8) asm volatile("s_nop 15\n\ts_nop 15" ::: "memory");
        if constexpr (!Epi::AFTER_DRAIN) { E(acc, cur, wr, wc, fr, fq); S.done(cur); }
        if (!has_next) break;
#pragma unroll
        for (int a = 0; a < 2; ++a)
#pragma unroll
            for (int b = 0; b < 2; ++b)
#pragma unroll
                for (int m = 0; m < 4; ++m)
#pragma unroll
                    for (int n = 0; n < 2; ++n) acc[a][b][m][n] = (f32x4){0.f, 0.f, 0.f, 0.f};
        cur = nxt; cA = nA; cB = nB; ++ui;
        if constexpr (ALIGN_EPI) { if (wr == 1) PG8_BAR; }
    }
    PG8_WAIT_V(0);
    if constexpr (!ALIGN_EPI) { if (wr == 0) PG8_BAR; }
    PG8_BAR;
    if constexpr (Epi::AFTER_DRAIN) { E.fused(acc, cur, wr, wc, fr, fq, lds, wid, lane); S.done(cur); }
#undef PG8_SA
#undef PG8_SB
#undef PG8_STAGE
#undef PG8_LDA
#undef PG8_LDB
#undef PG8_MMA
#undef PG8_WAIT_V
#undef PG8_WAIT_L
#undef PG8_BAR
#undef PG8_SCHED
}
}
#define PG8_SP2 true
#define GAS __attribute__((address_space(1)))
#define LAS __attribute__((address_space(3)))
typedef unsigned short bf16;
typedef unsigned v4u __attribute__((ext_vector_type(4)));
typedef float f32x4 __attribute__((ext_vector_type(4)));
typedef short bf16x8 __attribute__((ext_vector_type(8)));
typedef GAS unsigned gu32;
typedef GAS unsigned long long gu64;
#define RLX_AGENT __ATOMIC_RELAXED, __HIP_MEMORY_SCOPE_AGENT
#define LDS_WAIT() asm volatile("s_waitcnt lgkmcnt(0)" ::: "memory")
#define VM_WAIT() asm volatile("s_waitcnt vmcnt(0)" ::: "memory")
__device__ __forceinline__ unsigned long long rt() { return __builtin_amdgcn_s_memrealtime(); }
__device__ __forceinline__ unsigned f2bf(float f) { unsigned u = __builtin_bit_cast(unsigned, f); return (u + 0x7fffu + ((u >> 16) & 1u)) >> 16; }
__device__ __forceinline__ unsigned pk2(float lo, float hi) { return f2bf(lo) | (f2bf(hi) << 16); }

#define XB_TMO      128
#define XB_XCNT(j)  (256  + 64 * (j))
#define XB_XSUB(j)  (1280 + 64 * (j))
#define XB_XGEN(j)  (2304 + 64 * (j))
#define XB_TOP      3328
#define XB_TOPGEN   3392
#define XCD_BAR_WORDS 3456
#define XB_SPIN_CAP (1u << 18)

__device__ __forceinline__ unsigned xb_ld(unsigned* p)              { return __hip_atomic_load(p, __ATOMIC_RELAXED, __HIP_MEMORY_SCOPE_AGENT); }
__device__ __forceinline__ unsigned xb_add(unsigned* p, unsigned v) { return __hip_atomic_fetch_add(p, v, __ATOMIC_RELAXED, __HIP_MEMORY_SCOPE_AGENT); }
__device__ __forceinline__ unsigned xb_xcc_id() { return (unsigned)__builtin_amdgcn_s_getreg((3 << 11) | 20) & 0xFu; }
#define XB_SPIN(cond, bar) do { unsigned _sp = 0; while (cond) { __builtin_amdgcn_s_sleep(1); \
    if ((++_sp & 255u) == 0u) { if (xb_ld(&(bar)[XB_TMO])) break; if (_sp > XB_SPIN_CAP) { atomicAdd(&(bar)[XB_TMO], 1u); break; } } } } while (0)

struct XcdBarrier {
    unsigned* bar; unsigned x;
    volatile LAS unsigned* st;
};

__device__ __forceinline__ XcdBarrier xcd_barrier_post(unsigned* bar, volatile LAS unsigned* st) {
    XcdBarrier b; b.bar = bar; b.x = xb_xcc_id(); b.st = st;
    if (threadIdx.x == 0) st[3] = xb_add(&bar[XB_XCNT(b.x)], 1u);
    return b;
}
__device__ __forceinline__ void xcd_barrier_complete(unsigned* bar, unsigned x, unsigned& nloc, unsigned& nx, unsigned& uni) {
    const unsigned G = gridDim.x * gridDim.y * gridDim.z;
    unsigned sum, cnt, mine, bad, sp = 0u;
    for (;;) {
        sum = 0u; cnt = 0u; mine = 0u; bad = 0u;
#pragma unroll
        for (unsigned j = 0; j < 16; ++j) { const unsigned c = xb_ld(&bar[XB_XCNT(j)]); sum += c; cnt += (c > 0u) ? 1u : 0u; mine = (j == x) ? c : mine; bad += (c != 0u && c != 32u) ? 1u : 0u; }
        if (sum == G) break;
        __builtin_amdgcn_s_sleep(1);
        if ((++sp & 255u) == 0u) { if (xb_ld(&bar[XB_TMO])) break; if (sp > XB_SPIN_CAP) { atomicAdd(&bar[XB_TMO], 1u); break; } }
    }
    nloc = mine > 0u ? mine : 1u; nx = cnt > 0u ? cnt : 1u;
    uni = (sum == G && G == 256u && cnt == 8u && bad == 0u) ? 1u : 2u;
}

__device__ __forceinline__ void xcd_barrier(const XcdBarrier& b) {
    asm volatile("s_waitcnt vmcnt(0)" ::: "memory");
    __syncthreads();
    if (threadIdx.x == 0) {
        unsigned* bar = b.bar;
        __builtin_amdgcn_s_waitcnt(0);
        unsigned nloc = b.st[0], nx = b.st[1];
        if (nloc == 0u) { unsigned uni; xcd_barrier_complete(bar, b.x, nloc, nx, uni); b.st[0] = nloc; b.st[1] = nx; b.st[2] = uni; }
        const unsigned old = xb_add(&bar[XB_XSUB(b.x)], 1u);
        const unsigned gen = old / nloc;
        if (old + 1u == (gen + 1u) * nloc) {
            __builtin_amdgcn_fence(__ATOMIC_RELEASE, "agent");
            asm volatile("s_waitcnt vmcnt(0)" ::: "memory");
            const unsigned og = xb_add(&bar[XB_TOP], 1u);
            const unsigned tg = og / nx;
            if (og + 1u == (tg + 1u) * nx) xb_add(&bar[XB_TOPGEN], 1u);
            else XB_SPIN(xb_ld(&bar[XB_TOPGEN]) == tg, bar);
            __builtin_amdgcn_fence(__ATOMIC_ACQUIRE, "agent");
            xb_add(&bar[XB_XGEN(b.x)], 1u);
            asm volatile("s_waitcnt vmcnt(0)" ::: "memory");
        } else {
            XB_SPIN(xb_ld(&bar[XB_XGEN(b.x)]) == gen, bar);
            __builtin_amdgcn_fence(__ATOMIC_ACQUIRE, "agent");
            asm volatile("s_waitcnt vmcnt(0)" ::: "memory");
        }
    }
    __syncthreads();
}
__device__ __forceinline__ void xcd_barrier_local(const XcdBarrier& b) {
    asm volatile("s_waitcnt vmcnt(0)" ::: "memory");
    __syncthreads();
    if (threadIdx.x == 0) {
        unsigned* bar = b.bar;
        __builtin_amdgcn_s_waitcnt(0);
        const unsigned nloc = b.st[0];
        const unsigned old = xb_add(&bar[XB_XSUB(b.x)], 1u);
        const unsigned gen = old / nloc;
        if (old + 1u == (gen + 1u) * nloc) xb_add(&bar[XB_XGEN(b.x)], 1u);
        else XB_SPIN(xb_ld(&bar[XB_XGEN(b.x)]) == gen, bar);
        __builtin_amdgcn_fence(__ATOMIC_ACQUIRE, "agent");
        asm volatile("s_waitcnt vmcnt(0)" ::: "memory");
    }
    __syncthreads();
}
namespace cfg {
constexpr int NWAVES = 8;
constexpr int M = 16384, D = 2048, T = 2048, NBATCH = 8, DEPTH = 2;
constexpr int IN_COLS = 10152, NPROJ = 10240, PA_LD = 4096, GT_LD = 6144;
constexpr int C_QA = 0, C_KA = 1024, C_VA = 1280, C_QB = 1536, C_KB = 2048, C_VB = 2560, C_QC = 3072, C_CL = 3584, C_IQ = 3712, C_IK = 3968, C_IW = 4000;
constexpr float EPS = 1e-6f;
constexpr size_t MiB = 1u << 20;
constexpr size_t WS_CTL = 0, CTL_ZERO_BYTES = 1 * MiB;
constexpr size_t WS_ROWSSB = 842 * MiB;
constexpr size_t WS_ROWSSA = 1 * MiB;
constexpr size_t WS_KMEAN = 512 * 1024;
constexpr size_t WS_BIASD = 1 * MiB + 256 * 1024;
constexpr size_t WS_WUKB = 1 * MiB + 512 * 1024;
constexpr size_t WS_WUVT = 1 * MiB + 768 * 1024;
constexpr size_t WS_CN = 2 * MiB;
constexpr size_t WS_MASK = 6 * MiB;
constexpr size_t WS_WA = 10 * MiB, WS_WB = 18 * MiB, WS_WC = 22 * MiB, WS_WOUT = 26 * MiB, WS_WQ = 42 * MiB, WS_WIN = 58 * MiB;
constexpr size_t WS_U = 138 * MiB, WS_V = 266 * MiB;
constexpr size_t WS_USC = WS_U + 64 * MiB;
constexpr size_t WS_XB8 = WS_U + 80 * MiB;
constexpr size_t WS_WG8 = WS_V + 80 * MiB;
constexpr size_t WS_XB = 394 * MiB;
constexpr size_t WS_PA = 458 * MiB;
constexpr size_t WS_MG = 682 * MiB, WS_QP = 714 * MiB;
constexpr size_t WS_GT = 586 * MiB;
constexpr size_t WS_YA = 778 * MiB, WS_YB = 810 * MiB, WS_YC = 826 * MiB;
constexpr size_t WS_SKB = 844 * MiB;
constexpr size_t WS_SC = 845 * MiB;
constexpr size_t WS_PD = WS_SC;
constexpr size_t WS_RI = 973 * MiB, WS_RG = 981 * MiB, WS_W = 989 * MiB;
constexpr size_t WS_RSTD = 997 * MiB;
constexpr size_t WS_RS = 998 * MiB;
constexpr size_t WS_END = 999 * MiB;
constexpr int CW_BAR = 4096;
constexpr int RING_BYTES = 131072, LDS_BYTES = 147456, LDSCTL_OFF = LDS_BYTES - 512, MISC_OFF = LDSCTL_OFF + 320;
constexpr int NPHASE = 22;
}
using namespace cfg;
typedef unsigned u32x4v __attribute__((ext_vector_type(4)));
typedef unsigned u32x2v __attribute__((ext_vector_type(2)));
typedef float f32x2v __attribute__((ext_vector_type(2)));
typedef __bf16 bf16x2_t __attribute__((ext_vector_type(2)));
__device__ __forceinline__ float bflo(unsigned u) { return __builtin_bit_cast(float, u << 16); }
__device__ __forceinline__ float bfhi(unsigned u) { return __builtin_bit_cast(float, u & 0xffff0000u); }
__device__ __forceinline__ float bf1(bf16 v) { return __builtin_bit_cast(float, (unsigned)v << 16); }
__device__ __forceinline__ float dot2(unsigned a, unsigned b, float c) { return __builtin_amdgcn_fdot2_f32_bf16(__builtin_bit_cast(bf16x2_t, a), __builtin_bit_cast(bf16x2_t, b), c, false); }
__device__ __forceinline__ float dot8(v4u a, v4u b, float c) { c = dot2(a.x, b.x, c); c = dot2(a.y, b.y, c); c = dot2(a.z, b.z, c); c = dot2(a.w, b.w, c); return c; }
__device__ __forceinline__ float wave_sum(float v) {
    v += lane_xor<1>(v); v += lane_xor<2>(v); v += lane_xor<4>(v); v += lane_xor<8>(v); v += lane_xor<16>(v); v = half_sum(v);
    return v;
}
__device__ __forceinline__ float wave_max(float v) {
    v = fmaxf(v, lane_xor<1>(v)); v = fmaxf(v, lane_xor<2>(v)); v = fmaxf(v, lane_xor<4>(v)); v = fmaxf(v, lane_xor<8>(v)); v = fmaxf(v, lane_xor<16>(v)); v = half_max(v);
    return v;
}
__device__ __forceinline__ unsigned fkey(float f) { const unsigned u = __builtin_bit_cast(unsigned, f); return u ^ ((unsigned)((int)u >> 31) | 0x80000000u); }
__device__ __forceinline__ float funkey(unsigned k) { return __builtin_bit_cast(float, (k & 0x80000000u) ? (k ^ 0x80000000u) : ~k); }
__device__ __forceinline__ int mbcnt64(unsigned long long m) { return (int)__builtin_amdgcn_mbcnt_hi((unsigned)(m >> 32), __builtin_amdgcn_mbcnt_lo((unsigned)m, 0u)); }
__device__ __forceinline__ float rdlane(float v, int l) { return __builtin_bit_cast(float, __builtin_amdgcn_readlane(__builtin_bit_cast(int, v), l)); }
__device__ __forceinline__ float gelu_tanh(float x) { const float u = 0.7978845608028654f * (x + 0.044715f * x * x * x); const float e = __expf(2.0f * u); const float th = 1.0f - 2.0f / (e + 1.0f); return 0.5f * x * (1.0f + th); }
typedef int v6i_t __attribute__((ext_vector_type(6)));
typedef __bf16 v32b_t __attribute__((ext_vector_type(32)));
typedef float v32f_t __attribute__((ext_vector_type(32)));
typedef unsigned v16u_t __attribute__((ext_vector_type(16)));
constexpr size_t TBL_SLICE = (size_t)16384 * 192, TBL_LAYER = 8 * TBL_SLICE;
__device__ __forceinline__ void row6_load(const float* src, f32x4 (&a)[8], int lane) {
    const int s = lane >> 3, b = lane & 7;
#pragma unroll
    for (int k = 0; k < 8; ++k) a[k] = *(const f32x4*)(src + 256 * s + 32 * k + 4 * b);
}
template <bool UL>
__device__ __forceinline__ float row_to_fp6(f32x4 (&a)[8], const float* g, unsigned char* dst, int lane) {
    const int s = lane >> 3, b = lane & 7;
    float amax = 0.f;
#pragma unroll
    for (int k = 0; k < 8; ++k) { const int e0 = 256 * s + 32 * k + 4 * b;
        if (g) a[k] = a[k] * *(const f32x4*)(g + e0);
        amax = fmaxf(amax, fmaxf(fmaxf(fabsf(a[k].x), fabsf(a[k].y)), fmaxf(fabsf(a[k].z), fabsf(a[k].w)))); }
    amax = wave_max(amax);
    const float enc = amax > 0.f ? 7.5f / amax : 1.f;
    v32b_t v;
#pragma unroll
    for (int k = 0; k < 8; ++k) { v[4 * k] = (__bf16)(a[k].x * enc); v[4 * k + 1] = (__bf16)(a[k].y * enc); v[4 * k + 2] = (__bf16)(a[k].z * enc); v[4 * k + 3] = (__bf16)(a[k].w * enc); }
    const v6i_t w = __builtin_amdgcn_cvt_scalef32_pk32_fp6_bf16(v, 1.0f);
    unsigned* row = (unsigned*)(dst + (size_t)s * TBL_SLICE);
    if (UL) { const int p = b >> 1; const bool h = b & 1;
        v4u q4; q4.x = (unsigned)(h ? w[2] : w[0]); q4.y = (unsigned)(h ? w[3] : w[1]); q4.z = (unsigned)(h ? w[4] : w[2]); q4.w = (unsigned)(h ? w[5] : w[3]);
        u32x2v q2; q2.x = (unsigned)(h ? w[0] : w[4]); q2.y = (unsigned)(h ? w[1] : w[5]);
        *(v4u*)(row + (h ? 32 : 0) + 4 * p) = q4; *(u32x2v*)(row + 16 + 4 * p + (h ? 2 : 0)) = q2; }
    else {
#pragma unroll
        for (int j = 0; j < 3; ++j) { u32x2v q2; q2.x = (unsigned)w[2 * j]; q2.y = (unsigned)w[2 * j + 1]; *(u32x2v*)(row + 16 * j + 2 * b) = q2; } }
    return amax > 0.f ? amax / 7.5f : 1.f;
}
struct TItem { const float* W; const float* g; void* WT; float scale; int ldw, c0, ncv, row_off, ldk, koff, k0, n0; bool f8; };
__device__ __forceinline__ void titem_load(const TItem& d, f32x4 (&v)[8], int lane) {
    const int cj = lane & 7, ks = lane >> 3; const bool ok = d.n0 + 4 * cj < d.ncv;
#pragma unroll
    for (int i = 0; i < 8; ++i) v[i] = ok ? *(const f32x4*)(d.W + (size_t)(d.k0 + 8 * i + ks) * d.ldw + d.c0 + d.n0 + 4 * cj) : (f32x4){0.f, 0.f, 0.f, 0.f};
}
__device__ __forceinline__ void titem_finish(const TItem& d, const f32x4 (&v)[8], LAS float* scr, int lane) {
    const int cj = lane & 7, ks = lane >> 3;
#pragma unroll
    for (int i = 0; i < 8; ++i) { const int kk = 8 * i + ks; const f32x4 w = v[i] * (d.g ? d.g[d.k0 + kk] * d.scale : d.scale);
        LAS float* p = scr + kk * 33 + 4 * cj; p[0] = w.x; p[1] = w.y; p[2] = w.z; p[3] = w.w; }
    LDS_WAIT(); asm volatile("" ::: "memory");
    if (!d.f8) { const int c = lane & 7; bf16* WT = (bf16*)d.WT;
#pragma unroll
        for (int j = 0; j < 4; ++j) { const int n = (lane >> 3) + 8 * j; const LAS float* sp = scr + (8 * c) * 33 + n;
            v4u o; o.x = pk2(sp[0 * 33], sp[1 * 33]); o.y = pk2(sp[2 * 33], sp[3 * 33]); o.z = pk2(sp[4 * 33], sp[5 * 33]); o.w = pk2(sp[6 * 33], sp[7 * 33]);
            *(v4u*)(WT + (size_t)(d.row_off + d.n0 + n) * d.ldk + d.koff + d.k0 + 8 * c) = o; } }
    else { const int n = lane >> 1, hf = lane & 1; const LAS float* sp = scr + (32 * hf) * 33 + n;
        unsigned w[8];
#pragma unroll
        for (int q = 0; q < 8; ++q) { int t = __builtin_amdgcn_cvt_pk_fp8_f32(sp[(4 * q) * 33], sp[(4 * q + 1) * 33], 0, false); t = __builtin_amdgcn_cvt_pk_fp8_f32(sp[(4 * q + 2) * 33], sp[(4 * q + 3) * 33], t, true); w[q] = (unsigned)t; }
        unsigned char* dp = (unsigned char*)d.WT + (size_t)(d.row_off + d.n0 + n) * d.ldk + d.koff + d.k0 + 32 * hf;
        *(v4u*)dp = (v4u){w[0], w[1], w[2], w[3]}; *(v4u*)(dp + 16) = (v4u){w[4], w[5], w[6], w[7]}; }
    LDS_WAIT(); asm volatile("" ::: "memory");
}
__device__ __forceinline__ int rel_bucket(int d) {
    if (d < 16) return d;
    const int v = 16 + (int)(logf((float)d / 16.0f) / 4.852030263919617f * 16.0f);
    return v < 31 ? v : 31;
}
struct Ptrs {
    const float *x, *rel_bias, *g_mix, *w_in, *a_sinks, *c_gain, *w_uk, *w_uv, *w_a, *w_b, *w_c, *w_out, *g_ffn, *w_q, *sub_keys, *peer_u, *peer_v, *g_final;
    float* out; unsigned char* ws;
};
__device__ __forceinline__ void p0_prologue(const Ptrs& P, LAS unsigned char* lds, int gw, int NGW, int wave, int lane) {
    LAS float* scr = (LAS float*)(lds + wave * 16384);
    unsigned char* ws = P.ws;
    constexpr int I_IN1 = 32 * 32, I_IN1B = 32 * 16, I_IN8A = 32 * 48, I_IN8B = 32 * 32, I_IN2 = 32 * 192, I_A = 16 * 64, I_B = 8 * 64, I_C = 8 * 64, I_O = 32 * 64, I_Q = 32 * 64;
    constexpr int I_LAYER = I_IN1 + I_IN1B + I_IN8A + I_IN8B + I_IN2 + I_A + I_B + I_C + I_O + I_Q;
    auto mk = [&](int it) -> TItem {
        const int l = it / I_LAYER; int r = it % I_LAYER; TItem d;
        const float* win = P.w_in + (size_t)l * 2048 * IN_COLS; const float* gm = P.g_mix + l * 2048;
        auto set = [&](const float* W, int ldw, int c0, int ncv, const float* g, float scale, void* WT, int nblk, int ldk, int koff, bool f8) {
            d.W = W; d.ldw = ldw; d.c0 = c0; d.ncv = ncv; d.g = g; d.scale = scale; d.WT = WT; d.row_off = 0; d.ldk = ldk; d.koff = koff; d.k0 = 64 * (r / nblk); d.n0 = 32 * (r % nblk); d.f8 = f8; };
        bf16* WinT = (bf16*)(ws + WS_WIN) + (size_t)l * NPROJ * 2048; unsigned char* Win8 = ws + WS_WG8 + (size_t)l * NPROJ * 2048;
        if (r < I_IN1) { set(win, IN_COLS, 1536, 1024, gm, 1.0f, WinT, 32, 2048, 0, false); d.row_off = 1536; return d; } r -= I_IN1;
        if (r < I_IN1B) { set(win, IN_COLS, 3584, 424, gm, 1.0f, WinT, 16, 2048, 0, false); d.row_off = 3584; return d; } r -= I_IN1B;
        if (r < I_IN8A) { set(win, IN_COLS, 0, 1536, gm, 256.0f, Win8, 48, 2048, 0, true); return d; } r -= I_IN8A;
        if (r < I_IN8B) { set(win, IN_COLS, 2560, 1024, gm, 256.0f, Win8, 32, 2048, 0, true); d.row_off = 2560; return d; } r -= I_IN8B;
        if (r < I_IN2) { set(win, IN_COLS, 4008, 6144, gm, 256.0f, Win8, 192, 2048, 0, true); d.row_off = 4096; return d; } r -= I_IN2;
        if (r < I_A) { set(P.w_a + (size_t)l * 1024 * 2048, 2048, 0, 2048, nullptr, 128.0f, ws + WS_WA + (size_t)l * 2048 * 2048, 64, 2048, 0, true); return d; } r -= I_A;
        if (r < I_B) { set(P.w_b + (size_t)l * 512 * 2048, 2048, 0, 2048, nullptr, 128.0f, ws + WS_WA + (size_t)l * 2048 * 2048, 64, 2048, 1024, true); return d; } r -= I_B;
        if (r < I_C) { set(P.w_c + (size_t)l * 512 * 2048, 2048, 0, 2048, nullptr, 128.0f, ws + WS_WA + (size_t)l * 2048 * 2048, 64, 2048, 1536, true); return d; } r -= I_C;
        if (r < I_O) { set(P.w_out + (size_t)l * 2048 * 2048, 2048, 0, 2048, nullptr, 256.0f, ws + WS_WOUT + (size_t)l * 2048 * 2048, 64, 2048, 0, true); return d; } r -= I_O;
        set(P.w_q + (size_t)l * 2048 * 2048, 2048, 0, 2048, P.g_ffn + l * 2048, 1.0f, (bf16*)(ws + WS_WQ) + (size_t)l * 2048 * 2048, 64, 2048, 0, false); return d; };
    { f32x4 nx[8];
      if (gw < 2 * I_LAYER) { const TItem d0 = mk(gw); titem_load(d0, nx, lane); }
#pragma unroll 1
      for (int it = gw; it < 2 * I_LAYER; it += NGW) {
          const TItem d = mk(it);
          f32x4 a[8];
#pragma unroll
          for (int k = 0; k < 8; ++k) a[k] = nx[k];
          { const TItem dn = mk((it + NGW < 2 * I_LAYER) ? it + NGW : it); titem_load(dn, nx, lane); }
          titem_finish(d, a, scr, lane);
      } }
    { f32x4 nx[8];
      if (gw < 4 * 16384) { const int tb = gw >> 14, e = gw & 16383, l = tb & 1; row6_load((tb < 2 ? P.peer_u : P.peer_v) + ((size_t)l * 16384 + e) * 2048, nx, lane); }
#pragma unroll 1
      for (int it = gw; it < 4 * 16384; it += NGW) {
        const int tb = it >> 14, e = it & 16383, l = tb & 1;
        f32x4 a[8];
#pragma unroll
        for (int k = 0; k < 8; ++k) a[k] = nx[k];
        { const int itn = (it + NGW < 4 * 16384) ? it + NGW : it; const int tbn = itn >> 14, en = itn & 16383, ln = tbn & 1; row6_load((tbn < 2 ? P.peer_u : P.peer_v) + ((size_t)ln * 16384 + en) * 2048, nx, lane); }
        if (tb < 2) { const float sc = row_to_fp6<true>(a, P.g_ffn + l * 2048, ws + WS_U + (size_t)l * TBL_LAYER + (size_t)e * 192, lane); if (lane == 0) ((float*)(ws + WS_USC))[2 * (l * 16384 + e)] = sc; }
        else        { const float sc = row_to_fp6<false>(a, nullptr, ws + WS_V + (size_t)l * TBL_LAYER + (size_t)e * 192, lane); if (lane == 0) ((float*)(ws + WS_USC))[2 * (l * 16384 + e) + 1] = sc; }
      } }
    float* RS = (float*)(ws + WS_RS);
    { f32x4 nx[8];
      if (gw < M) {
#pragma unroll
          for (int i = 0; i < 4; ++i) { const float* p = P.x + (size_t)gw * 2048 + 8 * (lane + 64 * i); nx[2 * i] = *(const f32x4*)p; nx[2 * i + 1] = *(const f32x4*)(p + 4); } }
#pragma unroll 1
      for (int m = gw; m < M; m += NGW) {
          f32x4 a[8];
#pragma unroll
          for (int k = 0; k < 8; ++k) a[k] = nx[k];
          { const int mn = (m + NGW < M) ? m + NGW : m;
#pragma unroll
            for (int i = 0; i < 4; ++i) { const float* p = P.x + (size_t)mn * 2048 + 8 * (lane + 64 * i); nx[2 * i] = *(const f32x4*)p; nx[2 * i + 1] = *(const f32x4*)(p + 4); } }
          float ss = 0.f; bf16* dst = (bf16*)(ws + WS_XB) + (size_t)m * 2048; unsigned char* dst8 = ws + WS_XB8 + (size_t)m * 2048;
#pragma unroll
          for (int i = 0; i < 4; ++i) { const int e0 = 8 * (lane + 64 * i); const f32x4 p = a[2 * i], q = a[2 * i + 1];
              ss += (p.x * p.x + p.y * p.y) + (p.z * p.z + p.w * p.w) + (q.x * q.x + q.y * q.y) + (q.z * q.z + q.w * q.w);
              v4u o; o.x = pk2(p.x, p.y); o.y = pk2(p.z, p.w); o.z = pk2(q.x, q.y); o.w = pk2(q.z, q.w); *(v4u*)(dst + e0) = o;
              int w0 = __builtin_amdgcn_cvt_pk_fp8_f32(p.x, p.y, 0, false); w0 = __builtin_amdgcn_cvt_pk_fp8_f32(p.z, p.w, w0, true); int w1 = __builtin_amdgcn_cvt_pk_fp8_f32(q.x, q.y, 0, false); w1 = __builtin_amdgcn_cvt_pk_fp8_f32(q.z, q.w, w1, true);
              u32x2v o8; o8.x = (unsigned)w0; o8.y = (unsigned)w1; *(u32x2v*)(dst8 + e0) = o8; }
          ss = wave_sum(ss);
          if (lane < 16) RS[m * 16 + lane] = lane == 0 ? ss : 0.f; } }
    { bf16* SKB = (bf16*)(ws + WS_SKB);
      for (int i = gw * 64 + lane; i < 2 * 262144 / 4; i += NGW * 64) { const f32x4 v = *(const f32x4*)(P.sub_keys + 4 * (size_t)i); u32x2v o; o.x = pk2(v.x, v.y); o.y = pk2(v.z, v.w); *(u32x2v*)(SKB + 4 * (size_t)i) = o; } }
    { bf16* WUKB = (bf16*)(ws + WS_WUKB); bf16* WUVT = (bf16*)(ws + WS_WUVT);
      for (int i = gw * 64 + lane; i < 2 * 65536; i += NGW * 64) { const int l = i >> 16, c = (i >> 9) & 127, h = (i >> 6) & 7, d = i & 63;
          WUKB[((size_t)(l * 8 + h) * 128 + c) * 64 + d] = (bf16)f2bf(P.w_uk[i]); WUVT[((size_t)(l * 8 + h) * 64 + d) * 128 + c] = (bf16)f2bf(P.w_uv[i]); } }
    float* biasd = (float*)(ws + WS_BIASD);
    for (int i = gw * 64 + lane; i < 32 * 2048; i += NGW * 64) { const int hh = i >> 11, d = i & 2047; biasd[i] = P.rel_bias[rel_bucket(d) * 32 + hh]; }
}
__device__ __forceinline__ void cn_item(const bf16* PA, const float* gain, bf16* CN, int item, int lane) {
    const int row = 4 * item + (lane >> 4), c8 = 8 * (lane & 15);
    const v4u cv = *(const v4u*)(PA + (size_t)row * PA_LD + C_CL + c8);
    const float f0 = bflo(cv.x), f1 = bfhi(cv.x), f2 = bflo(cv.y), f3 = bfhi(cv.y), f4 = bflo(cv.z), f5 = bfhi(cv.z), f6 = bflo(cv.w), f7 = bfhi(cv.w);
    float ss = ((f0 * f0 + f1 * f1) + (f2 * f2 + f3 * f3)) + ((f4 * f4 + f5 * f5) + (f6 * f6 + f7 * f7));
    ss += lane_xor<1>(ss); ss += lane_xor<2>(ss); ss += lane_xor<4>(ss); ss += lane_xor<8>(ss);
    const float r = rsqrtf(ss * (1.0f / 128.0f) + EPS);
    const f32x4 g0 = *(const f32x4*)(gain + c8), g1 = *(const f32x4*)(gain + c8 + 4);
    v4u o; o.x = pk2(f0 * r * g0.x, f1 * r * g0.y); o.y = pk2(f2 * r * g0.z, f3 * r * g0.w); o.z = pk2(f4 * r * g1.x, f5 * r * g1.y); o.w = pk2(f6 * r * g1.z, f7 * r * g1.w);
    *(v4u*)(CN + (size_t)row * 128 + c8) = o;
}
typedef float f32x16 __attribute__((ext_vector_type(16)));
typedef short s16x4 __attribute__((ext_vector_type(4)));
#define MFMA32(a, b, c) __builtin_amdgcn_mfma_f32_32x32x16_bf16((a), (b), (c), 0, 0, 0)
__device__ __forceinline__ s16x4 vtr(const LAS unsigned char* p) { return __builtin_bit_cast(s16x4, __builtin_amdgcn_ds_read_tr16_b64_v4i16((LAS s16x4*)p)); }
__device__ __forceinline__ float xhalf_max(float v) { const unsigned u = __builtin_bit_cast(unsigned, v); auto rr = __builtin_amdgcn_permlane32_swap(u, u, false, false); return fmaxf(__builtin_bit_cast(float, (unsigned)rr[0]), __builtin_bit_cast(float, (unsigned)rr[1])); }
__device__ __forceinline__ float xhalf_sum(float v) { const unsigned u = __builtin_bit_cast(unsigned, v); auto rr = __builtin_amdgcn_permlane32_swap(u, u, false, false); return __builtin_bit_cast(float, (unsigned)rr[0]) + __builtin_bit_cast(float, (unsigned)rr[1]); }
__device__ __forceinline__ unsigned pkbf(float lo, float hi) { return pg8::cvt_pk_bf16(lo, hi); }
__device__ __forceinline__ unsigned pk4f8(float a, float b, float c, float d) { int w = __builtin_amdgcn_cvt_pk_fp8_f32(a * 16.0f, b * 16.0f, 0, false); return (unsigned)__builtin_amdgcn_cvt_pk_fp8_f32(c * 16.0f, d * 16.0f, w, true); }
template <int DK> __device__ __forceinline__ void qk_tile(const LAS unsigned char* Kt, const bf16x8 (&qf)[DK / 16], f32x16& p0, f32x16& p1, int r, int hh) {
#pragma unroll
    for (int i = 0; i < 16; ++i) { p0[i] = 0.f; p1[i] = 0.f; }
#pragma unroll
    for (int st = 0; st < DK / 16; ++st) {
        const bf16x8 k0 = *(const LAS bf16x8*)(Kt + ((2 * st + hh) * 64 + r) * 16);
        const bf16x8 k1 = *(const LAS bf16x8*)(Kt + ((2 * st + hh) * 64 + 32 + r) * 16);
        p0 = MFMA32(k0, qf[st], p0); p1 = MFMA32(k1, qf[st], p1);
    }
}
__device__ __forceinline__ float softmax_tile(f32x16& p0, f32x16& p1, float& m, float& l) {
    float mt = fmaxf(p0[0], p1[0]);
#pragma unroll
    for (int i = 1; i < 16; ++i) mt = fmaxf(mt, fmaxf(p0[i], p1[i]));
    mt = xhalf_max(mt);
    const float mn = fmaxf(m, mt);
    const float mu = (mn == -INFINITY) ? 0.f : mn;
    const float alpha = __builtin_amdgcn_exp2f(m - mu);
    float s = 0.f;
#pragma unroll
    for (int i = 0; i < 16; ++i) { p0[i] = __builtin_amdgcn_exp2f(p0[i] - mu); p1[i] = __builtin_amdgcn_exp2f(p1[i] - mu); s += p0[i] + p1[i]; }
    l = l * alpha + s; m = mn;
    return alpha;
}
constexpr float LOG2E = 1.4426950408889634f, QK_SCALE2 = 0.125f * LOG2E;
template <int DV> __device__ __forceinline__ void pv_tile(const LAS unsigned char* Vt, const f32x16& p0, const f32x16& p1, f32x16 (&o)[DV / 32], int lane) {
    const LAS unsigned char* vb = Vt + ((lane >> 4) & 1) * 32 + (lane & 3) * 8 + (4 * (lane >> 5) + ((lane & 15) >> 2)) * 64;
#pragma unroll
    for (int s = 0; s < 4; ++s) {
        const f32x16& p = (s < 2) ? p0 : p1; const int b0 = 8 * (s & 1);
        u32x4v pw; pw.x = pkbf(p[b0 + 0], p[b0 + 1]); pw.y = pkbf(p[b0 + 2], p[b0 + 3]); pw.z = pkbf(p[b0 + 4], p[b0 + 5]); pw.w = pkbf(p[b0 + 6], p[b0 + 7]);
        const bf16x8 pf = __builtin_bit_cast(bf16x8, pw);
#pragma unroll
        for (int db = 0; db < DV / 32; ++db) {
            const s16x4 lo = vtr(vb + db * 4096 + s * 1024), hi = vtr(vb + db * 4096 + s * 1024 + 512);
            const bf16x8 vf = (bf16x8){lo[0], lo[1], lo[2], lo[3], hi[0], hi[1], hi[2], hi[3]};
            o[db] = MFMA32(vf, pf, o[db]);
        }
    }
}
__device__ __forceinline__ void sel_unit(const bf16* PA, float* SC, unsigned long long* MASK, int b, int qt, LAS unsigned char* lds, int tid, int wave, int lane) {
    const int r = lane & 31, hh = lane >> 5;
    if (qt >= 8) {
        const int t = 32 * qt + r, row = b * T + t;
        LAS unsigned char* qs = lds + 65536;
        { int tq = tid; asm volatile("" : "+v"(tq));
          v4u tq4[3];
#pragma unroll
          for (int k = 0; k < 3; ++k) { const int c = tq + NWAVES * 64 * k, cc = c < 32 * 33 ? c : 0; const int rr = cc / 33, j = cc - 33 * rr;
              tq4[k] = *(const v4u*)(PA + (size_t)(b * T + 32 * qt + rr) * PA_LD + (j < 32 ? C_IQ + 8 * j : C_IW)); }
#pragma unroll
          for (int k = 0; k < 3; ++k) { const int c = tq + NWAVES * 64 * k; if (c < 32 * 33) { const int rr = c / 33, j = c - 33 * rr; *(LAS v4u*)(qs + rr * 528 + 16 * j) = tq4[k]; } } }
        __syncthreads();
        const int NT = (qt >> 1) + 1;
        int rk = r; asm volatile("" : "+v"(rk));
        const LAS unsigned char* qr = qs + rk * 528 + 16 * hh;
        bf16x8 k00, k01, k10, k11;
        if (wave < NT) { const bf16* kp = PA + (size_t)(b * T + 64 * wave + rk) * PA_LD + C_IK + 8 * hh;
            k00 = *(const bf16x8*)kp; k01 = *(const bf16x8*)(kp + 16); k10 = *(const bf16x8*)(kp + (size_t)32 * PA_LD); k11 = *(const bf16x8*)(kp + (size_t)32 * PA_LD + 16); }
#pragma unroll 1
        for (int tt = wave; tt < NT; tt += NWAVES) {
            const int s0 = 64 * tt;
            const bf16x8 c00 = k00, c01 = k01, c10 = k10, c11 = k11;
            { const int tn = (tt + NWAVES < NT) ? tt + NWAVES : tt;
              const bf16* kp = PA + (size_t)(b * T + 64 * tn + rk) * PA_LD + C_IK + 8 * hh;
              k00 = *(const bf16x8*)kp; k01 = *(const bf16x8*)(kp + 16); k10 = *(const bf16x8*)(kp + (size_t)32 * PA_LD); k11 = *(const bf16x8*)(kp + (size_t)32 * PA_LD + 16); }
            f32x16 s0a, s1a;
#pragma unroll
            for (int i = 0; i < 16; ++i) { s0a[i] = 0.f; s1a[i] = 0.f; }
            bf16x8 q0 = *(const LAS bf16x8*)qr, q1 = *(const LAS bf16x8*)(qr + 32); unsigned iwb = *(const LAS unsigned short*)(qs + rk * 528 + 512);
#pragma unroll 1
            for (int h = 0; h < 8; ++h) {
                const int hn = (h + 1) & 7;
                const bf16x8 q0n = *(const LAS bf16x8*)(qr + 64 * hn), q1n = *(const LAS bf16x8*)(qr + 64 * hn + 32); const unsigned iwn = *(const LAS unsigned short*)(qs + rk * 528 + 512 + 2 * hn);
                const float iwh = __builtin_bit_cast(float, iwb << 16);
                f32x16 a0, a1;
#pragma unroll
                for (int i = 0; i < 16; ++i) { a0[i] = 0.f; a1[i] = 0.f; }
                a0 = MFMA32(c00, q0, a0); a0 = MFMA32(c01, q1, a0);
                a1 = MFMA32(c10, q0, a1); a1 = MFMA32(c11, q1, a1);
#pragma unroll
                for (int i = 0; i < 16; ++i) { s0a[i] = fmaf(iwh, fmaxf(a0[i], 0.f), s0a[i]); s1a[i] = fmaf(iwh, fmaxf(a1[i], 0.f), s1a[i]); }
                q0 = q0n; q1 = q1n; iwb = iwn;
            }
            float* sp = SC + (size_t)row * 2048 + s0 + 4 * hh;
#pragma unroll
            for (int g = 0; g < 4; ++g) { *(f32x4*)(sp + 8 * g) = (f32x4){s0a[4 * g], s0a[4 * g + 1], s0a[4 * g + 2], s0a[4 * g + 3]}; *(f32x4*)(sp + 32 + 8 * g) = (f32x4){s1a[4 * g], s1a[4 * g + 1], s1a[4 * g + 2], s1a[4 * g + 3]}; }
        }
    }
    __syncthreads();
#define SEL_CNT4(pred, a0_, a1_, a2_, a3_, thr_, acc_) do { unsigned long long m0_, m1_, m2_, m3_; \
        asm("v_cmp_" pred "_u32_e64 %0, %4, %8\n\tv_cmp_" pred "_u32_e64 %1, %5, %8\n\tv_cmp_" pred "_u32_e64 %2, %6, %8\n\tv_cmp_" pred "_u32_e64 %3, %7, %8" \
            : "=&s"(m0_), "=&s"(m1_), "=&s"(m2_), "=&s"(m3_) : "v"(a0_), "v"(a1_), "v"(a2_), "v"(a3_), "v"(thr_)); \
        acc_ += (__popcll(m0_) + __popcll(m1_)) + (__popcll(m2_) + __popcll(m3_)); } while (0)
    float nv[32];
    { const int t0 = 32 * qt + 4 * wave; int ls0 = lane; asm volatile("" : "+v"(ls0));
      if (t0 >= 256) { const float* srow = SC + (size_t)(b * T + t0) * 2048 + ls0; const int ng0 = (t0 >> 6) + 1;
#pragma unroll
          for (int g = 0; g < 4; ++g) if (8 * g < ng0) {
#pragma unroll
              for (int jj = 0; jj < 8; ++jj) nv[8 * g + jj] = srow[64 * (8 * g + jj)]; } } }
#pragma unroll 1
    for (int qi = 0; qi < 4; ++qi) {
        const int t = 32 * qt + 4 * wave + qi, row = b * T + t;
        unsigned long long* mrow = MASK + (size_t)row * 32;
        if (t < 256) {
            if (lane < 32) { const int lo = 64 * lane; unsigned long long m = 0ull; if (t >= lo + 63) m = ~0ull; else if (t >= lo) m = (2ull << (t - lo)) - 1ull; mrow[lane] = m; }
            continue;
        }
        int ls = lane; asm volatile("" : "+v"(ls));
        unsigned keys[32];
#pragma unroll
        for (int j = 0; j < 32; ++j) keys[j] = (64 * j + ls <= t) ? fkey(nv[j]) : 0u;
        if (qi < 3) { const float* srow = SC + (size_t)(row + 1) * 2048 + ls; const int ngn = ((t + 1) >> 6) + 1;
#pragma unroll
            for (int g = 0; g < 4; ++g) if (8 * g < ngn) {
#pragma unroll
                for (int jj = 0; jj < 8; ++jj) nv[8 * g + jj] = srow[64 * (8 * g + jj)]; } }
        unsigned tau = 0u;
#pragma unroll 1
        for (int bit = 31; bit >= 0; --bit) {
            const unsigned cand = tau | (1u << bit); int cnt = 0;
#pragma unroll
            for (int g = 0; g < 8; ++g) SEL_CNT4("ge", keys[4 * g], keys[4 * g + 1], keys[4 * g + 2], keys[4 * g + 3], cand, cnt);
            if (cnt >= 256) tau = cand;
            if (cnt == 256) break;
        }
        int need = 256;
#pragma unroll
        for (int g = 0; g < 8; ++g) { int c_ = 0; SEL_CNT4("gt", keys[4 * g], keys[4 * g + 1], keys[4 * g + 2], keys[4 * g + 3], tau, c_); need -= c_; }
#pragma unroll
        for (int j = 0; j < 32; ++j) {
            unsigned long long eq, gt;
            asm("v_cmp_eq_u32_e64 %0, %2, %3\n\tv_cmp_gt_u32_e64 %1, %2, %3" : "=&s"(eq), "=&s"(gt) : "v"(keys[j]), "v"(tau));
            const int c = __popcll(eq); unsigned long long take;
            if (c <= need) { take = eq; need -= c; } else { take = __ballot((keys[j] == tau) && (mbcnt64(eq) < need)); need = 0; }
            if (lane == 0) mrow[j] = gt | take;
        }
    }
#undef SEL_CNT4
    __syncthreads();
}
constexpr int AT_K0 = 0, AT_K1 = 8192, AT_V0 = 16384, AT_V1 = 24576, AT_RB = 32768, MOBA_RBN = 2048 + 320;
__device__ __forceinline__ void moba_unit(const bf16* PA, const float* biasd, const float* KM, bf16* YB, int b, int h, int n, LAS unsigned char* lds, int tid, int wave, int lane) {
    const int r = lane & 31, hh = lane >> 5;
    const int t = 256 * n + 32 * wave + r, row = b * T + t;
    LAS float* RB = (LAS float*)(lds + AT_RB);
    __syncthreads();
    { int tf = tid; asm volatile("" : "+v"(tf)); float tv[4];
#pragma unroll
      for (int k = 0; k < 4; ++k) tv[k] = biasd[(16 + h) * 2048 + 2047 - (tf + NWAVES * 64 * k)];
#pragma unroll
      for (int k = 0; k < 4; ++k) RB[tf + NWAVES * 64 * k] = tv[k] * LOG2E;
      if (tf + 2048 < MOBA_RBN) RB[tf + 2048] = -INFINITY; }
    bf16x8 qf[4];
    const bf16* qp = PA + (size_t)row * PA_LD + C_QB + h * 64;
#pragma unroll
    for (int st = 0; st < 4; ++st) qf[st] = *(const bf16x8*)(qp + 16 * st + 8 * hh);
    unsigned selmask = (1u << n) - 1u;
    if (n > 3) {
        int z = 0; asm volatile("" : "+v"(z));
        float gv[8];
#pragma unroll
        for (int nn = 0; nn < 8; ++nn) gv[nn] = 0.f;
#pragma unroll 1
        for (int d8 = 0; d8 < 8; ++d8) {
            const v4u qv = *(const v4u*)(qp + 8 * d8);
            const float q0 = bflo(qv.x), q1 = bfhi(qv.x), q2 = bflo(qv.y), q3 = bfhi(qv.y), q4 = bflo(qv.z), q5 = bfhi(qv.z), q6 = bflo(qv.w), q7 = bfhi(qv.w);
#pragma unroll
            for (int nn = 0; nn < 7; ++nn) { const float* kmp = KM + ((b * 8 + nn) * 8 + h) * 64 + 8 * d8 + z; const f32x4 ka = *(const f32x4*)kmp, kb = *(const f32x4*)(kmp + 4);
                gv[nn] += (q0 * ka.x + q1 * ka.y) + (q2 * ka.z + q3 * ka.w) + (q4 * kb.x + q5 * kb.y) + (q6 * kb.z + q7 * kb.w); }
        }
#pragma unroll
        for (int nn = 0; nn < 8; ++nn) if (nn >= n) gv[nn] = -INFINITY;
        selmask = 0u;
#pragma unroll
        for (int rr = 0; rr < 3; ++rr) { int bi = 0; float bv = gv[0];
#pragma unroll
            for (int nn = 1; nn < 8; ++nn) if (gv[nn] > bv) { bv = gv[nn]; bi = nn; }
            selmask |= 1u << bi;
#pragma unroll
            for (int nn = 0; nn < 8; ++nn) if (nn == bi) gv[nn] = -INFINITY; }
    }
    f32x16 o[2];
#pragma unroll
    for (int i = 0; i < 16; ++i) { o[0][i] = 0.f; o[1][i] = 0.f; }
    float m = -INFINITY, l = 0.f;
    const int NT = 4 * (n + 1);
    const int skey = tid >> 3, sc = tid & 7;
    const bf16* Kg = PA + (size_t)(b * T + skey) * PA_LD + C_KB + h * 64 + sc * 8;
    const bf16* Vg = PA + (size_t)(b * T + skey) * PA_LD + C_VB + h * 64 + sc * 8;
    const int kwo = (sc * 64 + skey) * 16, vwo = (sc >> 2) * 4096 + skey * 64 + (sc & 3) * 16;
    v4u kreg = *(const v4u*)Kg, vreg = *(const v4u*)Vg;
    *(LAS v4u*)(lds + AT_K0 + kwo) = kreg; *(LAS v4u*)(lds + AT_V0 + vwo) = vreg;
    __syncthreads();
#pragma unroll 1
    for (int tt = 0; tt < NT; ++tt) {
        const int s0 = 64 * tt, buf = tt & 1;
        if (tt + 1 < NT) { kreg = *(const v4u*)(Kg + (size_t)(s0 + 64) * PA_LD); vreg = *(const v4u*)(Vg + (size_t)(s0 + 64) * PA_LD); }
        const bool own = (tt >> 2) == n;
        if (!own || s0 <= 256 * n + 32 * wave + 31) {
            f32x16 p0, p1;
            qk_tile<64>(lds + (buf ? AT_K1 : AT_K0), qf, p0, p1, r, hh);
            const int dl = t - s0 - 4 * hh;
            const bool selv = own || ((selmask >> (tt >> 2)) & 1u);
            const LAS float* rb = selv ? RB + (2047 - dl) : RB + 2176;
#pragma unroll
            for (int i = 0; i < 16; ++i) { const int c0 = (i & 3) + 8 * (i >> 2); p0[i] = fmaf(p0[i], QK_SCALE2, rb[c0]); p1[i] = fmaf(p1[i], QK_SCALE2, rb[c0 + 32]); }
            const float alpha = softmax_tile(p0, p1, m, l);
            if (__any(alpha != 1.0f)) {
#pragma unroll
                for (int i = 0; i < 16; ++i) { o[0][i] *= alpha; o[1][i] *= alpha; } }
            pv_tile<64>(lds + (buf ? AT_V1 : AT_V0), p0, p1, o, lane);
        }
        if (tt + 1 < NT) { *(LAS v4u*)(lds + (buf ? AT_K0 : AT_K1) + kwo) = kreg; *(LAS v4u*)(lds + (buf ? AT_V0 : AT_V1) + vwo) = vreg; }
        __syncthreads();
    }
    const float inv = 1.0f / xhalf_sum(l);
    unsigned char* yp = (unsigned char*)YB + (size_t)row * 2048 + 1024 + h * 64 + 4 * hh;
#pragma unroll
    for (int db = 0; db < 2; ++db)
#pragma unroll
        for (int g = 0; g < 4; ++g) *(unsigned*)(yp + 32 * db + 8 * g) = pk4f8(o[db][4 * g] * inv, o[db][4 * g + 1] * inv, o[db][4 * g + 2] * inv, o[db][4 * g + 3] * inv);
}
constexpr int SWA_RBN = 260;
__device__ __forceinline__ void swa_unit(const bf16* PA, const float* biasd, const float* sinks, bf16* YA, int b, int kvh, int qb, LAS unsigned char* lds, int tid, int wave, int lane) {
    const int r = lane & 31, hh = lane >> 5, g = wave >> 1, hq = kvh * 4 + g;
    const int t = 64 * qb + 32 * (wave & 1) + r, row = b * T + t;
    LAS float* RBall = (LAS float*)(lds + AT_RB);
    __syncthreads();
    { int tf = tid; asm volatile("" : "+v"(tf)); float tv[3];
#pragma unroll
      for (int k = 0; k < 3; ++k) { const int j = tf + NWAVES * 64 * k; const int jc = j < 4 * SWA_RBN ? j : 0; const int gg = jc / SWA_RBN, jj = jc - gg * SWA_RBN; tv[k] = biasd[(kvh * 4 + gg) * 2048 + ((jj >= 64 && jj < 192) ? 191 - jj : 0)]; }
#pragma unroll
      for (int k = 0; k < 3; ++k) { const int j = tf + NWAVES * 64 * k; if (j < 4 * SWA_RBN) { const int gg = j / SWA_RBN, jj = j - gg * SWA_RBN; RBall[j] = (jj >= 64 && jj < 192) ? tv[k] * LOG2E : -INFINITY; } } }
    const LAS float* RB = RBall + g * SWA_RBN;
    bf16x8 qf[4];
    const bf16* qp = PA + (size_t)row * PA_LD + C_QA + hq * 64;
#pragma unroll
    for (int st = 0; st < 4; ++st) qf[st] = *(const bf16x8*)(qp + 16 * st + 8 * hh);
    f32x16 o[2];
#pragma unroll
    for (int i = 0; i < 16; ++i) { o[0][i] = 0.f; o[1][i] = 0.f; }
    float m = -INFINITY, l = 0.f;
    const int tt0 = qb >= 2 ? qb - 2 : 0;
    const int skey = tid >> 3, sc = tid & 7;
    const bf16* Kg = PA + (size_t)(b * T + skey) * PA_LD + C_KA + kvh * 64 + sc * 8;
    const bf16* Vg = PA + (size_t)(b * T + skey) * PA_LD + C_VA + kvh * 64 + sc * 8;
    const int kwo = (sc * 64 + skey) * 16, vwo = (sc >> 2) * 4096 + skey * 64 + (sc & 3) * 16;
    v4u kreg = *(const v4u*)(Kg + (size_t)(64 * tt0) * PA_LD), vreg = *(const v4u*)(Vg + (size_t)(64 * tt0) * PA_LD);
    *(LAS v4u*)(lds + AT_K0 + kwo) = kreg; *(LAS v4u*)(lds + AT_V0 + vwo) = vreg;
    __syncthreads();
#pragma unroll 1
    for (int tt = tt0; tt <= qb; ++tt) {
        const int s0 = 64 * tt, buf = (tt - tt0) & 1;
        if (tt < qb) { kreg = *(const v4u*)(Kg + (size_t)(s0 + 64) * PA_LD); vreg = *(const v4u*)(Vg + (size_t)(s0 + 64) * PA_LD); }
        {
            f32x16 p0, p1;
            qk_tile<64>(lds + (buf ? AT_K1 : AT_K0), qf, p0, p1, r, hh);
            const int dl = t - s0 - 4 * hh;
            const LAS float* rb = RB + (191 - dl);
#pragma unroll
            for (int i = 0; i < 16; ++i) { const int c0 = (i & 3) + 8 * (i >> 2); p0[i] = fmaf(p0[i], QK_SCALE2, rb[c0]); p1[i] = fmaf(p1[i], QK_SCALE2, rb[c0 + 32]); }
            const float alpha = softmax_tile(p0, p1, m, l);
            if (__any(alpha != 1.0f)) {
#pragma unroll
                for (int i = 0; i < 16; ++i) { o[0][i] *= alpha; o[1][i] *= alpha; } }
            pv_tile<64>(lds + (buf ? AT_V1 : AT_V0), p0, p1, o, lane);
        }
        if (tt < qb) { *(LAS v4u*)(lds + (buf ? AT_K0 : AT_K1) + kwo) = kreg; *(LAS v4u*)(lds + (buf ? AT_V0 : AT_V1) + vwo) = vreg; }
        __syncthreads();
    }
    const float inv = 1.0f / (xhalf_sum(l) + __builtin_amdgcn_exp2f(sinks[hq] * LOG2E - m));
    unsigned char* yp = (unsigned char*)YA + (size_t)row * 2048 + hq * 64 + 4 * hh;
#pragma unroll
    for (int db = 0; db < 2; ++db)
#pragma unroll
        for (int gq = 0; gq < 4; ++gq) *(unsigned*)(yp + 32 * db + 8 * gq) = pk4f8(o[db][4 * gq] * inv, o[db][4 * gq + 1] * inv, o[db][4 * gq + 2] * inv, o[db][4 * gq + 3] * inv);
}
constexpr int DS_K0 = 0, DS_V0 = 16384, DS_K1 = 32768, DS_V1 = 49152, DS_RB = 65536, DS_RBN = 2048 + 128;
static_assert(DS_RB + 8 * DS_RBN * 4 <= LDSCTL_OFF, "DSA LDS map");
__device__ __forceinline__ bf16x8 pack8(const f32x4 a, const f32x4 b) { u32x4v w; w.x = pkbf(a.x, a.y); w.y = pkbf(a.z, a.w); w.z = pkbf(b.x, b.y); w.w = pkbf(b.z, b.w); return __builtin_bit_cast(bf16x8, w); }
__device__ __forceinline__ void dsa_unit(const bf16* CN, const bf16* PA, const unsigned long long* MASK, const float* biasd, const bf16* WUKB, const bf16* WUVT, bf16* YC, int b, int qt, LAS unsigned char* lds, int tid, int wave, int lane) {
    const int r = lane & 31, hh = lane >> 5, h = wave;
    const int t = 32 * qt + r, row = b * T + t;
    __syncthreads();
    static_assert(8 * DS_RBN == 34 * NWAVES * 64, "DSA bias table fill");
    { int tf = tid; asm volatile("" : "+v"(tf));
#pragma unroll 1
      for (int hfill = 0; hfill < 2; ++hfill) { float tv[17];
#pragma unroll
          for (int k = 0; k < 17; ++k) { const int j = tf + NWAVES * 64 * (17 * hfill + k); const int hd = j / DS_RBN, jj = j - hd * DS_RBN; tv[k] = biasd[(24 + hd) * 2048 + (jj < 2048 ? 2047 - jj : 0)]; }
#pragma unroll
          for (int k = 0; k < 17; ++k) { const int j = tf + NWAVES * 64 * (17 * hfill + k); const int hd = j / DS_RBN, jj = j - hd * DS_RBN; ((LAS float*)(lds + DS_RB))[j] = jj < 2048 ? tv[k] * LOG2E : 0.f; } } }
    const LAS float* RB = (const LAS float*)(lds + DS_RB) + h * DS_RBN;
    bf16x8 qa[8];
    { const bf16* qp = PA + (size_t)row * PA_LD + C_QC + h * 64;
      int rq = r; asm volatile("" : "+v"(rq));
      bf16x8 qh[4];
#pragma unroll
      for (int st = 0; st < 4; ++st) qh[st] = *(const bf16x8*)(qp + 16 * st + 8 * hh);
#pragma unroll
      for (int cb = 0; cb < 4; ++cb) { f32x16 acc;
#pragma unroll
          for (int i = 0; i < 16; ++i) acc[i] = 0.f;
#pragma unroll
          for (int st = 0; st < 4; ++st) acc = MFMA32(*(const bf16x8*)(WUKB + ((size_t)h * 128 + 32 * cb + rq) * 64 + 16 * st + 8 * hh), qh[st], acc);
          qa[2 * cb] = pack8((f32x4){acc[0], acc[1], acc[2], acc[3]}, (f32x4){acc[4], acc[5], acc[6], acc[7]});
          qa[2 * cb + 1] = pack8((f32x4){acc[8], acc[9], acc[10], acc[11]}, (f32x4){acc[12], acc[13], acc[14], acc[15]});
          asm volatile("" ::: "memory"); } }
    f32x16 o[4];
#pragma unroll
    for (int db = 0; db < 4; ++db)
#pragma unroll
        for (int i = 0; i < 16; ++i) o[db][i] = 0.f;
    float m = -INFINITY, l = 0.f;
    const int NT = (qt >> 1) + 1;
    const int skey = tid >> 4, sc = tid & 15;
    const bf16* Cg = CN + (size_t)(b * T + skey) * 128 + sc * 8;
    const int kwo = (sc * 64 + skey) * 16, vwo = (sc >> 2) * 4096 + skey * 64 + (sc & 3) * 16;
    v4u c0r = *(const v4u*)Cg, c1r = *(const v4u*)(Cg + 32 * 128);
    *(LAS v4u*)(lds + DS_K0 + kwo) = c0r; *(LAS v4u*)(lds + DS_K0 + kwo + 512) = c1r; *(LAS v4u*)(lds + DS_V0 + vwo) = c0r; *(LAS v4u*)(lds + DS_V0 + vwo + 2048) = c1r;
    const unsigned long long* mrow = MASK + (size_t)row * 32;
    __syncthreads();
#pragma unroll 1
    for (int tt = 0; tt < NT; ++tt) {
        const int s0 = 64 * tt, buf = tt & 1;
        if (tt + 1 < NT) { c0r = *(const v4u*)(Cg + (size_t)(s0 + 64) * 128); c1r = *(const v4u*)(Cg + (size_t)(s0 + 96) * 128); }
        const unsigned long long mw = mrow[tt];
        {
            const LAS unsigned char* Kt = lds + DS_K0 + buf * 32768;
            f32x16 p0, p1;
#pragma unroll
            for (int i = 0; i < 16; ++i) { p0[i] = 0.f; p1[i] = 0.f; }
#pragma unroll
            for (int ks = 0; ks < 8; ++ks) {
                const LAS unsigned char* ka = Kt + ((2 * ks) * 64 + r) * 16 + 8 * hh;
                const s16x4 a0 = *(const LAS s16x4*)ka, a1 = *(const LAS s16x4*)(ka + 1024), b0 = *(const LAS s16x4*)(ka + 512), b1 = *(const LAS s16x4*)(ka + 1024 + 512);
                p0 = MFMA32(((bf16x8){a0[0], a0[1], a0[2], a0[3], a1[0], a1[1], a1[2], a1[3]}), qa[ks], p0);
                p1 = MFMA32(((bf16x8){b0[0], b0[1], b0[2], b0[3], b1[0], b1[1], b1[2], b1[3]}), qa[ks], p1);
                if ((ks & 3) == 3) asm volatile("" ::: "memory");
            }
            const int dl = t - s0 - 4 * hh;
            const LAS float* rb = RB + (2047 - dl);
            const unsigned wlo = (unsigned)mw >> (4 * hh), whi = (unsigned)(mw >> 32) >> (4 * hh);
#pragma unroll
            for (int i = 0; i < 16; ++i) { const int c0 = (i & 3) + 8 * (i >> 2);
                const float v0 = fmaf(p0[i], QK_SCALE2, rb[c0]), v1 = fmaf(p1[i], QK_SCALE2, rb[c0 + 32]);
                p0[i] = ((wlo >> c0) & 1u) ? v0 : -INFINITY; p1[i] = ((whi >> c0) & 1u) ? v1 : -INFINITY;
                if ((i & 3) == 3) asm volatile("" ::: "memory"); }
            const float alpha = softmax_tile(p0, p1, m, l);
            if (__any(alpha != 1.0f)) {
#pragma unroll
            for (int db = 0; db < 4; ++db)
#pragma unroll
                for (int i = 0; i < 16; ++i) o[db][i] *= alpha; }
            pv_tile<128>(lds + DS_V0 + buf * 32768, p0, p1, o, lane);
        }
        if (tt + 1 < NT) { LAS unsigned char* Kn = lds + DS_K0 + (32768 - buf * 32768); LAS unsigned char* Vn = lds + DS_V0 + (32768 - buf * 32768);
            *(LAS v4u*)(Kn + kwo) = c0r; *(LAS v4u*)(Kn + kwo + 512) = c1r; *(LAS v4u*)(Vn + vwo) = c0r; *(LAS v4u*)(Vn + vwo + 2048) = c1r; }
        __syncthreads();
    }
    const float inv = 1.0f / xhalf_sum(l);
    int re = r; asm volatile("" : "+v"(re));
    unsigned char* yp = (unsigned char*)YC + (size_t)(b * T + 32 * qt + re) * 2048 + 1536 + h * 64 + 4 * hh;
#pragma unroll
    for (int db2 = 0; db2 < 2; ++db2) {
        f32x16 acc;
#pragma unroll
        for (int i = 0; i < 16; ++i) acc[i] = 0.f;
#pragma unroll
        for (int ks = 0; ks < 8; ++ks) {
            const int cb = ks >> 1, b0 = 8 * (ks & 1);
            const bf16x8 ob = pack8((f32x4){o[cb][b0] * inv, o[cb][b0 + 1] * inv, o[cb][b0 + 2] * inv, o[cb][b0 + 3] * inv}, (f32x4){o[cb][b0 + 4] * inv, o[cb][b0 + 5] * inv, o[cb][b0 + 6] * inv, o[cb][b0 + 7] * inv});
            const bf16* wp = WUVT + ((size_t)h * 64 + 32 * db2 + re) * 128 + 16 * ks + 4 * hh;
            const s16x4 w0 = *(const s16x4*)wp, w1 = *(const s16x4*)(wp + 8);
            const bf16x8 wf = (bf16x8){w0[0], w0[1], w0[2], w0[3], w1[0], w1[1], w1[2], w1[3]};
            acc = MFMA32(wf, ob, acc);
            if (ks & 1) asm volatile("" ::: "memory");
        }
#pragma unroll
        for (int g = 0; g < 4; ++g) *(unsigned*)(yp + 32 * db2 + 8 * g) = pk4f8(acc[4 * g], acc[4 * g + 1], acc[4 * g + 2], acc[4 * g + 3]);
    }
}
#ifndef NREP_ROUTE
#define NREP_ROUTE 1
#endif
constexpr int PU_RI = 0, PU_RG = 16384, PU_RSTD = 32768, PU_TOP = 33024, PU_EX = PU_TOP + 8 * 8192, PU_END = PU_EX + 8 * 4096;
static_assert(PU_END <= LDSCTL_OFF, "PEER unit LDS map");
#define CE_DESC(a, b) do { const unsigned hi_ = (a) > (b) ? (a) : (b); (b) = (a) > (b) ? (b) : (a); (a) = hi_; } while (0)
template <int B, typename A> __device__ __forceinline__ void sort16_desc(A& v) {
#pragma unroll
    for (int ks = 1; ks <= 4; ++ks)
#pragma unroll
        for (int js = ks - 1; js >= 0; --js)
#pragma unroll
            for (int i = 0; i < 16; ++i) { const int k = 1 << ks, j = 1 << js, l = i ^ j; if (l > i) { if ((i & k) == 0) CE_DESC(v[B + i], v[B + l]); else CE_DESC(v[B + l], v[B + i]); } }
}
template <int B0, int B1, typename A> __device__ __forceinline__ void merge16_desc(A& v) {
#pragma unroll
    for (int i = 0; i < 16; ++i) v[B0 + i] = v[B0 + i] > v[B1 + 15 - i] ? v[B0 + i] : v[B1 + 15 - i];
#pragma unroll
    for (int js = 3; js >= 0; --js)
#pragma unroll
        for (int i = 0; i < 16; ++i) { const int j = 1 << js, l = i ^ j; if (l > i) CE_DESC(v[B0 + i], v[B0 + l]); }
}
template <typename A> __device__ __forceinline__ void top16_of_64(A& v) {
    sort16_desc<0>(v); sort16_desc<16>(v); merge16_desc<0, 16>(v);
    sort16_desc<32>(v); sort16_desc<48>(v); merge16_desc<32, 48>(v);
    merge16_desc<0, 32>(v);
}
__device__ __forceinline__ void peer_route(const Ptrs& P, int l, int unit, LAS unsigned char* lds, int tid, int wave, int lane) {
    unsigned char* ws = P.ws;
    float* RSTD = (float*)(ws + WS_RSTD) + unit * 32; int* RI = (int*)(ws + WS_RI) + (size_t)unit * 32 * 128; float* RG = (float*)(ws + WS_RG) + (size_t)unit * 32 * 128;
    const bf16* QP = (const bf16*)(ws + WS_QP);
    const int r0 = unit * 32;
    const float* rowssB = (const float*)(ws + WS_ROWSSB);
    __syncthreads();
#pragma unroll 1
    for (int rrep = 0; rrep < NREP_ROUTE; ++rrep)
    {
        const int r = lane & 31, hh = lane >> 5, h = wave;
        const bf16* SKB = (const bf16*)(ws + WS_SKB) + (size_t)(l * 8 + h) * 2 * 16384;
        float rs; { const float* pp = rowssB + (size_t)(r0 + r) * 32; float a = 0.f;
#pragma unroll
            for (int j = 0; j < 8; ++j) { const f32x4 v = *(const f32x4*)(pp + 4 * j); a += (v.x + v.y) + (v.z + v.w); }
            rs = rsqrtf(a * (1.0f / 2048.0f) + EPS); }
        if (hh == 0 && h == 0) RSTD[r] = rs;
        LAS float* EXL = (LAS float*)(lds + PU_EX) + wave * 1024;
        LAS unsigned* TOPL = (LAS unsigned*)(lds + PU_TOP) + wave * 2048;
#pragma unroll 1
        for (int p = 0; p < 2; ++p) {
            bf16x8 qf[8];
            { int rq = r; asm volatile("" : "+v"(rq)); const bf16* qr2 = QP + (size_t)(r0 + rq) * 2048 + h * 256 + p * 128 + 8 * hh;
#pragma unroll
            for (int st = 0; st < 8; ++st) qf[st] = *(const bf16x8*)(qr2 + 16 * st); }
            unsigned kv[64];
            int rk = r; asm volatile("" : "+v"(rk));
            const bf16* skp = SKB + ((size_t)p * 128 + rk) * 128 + 8 * hh;
            bf16x8 sf[8];
#pragma unroll
            for (int st = 0; st < 8; ++st) sf[st] = *(const bf16x8*)(skp + 16 * st);
#pragma unroll
            for (int kb = 0; kb < 4; ++kb) {
                f32x16 acc;
#pragma unroll
                for (int i = 0; i < 16; ++i) acc[i] = 0.f;
                bf16x8 cf[8];
#pragma unroll
                for (int st = 0; st < 8; ++st) cf[st] = sf[st];
                if (kb < 3) {
#pragma unroll
                    for (int st = 0; st < 8; ++st) sf[st] = *(const bf16x8*)(skp + (size_t)(32 * (kb + 1)) * 128 + 16 * st); }
#pragma unroll
                for (int st = 0; st < 8; ++st) acc = MFMA32(cf[st], qf[st], acc);
#pragma unroll
                for (int i = 0; i < 16; ++i) kv[16 * kb + i] = (fkey(acc[i]) & ~127u) | (unsigned)(127 - (32 * kb + (i & 3) + 8 * (i >> 2) + 4 * hh));
                asm volatile("" ::: "memory");
            }
            top16_of_64(kv);
#pragma unroll
            for (int i = 0; i < 16; ++i) { const unsigned own = kv[i]; auto rr = __builtin_amdgcn_permlane32_swap(own, own, false, false); kv[16 + i] = (rr[0] == own) ? rr[1] : rr[0]; }
            merge16_desc<0, 16>(kv);
#pragma unroll
            for (int it = 0; it < 16; ++it) TOPL[(p * 16 + it) * 64 + lane] = kv[it];
        }
        LDS_WAIT(); asm volatile("" ::: "memory");
        unsigned ck[64];
        { float sa[16], sb[16];
#pragma unroll
          for (int j = 0; j < 16; ++j) { sa[j] = funkey(TOPL[j * 64 + lane] & ~127u); sb[j] = funkey(TOPL[(16 + j) * 64 + lane] & ~127u); }
          int pi = 0;
#pragma unroll
          for (int a = 0; a < 16; ++a)
#pragma unroll
              for (int bq = 0; bq < 16; ++bq) if ((a + 1) * (bq + 1) <= 16) { ck[pi] = (fkey(sa[a] + sb[bq]) & ~255u) | (unsigned)(255 - (a * 16 + bq)); ++pi; }
#pragma unroll
          for (int i = 50; i < 64; ++i) ck[i] = 0u; }
        top16_of_64(ck);
        float mx = 0.f, sm = 0.f;
#pragma unroll
        for (int it = 0; it < 16; ++it) {
            const unsigned m = ck[it];
            const int ab = 255 - (int)(m & 255u), a = ab >> 4, bq = ab & 15;
            const unsigned ka = TOPL[a * 64 + lane], kb2 = TOPL[(16 + bq) * 64 + lane];
            const float sc = funkey(m & ~255u) * rs;
            if (it == 0) mx = sc;
            const float e = __expf(sc - mx); sm += e;
            EXL[it * 64 + lane] = e;
            if (hh == 0) RI[r * 128 + h * 16 + it] = (127 - (int)(ka & 127u)) * 128 + (127 - (int)(kb2 & 127u));
        }
        LDS_WAIT(); asm volatile("" ::: "memory");
        const float inv = 1.0f / sm;
        if (hh == 0) {
#pragma unroll
            for (int it = 0; it < 16; ++it) RG[r * 128 + h * 16 + it] = EXL[it * 64 + lane] * inv;
        }
        LDS_WAIT(); asm volatile("" ::: "memory");
    }
}

#define PU_ISSUE(dst, eis, r0_) do { _Pragma("unroll") for (int rd = 0; rd < 4; ++rd) { const v4u* up = (const v4u*)(U6s + ((unsigned)eis[(r0_) + rd] * 192u + 16u * (unsigned)piece)); dst[rd][0] = up[0]; dst[rd][1] = up[4]; dst[rd][2] = up[8]; } } while (0)
#define PU_COMP(src, r0_) do { _Pragma("unroll") for (int rd = 0; rd < 4; ++rd) { \
        const v4u r0 = src[rd][0], r1 = src[rd][1], r2 = src[rd][2]; \
        const v6i_t ca = {(int)r0.x, (int)r0.y, (int)r0.z, (int)r0.w, (int)r1.x, (int)r1.y}, cb = {(int)r1.z, (int)r1.w, (int)r2.x, (int)r2.y, (int)r2.z, (int)r2.w}; \
        const v16u_t ua = __builtin_bit_cast(v16u_t, __builtin_amdgcn_cvt_scalef32_pk32_bf16_fp6(ca, 1.0f)), ub = __builtin_bit_cast(v16u_t, __builtin_amdgcn_cvt_scalef32_pk32_bf16_fp6(cb, 1.0f)); \
        float a0 = 0.f, a1 = 0.f, a2 = 0.f, a3 = 0.f; \
        _Pragma("unroll") for (int k = 0; k < 8; ++k) { a0 = dot2(ua[2 * k], xq[k].x, a0); a1 = dot2(ua[2 * k + 1], xq[k].y, a1); a2 = dot2(ub[2 * k], xq[k].z, a2); a3 = dot2(ub[2 * k + 1], xq[k].w, a3); } \
        float d = (a0 + a1) + (a2 + a3); d += lane_xor<1>(d); d += lane_xor<2>(d); \
        dd[(r0_) + rd] = d; } } while (0)
#define PU_SB() do { asm volatile("" ::: "memory"); __builtin_amdgcn_sched_barrier(0); } while (0)
__device__ __forceinline__ void peer_u_pass(const Ptrs& P, int l, int G, int vbx, int wave, int lane) {
    unsigned char* ws = P.ws;
    const int xs = vbx & 7, wr = vbx >> 3, nW = G >> 3;
    const int* RI = (const int*)(ws + WS_RI); float* PD = (float*)(ws + WS_PD); const bf16* XB = (const bf16*)(ws + WS_XB);
    const int slot = lane >> 2, piece = lane & 3;
    const int tstep = nW * NWAVES;
    const unsigned char* U6s = ws + WS_U + (size_t)l * TBL_LAYER + (size_t)xs * TBL_SLICE;
    int t = wr * NWAVES + wave;
    v4u xq[8], rowsA[4][3], rowsB[4][3]; int ein[8];
    { int e0[8]; const int* ri = RI + (size_t)t * 128 + slot;
#pragma unroll
      for (int rd = 0; rd < 8; ++rd) e0[rd] = ri[16 * rd];
      const int t1 = (t + tstep < M) ? t + tstep : t; const int* rn = RI + (size_t)t1 * 128 + slot; const bf16* xr = XB + (size_t)t * 2048 + 256 * xs + 8 * piece;
#pragma unroll
      for (int rd = 0; rd < 8; ++rd) ein[rd] = rn[16 * rd];
#pragma unroll
      for (int k = 0; k < 8; ++k) xq[k] = *(const v4u*)(xr + 32 * k);
      PU_SB();
      PU_ISSUE(rowsA, e0, 0); PU_ISSUE(rowsB, e0, 4); PU_SB(); }
#pragma unroll 1
    for (; t < M; t += tstep) {
        const int t1 = (t + tstep < M) ? t + tstep : t, t2 = (t + 2 * tstep < M) ? t + 2 * tstep : t1;
        v4u xn[8]; int ei2[8];
        { const int* ri = RI + (size_t)t2 * 128 + slot; const bf16* xr = XB + (size_t)t1 * 2048 + 256 * xs + 8 * piece;
#pragma unroll
          for (int rd = 0; rd < 8; ++rd) ei2[rd] = ri[16 * rd];
#pragma unroll
          for (int k = 0; k < 8; ++k) xn[k] = *(const v4u*)(xr + 32 * k); }
        float* pd = PD + ((size_t)xs * M + t) * 128 + slot;
        float dd[8];
        PU_SB(); PU_COMP(rowsA, 0); PU_SB();
        PU_ISSUE(rowsA, ein, 0); PU_SB();
        PU_COMP(rowsB, 4); PU_SB();
        PU_ISSUE(rowsB, ein, 4); PU_SB();
        if (piece == 0) {
#pragma unroll
            for (int rd = 0; rd < 8; ++rd) pd[16 * rd] = dd[rd]; }
#pragma unroll
        for (int k = 0; k < 8; ++k) xq[k] = xn[k];
#pragma unroll
        for (int rd = 0; rd < 8; ++rd) ein[rd] = ei2[rd];
    }
}
#undef PU_ISSUE
#undef PU_COMP
#undef PU_SB
__device__ __forceinline__ void peer_combine(const Ptrs& P, int l, int gw, int NGW, int lane) {
    unsigned char* ws = P.ws;
    const int* RI = (const int*)(ws + WS_RI); const float* RG = (const float*)(ws + WS_RG); const float* PD = (const float*)(ws + WS_PD); unsigned* W = (unsigned*)(ws + WS_W);
    const f32x2v* SCL = (const f32x2v*)(ws + WS_USC) + l * 16384; const float* RSTD = (const float*)(ws + WS_RSTD);
    float pd[2][8], rg[2], rstd; int ei[2];
    int z = 0; asm volatile("" : "+v"(z));
#define PC_LOAD(t_) do { rstd = RSTD[(t_) + z]; _Pragma("unroll") for (int hf = 0; hf < 2; ++hf) { const int k = lane + 64 * hf; \
        _Pragma("unroll") for (int sl = 0; sl < 8; ++sl) pd[hf][sl] = PD[((size_t)sl * M + (t_)) * 128 + k]; \
        ei[hf] = RI[(size_t)(t_) * 128 + k]; rg[hf] = RG[(size_t)(t_) * 128 + k]; } } while (0)
    if (gw < M) PC_LOAD(gw);
#pragma unroll 1
    for (int t = gw; t < M; t += NGW) {
        const float rs = rstd; const int e0 = ei[0], e1 = ei[1]; const float g0 = rg[0], g1 = rg[1];
        float a0 = 0.f, a1 = 0.f;
#pragma unroll
        for (int sl = 0; sl < 8; ++sl) { a0 += pd[0][sl]; a1 += pd[1][sl]; }
        const f32x2v s0 = SCL[e0], s1 = SCL[e1];
        { const int tn = (t + NGW < M) ? t + NGW : t; PC_LOAD(tn); }
        const float w0 = g0 * gelu_tanh(a0 * s0.x * rs) * s0.y, w1 = g1 * gelu_tanh(a1 * s1.x * rs) * s1.y;
        W[(size_t)t * 128 + lane] = (pk2(w0, 0.f) << 16) | (unsigned)e0; W[(size_t)t * 128 + lane + 64] = (pk2(w1, 0.f) << 16) | (unsigned)e1;
    }
#undef PC_LOAD
}
#define PV_LOAD(dst, k0) do { const v4u eq0_ = *(const LAS v4u*)(ELb + qd * 128 + (k0)), eq1_ = *(const LAS v4u*)(ELb + qd * 128 + (k0) + 4); \
    _Pragma("unroll") for (int kk = 0; kk < 8; ++kk) { const unsigned ei_ = (kk < 4 ? eq0_[kk & 3] : eq1_[kk & 3]) & 0xffffu; const unsigned char* rp_ = V6s + (ei_ * 192u + c8o); \
        dst[kk][0] = *(const u32x2v*)rp_; dst[kk][1] = *(const u32x2v*)(rp_ + 64); dst[kk][2] = *(const u32x2v*)(rp_ + 128); } } while (0)
#define PV_FMA(src, k0) do { const v4u wq0_ = *(const LAS v4u*)(ELb + qd * 128 + (k0)), wq1_ = *(const LAS v4u*)(ELb + qd * 128 + (k0) + 4); \
    _Pragma("unroll") for (int kk = 0; kk < 8; ++kk) { const float w_ = __builtin_bit_cast(float, (kk < 4 ? wq0_[kk & 3] : wq1_[kk & 3]) & 0xffff0000u); const f32x2v wk_ = (f32x2v){w_, w_}; \
        const v6i_t c_ = {(int)src[kk][0].x, (int)src[kk][0].y, (int)src[kk][1].x, (int)src[kk][1].y, (int)src[kk][2].x, (int)src[kk][2].y}; \
        const v32f_t d_ = __builtin_amdgcn_cvt_scalef32_pk32_f32_fp6(c_, 1.0f); \
        _Pragma("unroll") for (int i_ = 0; i_ < 16; ++i_) o[i_] = (f32x2v){d_[2 * i_], d_[2 * i_ + 1]} * wk_ + o[i_]; \
        __builtin_amdgcn_sched_barrier(0); } } while (0)
__device__ __forceinline__ void peer_v_pass(const Ptrs& P, int l, int G, int vbx, LAS unsigned char* lds, int wave, int lane) {
    unsigned char* ws = P.ws;
    const int xs = vbx & 7, wr = vbx >> 3, nW = G >> 3;
    const unsigned* W = (const unsigned*)(ws + WS_W);
    bf16* XB = (bf16*)(ws + WS_XB); float* RS = (float*)(ws + WS_RS);
    const int gstep = nW * NWAVES;
    const unsigned char* V6s = ws + WS_V + (size_t)l * TBL_LAYER + (size_t)xs * TBL_SLICE;
    int tg = wr * NWAVES + wave, par = 0;
    { LAS unsigned* EL0 = (LAS unsigned*)(lds + wave * 8192);
      const unsigned* wp = W + (size_t)(8 * tg) * 128;
      int ln0 = lane; asm volatile("" : "+v"(ln0));
#pragma unroll
      for (int j = 0; j < 16; ++j) EL0[ln0 + 64 * j] = wp[ln0 + 64 * j]; }
    LDS_WAIT(); asm volatile("" ::: "memory");
#pragma unroll 1
    for (; tg < M / 8; tg += gstep, par ^= 1) {
        const LAS unsigned* ELb = (const LAS unsigned*)(lds + wave * 8192 + par * 4096);
        int ln = lane; asm volatile("" : "+v"(ln));
        const int qd = ln >> 3, b8 = ln & 7;
        const unsigned c8o = 8u * (unsigned)b8;
        const int t = 8 * tg + qd;
        u32x2v vA[8][3], vB[8][3];
        PV_LOAD(vA, 0);
        unsigned nel[16];
        { const int tgn = (tg + gstep < M / 8) ? tg + gstep : tg;
          const unsigned* wp = W + (size_t)(8 * tgn) * 128;
#pragma unroll
          for (int j = 0; j < 16; ++j) nel[j] = wp[ln + 64 * j]; }
        const size_t col0 = (size_t)t * 2048 + 256 * xs + 4 * b8;
        u32x2v xres[8];
#pragma unroll
        for (int k = 0; k < 8; ++k) xres[k] = *(const u32x2v*)(XB + col0 + 32 * k);
        f32x2v o[16];
#pragma unroll
        for (int i = 0; i < 16; ++i) o[i] = (f32x2v){0.f, 0.f};
#define PV_SB() do { asm volatile("" ::: "memory"); __builtin_amdgcn_sched_barrier(0); } while (0)
        PV_SB(); PV_LOAD(vB, 8); PV_FMA(vA, 0); PV_SB();
        PV_LOAD(vA, 16); PV_FMA(vB, 8); PV_SB();
        PV_LOAD(vB, 24); PV_FMA(vA, 16); PV_SB();
        PV_LOAD(vA, 32); PV_FMA(vB, 24); PV_SB();
        PV_LOAD(vB, 40); PV_FMA(vA, 32); PV_SB();
        PV_LOAD(vA, 48); PV_FMA(vB, 40); PV_SB();
        PV_LOAD(vB, 56); PV_FMA(vA, 48); PV_SB();
        PV_LOAD(vA, 64); PV_FMA(vB, 56); PV_SB();
        PV_LOAD(vB, 72); PV_FMA(vA, 64); PV_SB();
        PV_LOAD(vA, 80); PV_FMA(vB, 72); PV_SB();
        PV_LOAD(vB, 88); PV_FMA(vA, 80); PV_SB();
        PV_LOAD(vA, 96); PV_FMA(vB, 88); PV_SB();
        PV_LOAD(vB, 104); PV_FMA(vA, 96); PV_SB();
        PV_LOAD(vA, 112); PV_FMA(vB, 104); PV_SB();
        PV_LOAD(vB, 120); PV_FMA(vA, 112); PV_SB();
        PV_FMA(vB, 120); PV_SB();
#undef PV_SB
        { LAS unsigned* ELn = (LAS unsigned*)(lds + wave * 8192 + (par ^ 1) * 4096);
#pragma unroll
          for (int j = 0; j < 16; ++j) ELn[ln + 64 * j] = nel[j]; }
        LDS_WAIT(); asm volatile("" ::: "memory");
        float ss = 0.f;
#pragma unroll
        for (int k = 0; k < 8; ++k) {
            const u32x2v xa = xres[k];
            const f32x4 na = (f32x4){bflo(xa.x) + o[2 * k].x, bfhi(xa.x) + o[2 * k].y, bflo(xa.y) + o[2 * k + 1].x, bfhi(xa.y) + o[2 * k + 1].y};
            u32x2v pk; pk.x = pk2(na.x, na.y); pk.y = pk2(na.z, na.w); *(u32x2v*)(XB + col0 + 32 * k) = pk;
            int w0 = __builtin_amdgcn_cvt_pk_fp8_f32(na.x, na.y, 0, false); w0 = __builtin_amdgcn_cvt_pk_fp8_f32(na.z, na.w, w0, true);
            *(unsigned*)(ws + WS_XB8 + col0 + 32 * k) = (unsigned)w0;
            ss += (na.x * na.x + na.y * na.y) + (na.z * na.z + na.w * na.w); }
        ss += lane_xor<1>(ss); ss += lane_xor<2>(ss); ss += lane_xor<4>(ss);
        if (b8 == 0) RS[t * 16 + xs] = ss;
    }
}
#undef PV_LOAD
#undef PV_FMA
__device__ __forceinline__ void final_norm(const Ptrs& P, int gw, int NGW, int lane) {
    const float* RS = (const float*)(P.ws + WS_RS);
#pragma unroll 1
    for (int t = gw; t < M; t += NGW) {
        const float pv = lane < 16 ? RS[t * 16 + lane] : 0.f;
        const float rf = rsqrtf(wave_sum(pv) * (1.0f / 2048.0f) + EPS);
        const bf16* xr = (const bf16*)(P.ws + WS_XB) + (size_t)t * 2048; float* orow = P.out + (size_t)t * 2048;
#pragma unroll
        for (int i = 0; i < 4; ++i) { const int e0 = 8 * (lane + 64 * i); const v4u v = *(const v4u*)(xr + e0); const f32x4 g0 = *(const f32x4*)(P.g_final + e0), g1 = *(const f32x4*)(P.g_final + e0 + 4);
            *(f32x4*)(orow + e0) = (f32x4){bflo(v.x) * rf * g0.x, bfhi(v.x) * rf * g0.y, bflo(v.y) * rf * g0.z, bfhi(v.y) * rf * g0.w};
            *(f32x4*)(orow + e0 + 4) = (f32x4){bflo(v.z) * rf * g1.x, bfhi(v.z) * rf * g1.y, bflo(v.w) * rf * g1.z, bfhi(v.w) * rf * g1.w}; }
    }
}
#ifndef MK_PER_PHASE
#define MK_PER_PHASE 0
#endif
struct Args { const float* in[18]; float* out; unsigned char* ws; int ph_lo, ph_hi; };
__global__ void __launch_bounds__(NWAVES * 64, 2) mega_fwd(Args args) {
    extern __shared__ __attribute__((aligned(16))) unsigned char lds_raw[];
    LAS unsigned char* lds = (LAS unsigned char*)lds_raw;
    const int tid0 = threadIdx.x, wave = __builtin_amdgcn_readfirstlane(tid0 >> 6);
    const int G = gridDim.x, bx = blockIdx.x; const int vcu0 = (G % 8 == 0) ? (bx % 8) * (G / 8) + bx / 8 : bx;
    const int gw0 = vcu0 * NWAVES + wave, NGW = G * NWAVES;
    Ptrs P;
    P.x = args.in[0]; P.rel_bias = args.in[1]; P.g_mix = args.in[2]; P.w_in = args.in[3]; P.a_sinks = args.in[4]; P.c_gain = args.in[5]; P.w_uk = args.in[6]; P.w_uv = args.in[7];
    P.w_a = args.in[8]; P.w_b = args.in[9]; P.w_c = args.in[10]; P.w_out = args.in[11]; P.g_ffn = args.in[12]; P.w_q = args.in[13]; P.sub_keys = args.in[14]; P.peer_u = args.in[15]; P.peer_v = args.in[16]; P.g_final = args.in[17];
    P.out = args.out; P.ws = args.ws;
    unsigned char* ws = args.ws;
    gu32* ctl = (gu32*)(ws + WS_CTL);
    for (int u = tid0; u < (LDS_BYTES - LDSCTL_OFF) / 4; u += NWAVES * 64) ((LAS unsigned*)(lds + LDSCTL_OFF))[u] = 0u;
    __syncthreads();
    volatile LAS unsigned* MISC = (volatile LAS unsigned*)(lds + MISC_OFF);
    XcdBarrier bar; bar.bar = (unsigned*)(ctl + CW_BAR); bar.x = 0; bar.st = nullptr;
    if (!MK_PER_PHASE) bar = xcd_barrier_post((unsigned*)(ctl + CW_BAR), MISC + 8);
    const int lo = args.ph_lo, hi = args.ph_hi;
#ifndef PH_MASK
#define PH_MASK 0xffff
#endif
#define IN(k) (lo <= (k) && (k) < hi)
#define EN(j) ((PH_MASK >> (j)) & 1)
#ifndef REP_MASK
#define REP_MASK 0
#endif
#define NREP(j) (((REP_MASK >> (j)) & 1) ? 2 : 1)
#define SEAM(k) do { if (IN(k) && IN((k) + 1)) xcd_barrier(bar); } while (0)
    bf16* XB = (bf16*)(ws + WS_XB); bf16* PA = (bf16*)(ws + WS_PA); bf16* GT = (bf16*)(ws + WS_GT); bf16* MG = (bf16*)(ws + WS_MG); bf16* QP = (bf16*)(ws + WS_QP);
    bf16* YA = (bf16*)(ws + WS_YA); bf16* YB = YA; bf16* YC = YA; bf16* CN = (bf16*)(ws + WS_CN);
    unsigned long long* MASK = (unsigned long long*)(ws + WS_MASK);
    float* rowssA = (float*)(ws + WS_RS); const float* biasd = (const float*)(ws + WS_BIASD);
    LAS unsigned char* wscr = lds + wave * 16384;

#define FRESH() int lane = lane_id_(); asm volatile("" : "+v"(lane)); int tid = wave * 64 + lane; (void)tid
    if (EN(0) && IN(0)) { FRESH(); for (int rep = 0; rep < NREP(0); ++rep) p0_prologue(P, lds, gw0, NGW, wave, lane); }
    SEAM(0);
    const bool loc = !MK_PER_PHASE && (G == 256) && (MISC[10] == 1u);
    const int X = __builtin_amdgcn_readfirstlane(loc ? (int)bar.x : (bx & 7)), J = __builtin_amdgcn_readfirstlane(loc ? (int)MISC[11] : (bx >> 3));
    const int vbx = (G == 256) ? J * 8 + X : bx;
    const int vcu = (G == 256) ? X * 32 + J : vcu0;
    const int gw = vcu * NWAVES + wave;
#define SEAML(k) do { if (IN(k) && IN((k) + 1)) { if (loc) xcd_barrier_local(bar); else xcd_barrier(bar); } } while (0)
#pragma unroll 1
    for (int l = 0; l < DEPTH; ++l) {
        const int pb = 1 + 10 * l;
        float* KM = (float*)(ws + WS_KMEAN) + (size_t)l * 32768;
        float* rowssB = (float*)(ws + WS_ROWSSB);
        if (EN(1) && IN(pb + 0)) {
#pragma unroll 1
            for (int rep = 0; rep < NREP(1); ++rep) {
            { pg8::Gemm g{XB, (const bf16*)(ws + WS_WIN) + (size_t)l * NPROJ * 2048, M, 4096, 2048}; pg8::SplitOrder S; S.init(G, vbx, true);
              pg8::EpiProj E{PA, KM, rowssA};
              pg8::gemm_phase<pg8::EpiProj, pg8::SplitOrder, true, true>(lds, g, S, E, wave); }
            { pg8::Gemm g{(const bf16*)(ws + WS_XB8), (const bf16*)(ws + WS_WG8 + (size_t)l * NPROJ * 2048), M, NPROJ, 2048}; pg8::SplitOrder S; S.init(G, vbx, false);
              pg8::EpiIn8 E{PA, (unsigned char*)GT, rowssA};
              pg8::gemm_phase<pg8::EpiIn8, pg8::SplitOrder, true, true, true>(lds, g, S, E, wave); }
            }
        }
        SEAML(pb + 0);
        if (EN(2) && IN(pb + 1)) { FRESH();
#pragma unroll 1
            for (int rep = 0; rep < NREP(2); ++rep)
#pragma unroll 1
            for (int u = vcu; u < 512; u += G) {
                const int bb = (u & 255) >> 5, ii = u & 31, qt = (u < 256) ? ii : 63 - ii;
                sel_unit(PA, (float*)(ws + WS_SC), MASK, bb, qt, lds, tid, wave, lane);
            }
            if (G == 256) { for (int k = 0; k < 2; ++k) cn_item(PA, P.c_gain + l * 128, CN, X * 512 + J * 8 + wave + 256 * k, lane); }
            else for (int i = gw; i < M / 4; i += NGW) cn_item(PA, P.c_gain + l * 128, CN, i, lane);
#pragma unroll 1
            for (int rep = 0; rep < NREP(3); ++rep)
#pragma unroll 1
            for (int u = vcu, k = 0; u < 1024; u += G, ++k) { if (G == 256) swa_unit(PA, biasd, P.a_sinks + l * 16, YA, X, k, J, lds, tid, wave, lane);
                else swa_unit(PA, biasd, P.a_sinks + l * 16, YA, u >> 7, (u >> 5) & 3, u & 31, lds, tid, wave, lane); }
            __syncthreads();
        }
        SEAML(pb + 1);
        if (EN(3) && IN(pb + 2)) { FRESH();
#pragma unroll 1
            for (int rep = 0; rep < NREP(4); ++rep)
#pragma unroll 1
            for (int u = vcu; u < 512; u += G) {
                const int bb = (u & 255) >> 5, ii = u & 31, qt = (u < 256) ? ii : 63 - ii;
                dsa_unit(CN, PA, MASK, biasd, (const bf16*)(ws + WS_WUKB) + (size_t)l * 65536, (const bf16*)(ws + WS_WUVT) + (size_t)l * 65536, YC, bb, qt, lds, tid, wave, lane);
            }
            __syncthreads();
#pragma unroll 1
            for (int rep = 0; rep < NREP(5); ++rep)
#pragma unroll 1
            for (int u = vcu; u < 512; u += G) {
                const int bh = (u & 255) >> 2, pr = u & 3, nblk = (u < 256) ? pr : 7 - pr;
                moba_unit(PA, biasd, KM, YB, bh >> 3, bh & 7, nblk, lds, tid, wave, lane);
            }
            __syncthreads();
        }
        SEAML(pb + 2);
        if (EN(4) && IN(pb + 3)) {
            pg8::StaticOrder S; S.init(M, 2048, G, vbx);
            pg8::Gemm g{YA, (const bf16*)(ws + WS_WA + (size_t)l * 2048 * 2048), M, 2048, 2048}; pg8::EpiGate3 E{(unsigned char*)MG, (const unsigned char*)GT};
#pragma unroll 1
            for (int rep = 0; rep < NREP(6); ++rep) pg8::gemm_phase<pg8::EpiGate3, pg8::StaticOrder, true, true, true>(lds, g, S, E, wave);
        }
        SEAML(pb + 3);
        if (EN(5) && IN(pb + 4)) {
            pg8::Gemm g{MG, (const bf16*)(ws + WS_WOUT + (size_t)l * 2048 * 2048), M, 2048, 2048}; pg8::StaticOrder S; S.init(M, 2048, G, vbx);
            pg8::EpiResid E{XB, rowssB, 0.000244140625f};
            pg8::gemm_phase<pg8::EpiResid, pg8::StaticOrder, true, true, true>(lds, g, S, E, wave);
        }
        SEAML(pb + 4);
        if (EN(6) && IN(pb + 5)) {
            pg8::Gemm g{XB, (const bf16*)(ws + WS_WQ) + (size_t)l * 2048 * 2048, M, 2048, 2048}; pg8::StaticOrder S; S.init(M, 2048, G, vbx);
            pg8::EpiQ E{QP};
#pragma unroll 1
            for (int rep = 0; rep < NREP(7); ++rep) pg8::gemm_phase<pg8::EpiQ, pg8::StaticOrder, true, true>(lds, g, S, E, wave);
        }
        SEAML(pb + 5);
        if (EN(7) && IN(pb + 6)) { FRESH();
            for (int u = vcu, k = 0; u < M / 32; u += G, ++k) peer_route(P, l, (G == 256) ? X * 64 + J + 32 * k : u, lds, tid, wave, lane);
        }
        SEAM(pb + 6);
        if (EN(8) && IN(pb + 7)) { FRESH(); peer_u_pass(P, l, G, vbx, wave, lane); }
        SEAM(pb + 7);
        if (EN(9) && IN(pb + 8)) { FRESH(); peer_combine(P, l, gw, NGW, lane); }
        SEAM(pb + 8);
        if (EN(10) && IN(pb + 9)) { FRESH(); peer_v_pass(P, l, G, vbx, lds, wave, lane); }
        SEAM(pb + 9);
    }
    if (IN(21)) { FRESH(); final_norm(P, gw, NGW, lane); }
#undef IN
#undef SEAM
}

extern "C" void kernel_launch(void* const* d_in, const int* in_sizes, int n_in, void* d_out, int out_size, void* d_ws, size_t ws_size, hipStream_t stream) {
    static int grid = 0;
    if (grid == 0) {
        if (n_in != 18 || out_size != M * D || ws_size < WS_END) { fprintf(stderr, "kernel_launch: unexpected problem (n_in %d, out %d, ws %zu); nothing launched\n", n_in, out_size, ws_size); grid = -1; return; }
        int dev = 0, cus = 0, per_cu = 0;
        if (hipGetDevice(&dev) != hipSuccess || hipDeviceGetAttribute(&cus, hipDeviceAttributeMultiprocessorCount, dev) != hipSuccess) { grid = -1; return; }
        if (hipFuncSetAttribute((const void*)mega_fwd, hipFuncAttributeMaxDynamicSharedMemorySize, LDS_BYTES) != hipSuccess) { fprintf(stderr, "kernel_launch: hipFuncSetAttribute failed\n"); grid = -1; return; }
        if (hipOccupancyMaxActiveBlocksPerMultiprocessor(&per_cu, (const void*)mega_fwd, NWAVES * 64, LDS_BYTES) != hipSuccess || per_cu < 1) { fprintf(stderr, "kernel_launch: occupancy query reports %d workgroups per CU\n", per_cu); }
        (void)hipGetLastError();
        grid = cus;
    }
    if (grid < 0) return;
    if (hipMemsetAsync((char*)d_ws + WS_CTL, 0, CTL_ZERO_BYTES, stream) != hipSuccess) { fprintf(stderr, "kernel_launch: hipMemsetAsync failed\n"); return; }
    Args a{};
    for (int i = 0; i < 18; ++i) a.in[i] = (const float*)d_in[i];
    a.out = (float*)d_out; a.ws = (unsigned char*)d_ws;
#if MK_PER_PHASE
    for (int p = 0; p < NPHASE; ++p) { a.ph_lo = p; a.ph_hi = p + 1; hipLaunchKernelGGL(mega_fwd, dim3(grid), dim3(NWAVES * 64), LDS_BYTES, stream, a); }
#else
    a.ph_lo = 0; a.ph_hi = NPHASE;
    hipLaunchKernelGGL(mega_fwd, dim3(grid), dim3(NWAVES * 64), LDS_BYTES, stream, a);
#endif
    const hipError_t le = hipPeekAtLastError();
    if (le != hipSuccess) fprintf(stderr, "kernel_launch: launch failed: %s\n", hipGetErrorName(le));
}
```

```cpp
#include <hip/hip_runtime.h>
#include <cstdio>
#include <cstdint>
__device__ __forceinline__ int lane_id_() { return (int)__builtin_amdgcn_mbcnt_hi(~0u, __builtin_amdgcn_mbcnt_lo(~0u, 0u)); }
template <int K> __device__ __forceinline__ float lane_xor(float v) {
    static_assert(K == 1 || K == 2 || K == 4 || K == 8 || K == 16, "lane_xor: 1, 2, 4, 8, 16");
    if constexpr (K == 16) return __builtin_bit_cast(float, __builtin_amdgcn_ds_swizzle(__builtin_bit_cast(int, v), (16 << 10) | 0x1F));
    else return __builtin_bit_cast(float, __builtin_amdgcn_mov_dpp(__builtin_bit_cast(int, v), K == 1 ? 0xB1 : K == 2 ? 0x4E : K == 4 ? 0x124 : 0x128, 0xF, 0xF, true));
}
__device__ __forceinline__ float half_sum(float v) { const unsigned u = __builtin_bit_cast(unsigned, v); auto rr = __builtin_amdgcn_permlane32_swap(u, u, false, false); return __builtin_bit_cast(float, (unsigned)rr[0]) + __builtin_bit_cast(float, (unsigned)rr[1]); }
__device__ __forceinline__ float half_max(float v) { const unsigned u = __builtin_bit_cast(unsigned, v); auto rr = __builtin_amdgcn_permlane32_swap(u, u, false, false); return fmaxf(__builtin_bit_cast(float, (unsigned)rr[0]), __builtin_bit_cast(float, (unsigned)rr[1])); }
namespace pg8 {
#define PG8_LAS __attribute__((address_space(3)))
typedef unsigned short bf16_t;
typedef short bf16x8 __attribute__((ext_vector_type(8)));
typedef float f32x4 __attribute__((ext_vector_type(4)));
typedef unsigned u32x4 __attribute__((ext_vector_type(4)));
constexpr int BM = 256, BK = 64, HALF = 128, HTB = HALF * BK * 2  , STAGE_BYTES = 8 * HTB, NXCD = 8, WGM = 8;

__host__ __device__ __forceinline__ int lds_byte(int r, int c) { const int st = (r >> 4) * 2 + (c >> 5), rr = r & 15, cc = c & 31, ob = rr * 64 + cc * 2; return st * 1024 + (ob ^ (((ob >> 9) & 1) << 5)); }
__host__ __device__ __forceinline__ void stage_rc(int b, int& R, int& C) { const int st = b / 1024, sb = b % 1024, swz = sb ^ (((sb >> 9) & 1) << 5); R = (st >> 1) * 16 + swz / 64; C = (st & 1) * 32 + (swz % 64) / 2; }
__host__ __device__ __forceinline__ int perm32(int rho) { const int n = rho >> 4, i = rho & 15; return 8 * (i >> 2) + 4 * n + (i & 3); }

struct Unit { int pm, pn; };
struct Gemm { const bf16_t* A; const bf16_t* Bt; int M, N, K; };

struct StaticOrder {
    int nM, nN, nwg, G, c;
    __host__ __device__ void init(int M, int N, int G_, int c_) { nM = M / BM; nN = N / BM; nwg = nM * nN; G = G_; c = c_; }
    __host__ __device__ bool next(int i, Unit& u) const {
        const long L = (long)i * G + c; if (L >= nwg) return false;
        int wgid = (int)L; { const int q = nwg / NXCD, r = nwg % NXCD, xcd = wgid % NXCD, off = wgid / NXCD; wgid = (xcd < r ? xcd * (q + 1) : r * (q + 1) + (xcd - r) * q) + off; }
        const int nig = WGM * nN, gid = wgid / nig, fm = gid * WGM, gsz = (nM - fm) < WGM ? (nM - fm) : WGM;
        u.pm = fm + ((wgid % nig) % gsz); u.pn = (wgid % nig) / gsz; return true;
    }
    __device__ __forceinline__ void a_ready(const Unit&) const {}
    __device__ __forceinline__ void done(const Unit&) const {}
};

struct SplitOrder {
    int x, j, G, c; bool bf;
    __host__ __device__ void init(int G_, int c_, bool bf_) { G = G_; c = c_; x = c_ & 7; j = c_ >> 3; bf = bf_; }
    __host__ __device__ bool next(int i, Unit& u) const {
        const int ncol = bf ? 6 : 34; int pm, pk;
        if (G == 256) { const int nA = bf ? 2 : 8, nB = bf ? 0 : 10; const int cnt = j < 24 ? nA : nB; if (i >= cnt) return false;
            const int t = (j < 24 ? nA * j : 24 * nA + nB * (j - 24)) + i; pm = 8 * x + (t & 7); pk = t >> 3; }
        else { const long t = (long)i * G + c; if (t >= 64L * ncol) return false; pm = (int)(t & 63); pk = (int)(t >> 6); }
        u.pm = pm; u.pn = bf ? (pk < 4 ? 6 + pk : 10 + pk) : (pk < 6 ? pk : pk < 10 ? pk + 4 : pk + 6);
        return true;
    }
    __device__ __forceinline__ void a_ready(const Unit&) const {}
    __device__ __forceinline__ void done(const Unit&) const {}
};

typedef float f32x2c __attribute__((ext_vector_type(2))); typedef __bf16 bf16x2c __attribute__((ext_vector_type(2)));
__device__ __forceinline__ unsigned cvt_pk_bf16(float lo, float hi) { const f32x2c v = {lo, hi}; return __builtin_bit_cast(unsigned, __builtin_convertvector(v, bf16x2c)); }
typedef float f32x2 __attribute__((ext_vector_type(2)));
typedef unsigned u32x2 __attribute__((ext_vector_type(2)));
__device__ __forceinline__ float bf_lo(unsigned u) { return __builtin_bit_cast(float, u << 16); }
__device__ __forceinline__ float bf_hi(unsigned u) { return __builtin_bit_cast(float, u & 0xffff0000u); }
__device__ __forceinline__ float sigmoidf_(float v) { return 1.0f / (1.0f + __expf(-v)); }

__device__ __forceinline__ void rstd8(const float* rowss, int row0, float scale, float (&rsv)[8]) {
#pragma unroll
    for (int h = 0; h < 2; ++h) {
#pragma unroll
        for (int m = 0; m < 4; ++m) { const int row = row0 + h * HALF + m * 16; const f32x4* rp = (const f32x4*)(rowss + (size_t)row * 16); const f32x4 a = rp[0], b = rp[1];
            const float rsum = ((a[0] + a[1]) + (a[2] + a[3])) + ((b[0] + b[1]) + (b[2] + b[3]));
            rsv[4 * h + m] = rsqrtf(rsum * (1.0f / 2048.0f) + 1e-6f) * scale; }
        asm volatile("" ::: "memory"); }
}
struct EpiProj {
    static constexpr bool PERM = true, AFTER_DRAIN = false, MIDK = false;
    bf16_t* PA; float* KMS; const float* rowss;
    __device__ __forceinline__ void operator()(const f32x4 (&acc)[2][2][4][2], const Unit& u, int wr, int wc, int fr, int fq) const {
        asm volatile("" : "+v"(fr), "+v"(fq));
        const int row0 = u.pm * BM + wr * 64 + fr;
        const int col0 = u.pn * BM + wc * 32 + 8 * fq;
        float rsv[8]; rstd8(rowss, row0, 1.0f, rsv);
#pragma unroll
        for (int ai = 0; ai < 2; ++ai)
#pragma unroll
            for (int m = 0; m < 4; ++m) { const int row = row0 + ai * HALF + m * 16;
                const float rs = rsv[4 * ai + m];
                bf16_t* rowp = PA + (size_t)row * 4096 + col0;
#pragma unroll
                for (int bj = 0; bj < 2; ++bj) { const f32x4 v0 = acc[ai][bj][m][0] * rs, v1 = acc[ai][bj][m][1] * rs;
                    u32x4 w; w.x = cvt_pk_bf16(v0[0], v0[1]); w.y = cvt_pk_bf16(v0[2], v0[3]); w.z = cvt_pk_bf16(v1[0], v1[1]); w.w = cvt_pk_bf16(v1[2], v1[3]);
                    *(u32x4*)(rowp + bj * HALF) = w; } }
        if ((u.pn == 8) || (u.pn == 9)) {
            float* kp = KMS + (size_t)u.pm * 512 + (u.pn - 8) * BM + wc * 32 + 8 * fq;
#pragma unroll
            for (int bj = 0; bj < 2; ++bj)
#pragma unroll
                for (int n = 0; n < 2; ++n) { f32x4 cs = (f32x4){0.f, 0.f, 0.f, 0.f};
#pragma unroll
                    for (int ai = 0; ai < 2; ++ai)
#pragma unroll
                        for (int m = 0; m < 4; ++m) cs = cs + acc[ai][bj][m][n] * rsv[4 * ai + m];
#pragma unroll
                    for (int e = 0; e < 4; ++e) { float v = cs[e];
                        v += lane_xor<1>(v); v += lane_xor<2>(v); v += lane_xor<4>(v); v += lane_xor<8>(v);
                        if (fr == 0) atomicAdd(kp + bj * HALF + 4 * n + e, v); } }
        }
    }
};
struct EpiGate3 {
    static constexpr bool PERM = true, AFTER_DRAIN = false, MIDK = true;
    static constexpr int KB1 = 8, KB2 = 12;
    unsigned char* MG; const unsigned char* GT;
    static __device__ __forceinline__ float fl(float g) { return fmaxf(g, 2.4318695068359375e-04f); }
    static __device__ __forceinline__ float b0(unsigned w) { return (float)(w & 0xffu); }
    static __device__ __forceinline__ float b1(unsigned w) { return (float)((w >> 8) & 0xffu); }
    static __device__ __forceinline__ float b2(unsigned w) { return (float)((w >> 16) & 0xffu); }
    static __device__ __forceinline__ float b3(unsigned w) { return (float)(w >> 24); }
    __device__ __forceinline__ void mid(f32x4 (&acc)[2][2][4][2], const Unit& u, int t, int wr, int wc, int fr, int fq) const {
        asm volatile("" : "+v"(fr), "+v"(fq));
        const int gnum = (t == KB1) ? 0 : 2048;
        const int row0 = u.pm * BM + wr * 64 + fr; const int col0 = u.pn * BM + wc * 32 + 8 * fq;
        u32x2 nv[2][4][2], dv[2][4][2];
#pragma unroll
        for (int ai = 0; ai < 2; ++ai)
#pragma unroll
            for (int m = 0; m < 4; ++m) { const unsigned char* gp = GT + (size_t)(row0 + ai * HALF + m * 16) * 6144 + gnum + col0;
#pragma unroll
                for (int bj = 0; bj < 2; ++bj) { nv[ai][m][bj] = *(const u32x2*)(gp + bj * HALF); dv[ai][m][bj] = *(const u32x2*)(gp + 2048 + bj * HALF); } }
#pragma unroll
        for (int ai = 0; ai < 2; ++ai) {
#pragma unroll
            for (int m = 0; m < 4; ++m)
#pragma unroll
                for (int bj = 0; bj < 2; ++bj) { const u32x2 n_ = nv[ai][m][bj], d_ = dv[ai][m][bj];
                    const f32x4 r0 = (f32x4){fl(b0(n_.x)) * __builtin_amdgcn_rcpf(fl(b0(d_.x))), fl(b1(n_.x)) * __builtin_amdgcn_rcpf(fl(b1(d_.x))), fl(b2(n_.x)) * __builtin_amdgcn_rcpf(fl(b2(d_.x))), fl(b3(n_.x)) * __builtin_amdgcn_rcpf(fl(b3(d_.x)))};
                    const f32x4 r1 = (f32x4){fl(b0(n_.y)) * __builtin_amdgcn_rcpf(fl(b0(d_.y))), fl(b1(n_.y)) * __builtin_amdgcn_rcpf(fl(b1(d_.y))), fl(b2(n_.y)) * __builtin_amdgcn_rcpf(fl(b2(d_.y))), fl(b3(n_.y)) * __builtin_amdgcn_rcpf(fl(b3(d_.y)))};
                    acc[ai][bj][m][0] = acc[ai][bj][m][0] * r0; acc[ai][bj][m][1] = acc[ai][bj][m][1] * r1; }
            asm volatile("" ::: "memory");
        }
    }
    __device__ __forceinline__ void operator()(const f32x4 (&acc)[2][2][4][2], const Unit& u, int wr, int wc, int fr, int fq) const {
        asm volatile("" : "+v"(fr), "+v"(fq));
        const int row0 = u.pm * BM + wr * 64 + fr; const int col0 = u.pn * BM + wc * 32 + 8 * fq;
        constexpr float GS = 0.0078125f / 255.0f;
#pragma unroll
        for (int ai = 0; ai < 2; ++ai)
#pragma unroll
            for (int m = 0; m < 4; ++m) { const int row = row0 + ai * HALF + m * 16;
                const unsigned char* gp = GT + (size_t)row * 6144 + 4096 + col0; unsigned char* op = MG + (size_t)row * 2048 + col0;
#pragma unroll
                for (int bj = 0; bj < 2; ++bj) { const u32x2 gv = *(const u32x2*)(gp + bj * HALF);
                    const f32x4 v0 = acc[ai][bj][m][0] * ((f32x4){fl(b0(gv.x)), fl(b1(gv.x)), fl(b2(gv.x)), fl(b3(gv.x))} * GS);
                    const f32x4 v1 = acc[ai][bj][m][1] * ((f32x4){fl(b0(gv.y)), fl(b1(gv.y)), fl(b2(gv.y)), fl(b3(gv.y))} * GS);
                    int w0 = __builtin_amdgcn_cvt_pk_fp8_f32(v0[0], v0[1], 0, false); w0 = __builtin_amdgcn_cvt_pk_fp8_f32(v0[2], v0[3], w0, true);
                    int w1 = __builtin_amdgcn_cvt_pk_fp8_f32(v1[0], v1[1], 0, false); w1 = __builtin_amdgcn_cvt_pk_fp8_f32(v1[2], v1[3], w1, true);
                    u32x2 w; w.x = (unsigned)w0; w.y = (unsigned)w1; *(u32x2*)(op + bj * HALF) = w; }
                asm volatile("" ::: "memory"); }
    }
};
struct EpiIn8 {
    static constexpr bool PERM = true, AFTER_DRAIN = false, MIDK = false;
    bf16_t* PA; unsigned char* GT; const float* rowss;
    static __device__ __forceinline__ float g255(float v) { return __builtin_rintf(255.0f * __builtin_amdgcn_rcpf(1.0f + __expf(-v))); }
    static __device__ __forceinline__ unsigned pk4(const f32x4& v) { unsigned w = __builtin_amdgcn_cvt_pk_u8_f32(g255(v[0]), 0, 0u); w = __builtin_amdgcn_cvt_pk_u8_f32(g255(v[1]), 1, w); w = __builtin_amdgcn_cvt_pk_u8_f32(g255(v[2]), 2, w); return __builtin_amdgcn_cvt_pk_u8_f32(g255(v[3]), 3, w); }
    __device__ __forceinline__ void operator()(const f32x4 (&acc)[2][2][4][2], const Unit& u, int wr, int wc, int fr, int fq) const {
        asm volatile("" : "+v"(fr), "+v"(fq));
        const bool gate = u.pn >= 16;
        const int row0 = u.pm * BM + wr * 64 + fr; const int col0 = (gate ? u.pn - 16 : u.pn) * BM + wc * 32 + 8 * fq;
        float rsv[8]; rstd8(rowss, row0, 0.00390625f, rsv);
#pragma unroll
        for (int ai = 0; ai < 2; ++ai)
#pragma unroll
            for (int m = 0; m < 4; ++m) { const int row = row0 + ai * HALF + m * 16;
                const float rs = rsv[4 * ai + m];
                if (gate) { unsigned char* rowp = GT + (size_t)row * 6144 + col0;
#pragma unroll
                    for (int bj = 0; bj < 2; ++bj) { const f32x4 v0 = acc[ai][bj][m][0] * rs, v1 = acc[ai][bj][m][1] * rs;
                        u32x2 w; w.x = pk4(v0); w.y = pk4(v1);
                        *(u32x2*)(rowp + bj * HALF) = w; } }
                else { bf16_t* rowp = PA + (size_t)row * 4096 + col0;
#pragma unroll
                    for (int bj = 0; bj < 2; ++bj) { const f32x4 v0 = acc[ai][bj][m][0] * rs, v1 = acc[ai][bj][m][1] * rs;
                        u32x4 w; w.x = cvt_pk_bf16(v0[0], v0[1]); w.y = cvt_pk_bf16(v0[2], v0[3]); w.z = cvt_pk_bf16(v1[0], v1[1]); w.w = cvt_pk_bf16(v1[2], v1[3]);
                        *(u32x4*)(rowp + bj * HALF) = w; } } }
    }
};
struct EpiResid {
    static constexpr bool PERM = false, AFTER_DRAIN = false, MIDK = false;
    bf16_t* xb; float* rowss; float ascale;
    __device__ __forceinline__ void operator()(const f32x4 (&acc)[2][2][4][2], const Unit& u, int wr, int wc, int fr, int fq) const {
        const int col0 = u.pn * BM + wc * 32 + 4 * fq;
#pragma unroll
        for (int ai = 0; ai < 2; ++ai)
#pragma unroll
            for (int m = 0; m < 4; ++m) { const int r = u.pm * BM + ai * HALF + wr * 64 + m * 16 + fr; const size_t off = (size_t)r * 2048 + col0; float ss = 0.f;
#pragma unroll
                for (int bj = 0; bj < 2; ++bj)
#pragma unroll
                    for (int n = 0; n < 2; ++n) { const size_t o = off + bj * HALF + n * 16; const u32x2 xo = *(const u32x2*)(xb + o); const f32x4 v = (f32x4){bf_lo(xo.x), bf_hi(xo.x), bf_lo(xo.y), bf_hi(xo.y)} + acc[ai][bj][m][n] * ascale;
                        ss += (v[0] * v[0] + v[1] * v[1]) + (v[2] * v[2] + v[3] * v[3]);
                        u32x2 w; w.x = cvt_pk_bf16(v[0], v[1]); w.y = cvt_pk_bf16(v[2], v[3]); *(u32x2*)(xb + o) = w; }
                ss += lane_xor<16>(ss); ss = half_sum(ss);
                if (fq == 0) rowss[(size_t)r * 32 + u.pn * 4 + wc] = ss; }
    }
};
struct EpiQ {
    static constexpr bool PERM = true, AFTER_DRAIN = false, MIDK = false;
    bf16_t* Q;
    __device__ __forceinline__ void operator()(const f32x4 (&acc)[2][2][4][2], const Unit& u, int wr, int wc, int fr, int fq) const {
        const int row0 = u.pm * BM + wr * 64 + fr; const int col0 = u.pn * BM + wc * 32 + 8 * fq;
#pragma unroll
        for (int ai = 0; ai < 2; ++ai)
#pragma unroll
            for (int m = 0; m < 4; ++m) { const int row = row0 + ai * HALF + m * 16;
                bf16_t* rowp = Q + (size_t)row * 2048 + col0;
#pragma unroll
                for (int bj = 0; bj < 2; ++bj) { const f32x4 v0 = acc[ai][bj][m][0], v1 = acc[ai][bj][m][1];
                    u32x4 w; w.x = cvt_pk_bf16(v0[0], v0[1]); w.y = cvt_pk_bf16(v0[2], v0[3]); w.z = cvt_pk_bf16(v1[0], v1[1]); w.w = cvt_pk_bf16(v1[2], v1[3]);
                    *(u32x4*)(rowp + bj * HALF) = w; } }
    }
};
typedef int v8i_t __attribute__((ext_vector_type(8)));
template <class Epi, class Sched, bool ALIGN_EPI = false, bool SP2 = false, bool F8 = false>
__device__ __forceinline__ void gemm_phase(PG8_LAS unsigned char* lds, const Gemm g, const Sched& S, const Epi& E, const int wave_in) {
    int tid_ = wave_in * 64 + lane_id_(); asm volatile("" : "+v"(tid_));
    const int tid = tid_, wid = __builtin_amdgcn_readfirstlane(tid >> 6), lane = tid & 63, wr = wid >> 2, wc = wid & 3, fr = lane & 15, fq = lane >> 4;
    const int K = g.K, nt = F8 ? K / 128 : K / BK;
    unsigned voffA[2], voffB[2];
#pragma unroll
    for (int i = 0; i < 2; ++i) { int R, C; stage_rc(tid * 16 + i * 8192, R, C); const int Rb = Epi::PERM ? ((R & ~31) + perm32(R & 31)) : R;
        if constexpr (F8) { voffA[i] = (unsigned)(R * K + 2 * C); voffB[i] = (unsigned)(Rb * K + 2 * C); } else { voffA[i] = (unsigned)(R * K + C) * 2u; voffB[i] = (unsigned)(Rb * K + C) * 2u; } }
    const size_t kstep = (size_t)(BK * 2);
    const size_t hstep = (size_t)HALF * K * (F8 ? 1 : 2);
    const size_t tstep = 2 * hstep;
    const unsigned ldsw = (unsigned)wid * 1024u;
    const int aoff = lds_byte(wr * 64 + fr, fq * 8), boff = lds_byte(wc * 32 + fr, fq * 8);
    const int aoff1 = aoff + 1024, boff1 = boff + 1024;
#define PG8_SA(b, h) (((b) * 2 + (h)) * HTB)
#define PG8_SB(b, h) ((4 + (b) * 2 + (h)) * HTB)
#define PG8_STAGE(bufoff, gbase, voff) do { _Pragma("unroll") for (int _i = 0; _i < 2; ++_i) \
        __builtin_amdgcn_global_load_lds((const unsigned*)((const char*)(gbase) + (voff)[_i]), (PG8_LAS unsigned*)(lds + (bufoff) + ldsw + _i * 8192), 16, 0, 0); } while (0)
#define PG8_LDA(dst, b, h) do { if constexpr (F8) { _Pragma("unroll") for (int m = 0; m < 4; ++m) { const u32x4 x0_ = *(const PG8_LAS u32x4*)(lds + PG8_SA(b, h) + aoff + m * 2048), x1_ = *(const PG8_LAS u32x4*)(lds + PG8_SA(b, h) + aoff1 + m * 2048); \
        dst##8[m] = (v8i_t){(int)x0_.x, (int)x0_.y, (int)x0_.z, (int)x0_.w, (int)x1_.x, (int)x1_.y, (int)x1_.z, (int)x1_.w}; } } else { \
        _Pragma("unroll") for (int m = 0; m < 4; ++m) _Pragma("unroll") for (int k = 0; k < 2; ++k) dst[m][k] = *(const PG8_LAS bf16x8*)(lds + PG8_SA(b, h) + aoff + m * 2048 + k * 1024); } } while (0)
#define PG8_LDB(dst, b, h) do { if constexpr (F8) { _Pragma("unroll") for (int n = 0; n < 2; ++n) { const u32x4 x0_ = *(const PG8_LAS u32x4*)(lds + PG8_SB(b, h) + boff + n * 2048), x1_ = *(const PG8_LAS u32x4*)(lds + PG8_SB(b, h) + boff1 + n * 2048); \
        dst##8[n] = (v8i_t){(int)x0_.x, (int)x0_.y, (int)x0_.z, (int)x0_.w, (int)x1_.x, (int)x1_.y, (int)x1_.z, (int)x1_.w}; } } else { \
        _Pragma("unroll") for (int n = 0; n < 2; ++n) _Pragma("unroll") for (int k = 0; k < 2; ++k) dst[n][k] = *(const PG8_LAS bf16x8*)(lds + PG8_SB(b, h) + boff + n * 2048 + k * 1024); } } while (0)
#define PG8_MMA(ai, bj, At, Bt) do { __builtin_amdgcn_s_setprio(1); if constexpr (F8) { _Pragma("unroll") for (int m = 0; m < 4; ++m) _Pragma("unroll") for (int n = 0; n < 2; ++n) \
        asm volatile("v_mfma_scale_f32_16x16x128_f8f6f4 %0, %1, %2, %0, %3, %3 op_sel_hi:[0,0,0]" : "+v"(acc[ai][bj][m][n]) : "v"(Bt##8[n]), "v"(At##8[m]), "v"(sc1_)); } else { \
        _Pragma("unroll") for (int m = 0; m < 4; ++m) _Pragma("unroll") for (int n = 0; n < 2; ++n) _Pragma("unroll") for (int k = 0; k < 2; ++k) \
        acc[ai][bj][m][n] = __builtin_amdgcn_mfma_f32_16x16x32_bf16(Bt[n][k], At[m][k], acc[ai][bj][m][n], 0, 0, 0); } __builtin_amdgcn_s_setprio(0); } while (0)
#define PG8_WAIT_V(n) asm volatile("s_waitcnt vmcnt(" #n ")" ::: "memory")
#define PG8_WAIT_L(n) asm volatile("s_waitcnt lgkmcnt(" #n ")" ::: "memory")
#define PG8_BAR __builtin_amdgcn_s_barrier()
#define PG8_SCHED __builtin_amdgcn_sched_barrier(0)
    Unit cur, nxt; int ui = 0;
    if (!S.next(0, cur)) return;
    f32x4 acc[2][2][4][2];
#pragma unroll
    for (int a = 0; a < 2; ++a)
#pragma unroll
        for (int b = 0; b < 2; ++b)
#pragma unroll
            for (int m = 0; m < 4; ++m)
#pragma unroll
                for (int n = 0; n < 2; ++n) acc[a][b][m][n] = (f32x4){0.f, 0.f, 0.f, 0.f};
    bf16x8 At[4][2], B0[2][2], B1[2][2]; v8i_t At8[4], B08[2], B18[2];
    int sc1_ = 0x7F7F7F7F; asm volatile("" : "+v"(sc1_));
    const char* cA = (const char*)g.A + (size_t)cur.pm * tstep; const char* cB = (const char*)g.Bt + (size_t)cur.pn * tstep;
    S.a_ready(cur);
    if constexpr (SP2) {
        PG8_STAGE(PG8_SB(0, 0), cB, voffB); PG8_STAGE(PG8_SB(0, 1), cB + hstep, voffB); PG8_STAGE(PG8_SA(0, 0), cA, voffA); PG8_STAGE(PG8_SA(0, 1), cA + hstep, voffA);
        if (wr == 1) PG8_BAR;
        PG8_WAIT_V(2); PG8_BAR;
        PG8_STAGE(PG8_SB(1, 0), cB + kstep, voffB); PG8_STAGE(PG8_SA(1, 0), cA + kstep, voffA); PG8_STAGE(PG8_SB(1, 1), cB + hstep + kstep, voffB);
        PG8_WAIT_V(6); PG8_BAR;
    } else {
        PG8_STAGE(PG8_SB(0, 0), cB, voffB); PG8_STAGE(PG8_SA(0, 0), cA, voffA); PG8_STAGE(PG8_SB(0, 1), cB + hstep, voffB); PG8_STAGE(PG8_SA(0, 1), cA + hstep, voffA);
        if (wr == 1) PG8_BAR;
        PG8_WAIT_V(4); PG8_BAR;
        PG8_STAGE(PG8_SB(1, 0), cB + kstep, voffB); PG8_STAGE(PG8_SA(1, 0), cA + kstep, voffA); PG8_STAGE(PG8_SB(1, 1), cB + hstep + kstep, voffB);
        PG8_WAIT_V(6); PG8_BAR;
    }
    for (;;) {
        const bool has_next = S.next(ui + 1, nxt);
        const char* nA = has_next ? (const char*)g.A + (size_t)nxt.pm * tstep : cA; const char* nB = has_next ? (const char*)g.Bt + (size_t)nxt.pn * tstep : cB;
        for (int t = 0; t < nt; t += 2) {
            if constexpr (Epi::MIDK) { if (t == Epi::KB1 || t == Epi::KB2) E.mid(acc, cur, t, wr, wc, fr, fq); }
            const bool last = (t == nt - 2);
            const char* a1 = cA + (size_t)(t + 1) * kstep;
            const char* a2 = last ? nA : cA + (size_t)(t + 2) * kstep; const char* b2 = last ? nB : cB + (size_t)(t + 2) * kstep;
            const char* a3 = a2 + kstep; const char* b3 = b2 + kstep;
            if (last && has_next) S.a_ready(nxt);
            if constexpr (SP2) {
            PG8_LDB(B0, 0, 0); PG8_LDB(B1, 0, 1); PG8_SCHED; PG8_LDA(At, 0, 0); PG8_STAGE(PG8_SA(1, 1), a1 + hstep, voffA);
            PG8_WAIT_V(8); PG8_WAIT_L(0); PG8_BAR; PG8_MMA(0, 0, At, B0); PG8_MMA(0, 1, At, B1); PG8_BAR; PG8_SCHED;
            PG8_LDA(At, 0, 1); PG8_STAGE(PG8_SB(0, 0), b2, voffB); PG8_STAGE(PG8_SB(0, 1), b2 + hstep, voffB); PG8_STAGE(PG8_SA(0, 0), a2, voffA);
            PG8_WAIT_V(8); PG8_WAIT_L(0); PG8_BAR; PG8_MMA(1, 0, At, B0); PG8_MMA(1, 1, At, B1); PG8_BAR; PG8_SCHED;
            PG8_LDB(B0, 1, 0); PG8_LDB(B1, 1, 1); PG8_SCHED; PG8_LDA(At, 1, 0); PG8_STAGE(PG8_SA(0, 1), a2 + hstep, voffA);
            PG8_WAIT_V(8); PG8_WAIT_L(0); PG8_BAR; PG8_MMA(0, 0, At, B0); PG8_MMA(0, 1, At, B1); PG8_BAR; PG8_SCHED;
            PG8_LDA(At, 1, 1); PG8_STAGE(PG8_SB(1, 0), b3, voffB); PG8_STAGE(PG8_SB(1, 1), b3 + hstep, voffB); PG8_STAGE(PG8_SA(1, 0), a3, voffA);
            PG8_WAIT_V(8); PG8_WAIT_L(0); PG8_BAR; PG8_MMA(1, 0, At, B0); PG8_MMA(1, 1, At, B1); PG8_BAR; PG8_SCHED;
            } else {
            PG8_LDB(B0, 0, 0); PG8_SCHED; PG8_LDA(At, 0, 0); PG8_STAGE(PG8_SA(1, 1), a1 + hstep, voffA);
            PG8_WAIT_L(8); PG8_BAR; PG8_WAIT_L(0); PG8_MMA(0, 0, At, B0); PG8_BAR; PG8_SCHED;
            PG8_LDB(B1, 0, 1); PG8_STAGE(PG8_SB(0, 0), b2, voffB);
            PG8_BAR; PG8_WAIT_L(0); PG8_MMA(0, 1, At, B1); PG8_BAR;
            PG8_LDA(At, 0, 1); PG8_STAGE(PG8_SA(0, 0), a2, voffA);
            PG8_BAR; PG8_WAIT_L(0); PG8_MMA(1, 0, At, B0); PG8_BAR; PG8_SCHED;
            PG8_STAGE(PG8_SB(0, 1), b2 + hstep, voffB);
            PG8_WAIT_V(6); PG8_BAR; PG8_MMA(1, 1, At, B1); PG8_BAR;
            PG8_LDB(B0, 1, 0); PG8_SCHED; PG8_LDA(At, 1, 0); PG8_STAGE(PG8_SA(0, 1), a2 + hstep, voffA);
            PG8_WAIT_L(8); PG8_BAR; PG8_WAIT_L(0); PG8_MMA(0, 0, At, B0); PG8_BAR; PG8_SCHED;
            PG8_LDB(B1, 1, 1); PG8_STAGE(PG8_SB(1, 0), b3, voffB);
            PG8_BAR; PG8_WAIT_L(0); PG8_MMA(0, 1, At, B1); PG8_BAR;
            PG8_LDA(At, 1, 1); PG8_STAGE(PG8_SA(1, 0), a3, voffA);
            PG8_BAR; PG8_WAIT_L(0); PG8_MMA(1, 0, At, B0); PG8_BAR; PG8_SCHED;
            PG8_STAGE(PG8_SB(1, 1), b3 + hstep, voffB);
            PG8_WAIT_V(6); PG8_BAR; PG8_MMA(1, 1, At, B1); PG8_BAR;
            }
        }
        if constexpr (ALIGN_EPI) { if (wr == 0) PG8_BAR; }
        if constexpr (F8) asm volatile("s_nop 15\n\ts_nop 15" ::: "memory");
        if constexpr (!Epi::AFTER_DRAIN) { E(acc, cur, wr, wc, fr, fq); S.done(cur); }
        if (!has_next) break;
#pragma unroll
        for (int a = 0; a < 2; ++a)
#pragma unroll
            for (int b = 0; b < 2; ++b)
#pragma unroll
                for (int m = 0; m < 4; ++m)
#pragma unroll
                    for (int n = 0; n < 2; ++n) acc[a][b][m][n] = (f32x4){0.f, 0.f, 0.f, 0.f};
        cur = nxt; cA = nA; cB = nB; ++ui;
        if constexpr (ALIGN_EPI) { if (wr == 1) PG8_BAR; }
    }
    PG8_WAIT_V(0);
    if constexpr (!ALIGN_EPI) { if (wr == 0) PG8_BAR; }
    PG8_BAR;
    if constexpr (Epi::AFTER_DRAIN) { E.fused(acc, cur, wr, wc, fr, fq, lds, wid, lane); S.done(cur); }
#undef PG8_SA
#undef PG8_SB
#undef PG8_STAGE
#undef PG8_LDA
#undef PG8_LDB
#undef PG8_MMA
#undef PG8_WAIT_V
#undef PG8_WAIT_L
#undef PG8_BAR
#undef PG8_SCHED
}
}
#define PG8_SP2 true
#define GAS __attribute__((address_space(1)))
#define LAS __attribute__((address_space(3)))
typedef unsigned short bf16;
typedef unsigned v4u __attribute__((ext_vector_type(4)));
typedef float f32x4 __attribute__((ext_vector_type(4)));
typedef short bf16x8 __attribute__((ext_vector_type(8)));
typedef GAS unsigned gu32;
typedef GAS unsigned long long gu64;
#define RLX_AGENT __ATOMIC_RELAXED, __HIP_MEMORY_SCOPE_AGENT
#define LDS_WAIT() asm volatile("s_waitcnt lgkmcnt(0)" ::: "memory")
#define VM_WAIT() asm volatile("s_waitcnt vmcnt(0)" ::: "memory")
__device__ __forceinline__ unsigned long long rt() { return __builtin_amdgcn_s_memrealtime(); }
__device__ __forceinline__ unsigned f2bf(float f) { unsigned u = __builtin_bit_cast(unsigned, f); return (u + 0x7fffu + ((u >> 16) & 1u)) >> 16; }
__device__ __forceinline__ unsigned pk2(float lo, float hi) { return f2bf(lo) | (f2bf(hi) << 16); }

#define XB_TMO      128
#define XB_XCNT(j)  (256  + 64 * (j))
#define XB_XSUB(j)  (1280 + 64 * (j))
#define XB_XGEN(j)  (2304 + 64 * (j))
#define XB_TOP      3328
#define XB_TOPGEN   3392
#define XCD_BAR_WORDS 3456
#define XB_SPIN_CAP (1u << 18)

__device__ __forceinline__ unsigned xb_ld(unsigned* p)              { return __hip_atomic_load(p, __ATOMIC_RELAXED, __HIP_MEMORY_SCOPE_AGENT); }
__device__ __forceinline__ unsigned xb_add(unsigned* p, unsigned v) { return __hip_atomic_fetch_add(p, v, __ATOMIC_RELAXED, __HIP_MEMORY_SCOPE_AGENT); }
__device__ __forceinline__ unsigned xb_xcc_id() { return (unsigned)__builtin_amdgcn_s_getreg((3 << 11) | 20) & 0xFu; }
#define XB_SPIN(cond, bar) do { unsigned _sp = 0; while (cond) { __builtin_amdgcn_s_sleep(1); \
    if ((++_sp & 255u) == 0u) { if (xb_ld(&(bar)[XB_TMO])) break; if (_sp > XB_SPIN_CAP) { atomicAdd(&(bar)[XB_TMO], 1u); break; } } } } while (0)

struct XcdBarrier {
    unsigned* bar; unsigned x;
    volatile LAS unsigned* st;
};

__device__ __forceinline__ XcdBarrier xcd_barrier_post(unsigned* bar, volatile LAS unsigned* st) {
    XcdBarrier b; b.bar = bar; b.x = xb_xcc_id(); b.st = st;
    if (threadIdx.x == 0) st[3] = xb_add(&bar[XB_XCNT(b.x)], 1u);
    return b;
}
__device__ __forceinline__ void xcd_barrier_complete(unsigned* bar, unsigned x, unsigned& nloc, unsigned& nx, unsigned& uni) {
    const unsigned G = gridDim.x * gridDim.y * gridDim.z;
    unsigned sum, cnt, mine, bad, sp = 0u;
    for (;;) {
        sum = 0u; cnt = 0u; mine = 0u; bad = 0u;
#pragma unroll
        for (unsigned j = 0; j < 16; ++j) { const unsigned c = xb_ld(&bar[XB_XCNT(j)]); sum += c; cnt += (c > 0u) ? 1u : 0u; mine = (j == x) ? c : mine; bad += (c != 0u && (c != 32u || j >= 8u)) ? 1u : 0u; }
        if (sum == G) break;
        __builtin_amdgcn_s_sleep(1);
        if ((++sp & 255u) == 0u) { if (xb_ld(&bar[XB_TMO])) break; if (sp > XB_SPIN_CAP) { atomicAdd(&bar[XB_TMO], 1u); break; } }
    }
    nloc = mine > 0u ? mine : 1u; nx = cnt > 0u ? cnt : 1u;
    uni = (sum == G && G == 256u && cnt == 8u && bad == 0u) ? 1u : 2u;
}

__device__ __forceinline__ void xcd_barrier(const XcdBarrier& b) {
    asm volatile("s_waitcnt vmcnt(0)" ::: "memory");
    __syncthreads();
    if (threadIdx.x == 0) {
        unsigned* bar = b.bar;
        __builtin_amdgcn_s_waitcnt(0);
        unsigned nloc = b.st[0], nx = b.st[1];
        if (nloc == 0u) { unsigned uni; xcd_barrier_complete(bar, b.x, nloc, nx, uni); b.st[0] = nloc; b.st[1] = nx; b.st[2] = uni; }
        const unsigned old = xb_add(&bar[XB_XSUB(b.x)], 1u);
        const unsigned gen = old / nloc;
        if (old + 1u == (gen + 1u) * nloc) {
            __builtin_amdgcn_fence(__ATOMIC_RELEASE, "agent");
            asm volatile("s_waitcnt vmcnt(0)" ::: "memory");
            const unsigned og = xb_add(&bar[XB_TOP], 1u);
            const unsigned tg = og / nx;
            if (og + 1u == (tg + 1u) * nx) xb_add(&bar[XB_TOPGEN], 1u);
            else XB_SPIN(xb_ld(&bar[XB_TOPGEN]) == tg, bar);
            __builtin_amdgcn_fence(__ATOMIC_ACQUIRE, "agent");
            xb_add(&bar[XB_XGEN(b.x)], 1u);
            asm volatile("s_waitcnt vmcnt(0)" ::: "memory");
        } else {
            XB_SPIN(xb_ld(&bar[XB_XGEN(b.x)]) == gen, bar);
            __builtin_amdgcn_fence(__ATOMIC_ACQUIRE, "agent");
            asm volatile("s_waitcnt vmcnt(0)" ::: "memory");
        }
    }
    __syncthreads();
}
__device__ __forceinline__ void xcd_barrier_local(const XcdBarrier& b) {
    asm volatile("s_waitcnt vmcnt(0)" ::: "memory");
    __syncthreads();
    if (threadIdx.x == 0) {
        unsigned* bar = b.bar;
        __builtin_amdgcn_s_waitcnt(0);
        const unsigned nloc = b.st[0];
        const unsigned old = xb_add(&bar[XB_XSUB(b.x)], 1u);
        const unsigned gen = old / nloc;
        if (old + 1u == (gen + 1u) * nloc) xb_add(&bar[XB_XGEN(b.x)], 1u);
        else XB_SPIN(xb_ld(&bar[XB_XGEN(b.x)]) == gen, bar);
        __builtin_amdgcn_fence(__ATOMIC_ACQUIRE, "agent");
        asm volatile("s_waitcnt vmcnt(0)" ::: "memory");
    }
    __syncthreads();
}
namespace cfg {
constexpr int NWAVES = 8;
constexpr int M = 16384, D = 2048, T = 2048, NBATCH = 8, DEPTH = 2;
constexpr int IN_COLS = 10152, NPROJ = 10240, PA_LD = 4096, GT_LD = 6144;
constexpr int C_QA = 0, C_KA = 1024, C_VA = 1280, C_QB = 1536, C_KB = 2048, C_VB = 2560, C_QC = 3072, C_CL = 3584, C_IQ = 3712, C_IK = 3968, C_IW = 4000;
constexpr float EPS = 1e-6f;
constexpr size_t MiB = 1u << 20;
constexpr size_t WS_CTL = 0, CTL_ZERO_BYTES = 1 * MiB;
constexpr size_t WS_ROWSSB = 842 * MiB;
constexpr size_t WS_ROWSSA = 1 * MiB;
constexpr size_t WS_KMEAN = 512 * 1024;
constexpr size_t WS_BIASD = 1 * MiB + 256 * 1024;
constexpr size_t WS_WUKB = 1 * MiB + 512 * 1024;
constexpr size_t WS_WUVT = 1 * MiB + 768 * 1024;
constexpr size_t WS_CN = 2 * MiB;
constexpr size_t WS_MASK = 6 * MiB;
constexpr size_t WS_WA = 10 * MiB, WS_WB = 18 * MiB, WS_WC = 22 * MiB, WS_WOUT = 26 * MiB, WS_WQ = 42 * MiB, WS_WIN = 58 * MiB;
constexpr size_t WS_U = 138 * MiB, WS_V = 266 * MiB;
constexpr size_t WS_USC = WS_U + 64 * MiB;
constexpr size_t WS_XB8 = WS_U + 80 * MiB;
constexpr size_t WS_WG8 = WS_V + 80 * MiB;
constexpr size_t WS_XB = 394 * MiB;
constexpr size_t WS_PA = 458 * MiB;
constexpr size_t WS_MG = 682 * MiB, WS_QP = 714 * MiB;
constexpr size_t WS_GT = 586 * MiB;
constexpr size_t WS_YA = 778 * MiB, WS_YB = 810 * MiB, WS_YC = 826 * MiB;
constexpr size_t WS_SKB = 844 * MiB;
constexpr size_t WS_SC = 845 * MiB;
constexpr size_t WS_PD = WS_SC;
constexpr size_t WS_RI = 973 * MiB, WS_RG = 981 * MiB, WS_W = 989 * MiB;
constexpr size_t WS_RSTD = 997 * MiB;
constexpr size_t WS_RS = 998 * MiB;
constexpr size_t WS_END = 999 * MiB;
constexpr int CW_BAR = 4096;
constexpr int RING_BYTES = 131072, LDS_BYTES = 147456, LDSCTL_OFF = LDS_BYTES - 512, MISC_OFF = LDSCTL_OFF + 320;
constexpr int NPHASE = 22;
}
using namespace cfg;
typedef unsigned u32x4v __attribute__((ext_vector_type(4)));
typedef unsigned u32x2v __attribute__((ext_vector_type(2)));
typedef float f32x2v __attribute__((ext_vector_type(2)));
typedef __bf16 bf16x2_t __attribute__((ext_vector_type(2)));
__device__ __forceinline__ float bflo(unsigned u) { return __builtin_bit_cast(float, u << 16); }
__device__ __forceinline__ float bfhi(unsigned u) { return __builtin_bit_cast(float, u & 0xffff0000u); }
__device__ __forceinline__ float bf1(bf16 v) { return __builtin_bit_cast(float, (unsigned)v << 16); }
__device__ __forceinline__ float dot2(unsigned a, unsigned b, float c) { return __builtin_amdgcn_fdot2_f32_bf16(__builtin_bit_cast(bf16x2_t, a), __builtin_bit_cast(bf16x2_t, b), c, false); }
__device__ __forceinline__ float dot8(v4u a, v4u b, float c) { c = dot2(a.x, b.x, c); c = dot2(a.y, b.y, c); c = dot2(a.z, b.z, c); c = dot2(a.w, b.w, c); return c; }
__device__ __forceinline__ float wave_sum(float v) {
    v += lane_xor<1>(v); v += lane_xor<2>(v); v += lane_xor<4>(v); v += lane_xor<8>(v); v += lane_xor<16>(v); v = half_sum(v);
    return v;
}
__device__ __forceinline__ float wave_max(float v) {
    v = fmaxf(v, lane_xor<1>(v)); v = fmaxf(v, lane_xor<2>(v)); v = fmaxf(v, lane_xor<4>(v)); v = fmaxf(v, lane_xor<8>(v)); v = fmaxf(v, lane_xor<16>(v)); v = half_max(v);
    return v;
}
__device__ __forceinline__ unsigned fkey(float f) { const unsigned u = __builtin_bit_cast(unsigned, f); return u ^ ((unsigned)((int)u >> 31) | 0x80000000u); }
__device__ __forceinline__ float funkey(unsigned k) { return __builtin_bit_cast(float, (k & 0x80000000u) ? (k ^ 0x80000000u) : ~k); }
__device__ __forceinline__ int mbcnt64(unsigned long long m) { return (int)__builtin_amdgcn_mbcnt_hi((unsigned)(m >> 32), __builtin_amdgcn_mbcnt_lo((unsigned)m, 0u)); }
__device__ __forceinline__ float rdlane(float v, int l) { return __builtin_bit_cast(float, __builtin_amdgcn_readlane(__builtin_bit_cast(int, v), l)); }
__device__ __forceinline__ float gelu_tanh(float x) { const float u = 0.7978845608028654f * (x + 0.044715f * x * x * x); const float e = __expf(2.0f * u); const float th = 1.0f - 2.0f / (e + 1.0f); return 0.5f * x * (1.0f + th); }
typedef int v6i_t __attribute__((ext_vector_type(6)));
typedef __bf16 v32b_t __attribute__((ext_vector_type(32)));
typedef float v32f_t __attribute__((ext_vector_type(32)));
typedef unsigned v16u_t __attribute__((ext_vector_type(16)));
constexpr size_t TBL_SLICE = (size_t)16384 * 192, TBL_LAYER = 8 * TBL_SLICE;
__device__ __forceinline__ void row6_load(const float* src, f32x4 (&a)[8], int lane) {
    const int s = lane >> 3, b = lane & 7;
#pragma unroll
    for (int k = 0; k < 8; ++k) a[k] = *(const f32x4*)(src + 256 * s + 32 * k + 4 * b);
}
template <bool UL>
__device__ __forceinline__ float row_to_fp6(f32x4 (&a)[8], const float* g, unsigned char* dst, int lane) {
    const int s = lane >> 3, b = lane & 7;
    float amax = 0.f;
#pragma unroll
    for (int k = 0; k < 8; ++k) { const int e0 = 256 * s + 32 * k + 4 * b;
        if (g) a[k] = a[k] * *(const f32x4*)(g + e0);
        amax = fmaxf(amax, fmaxf(fmaxf(fabsf(a[k].x), fabsf(a[k].y)), fmaxf(fabsf(a[k].z), fabsf(a[k].w)))); }
    amax = wave_max(amax);
    const float enc = amax > 0.f ? 7.5f / amax : 1.f;
    v32b_t v;
#pragma unroll
    for (int k = 0; k < 8; ++k) { v[4 * k] = (__bf16)(a[k].x * enc); v[4 * k + 1] = (__bf16)(a[k].y * enc); v[4 * k + 2] = (__bf16)(a[k].z * enc); v[4 * k + 3] = (__bf16)(a[k].w * enc); }
    const v6i_t w = __builtin_amdgcn_cvt_scalef32_pk32_fp6_bf16(v, 1.0f);
    unsigned* row = (unsigned*)(dst + (size_t)s * TBL_SLICE);
    if (UL) { const int p = b >> 1; const bool h = b & 1;
        v4u q4; q4.x = (unsigned)(h ? w[2] : w[0]); q4.y = (unsigned)(h ? w[3] : w[1]); q4.z = (unsigned)(h ? w[4] : w[2]); q4.w = (unsigned)(h ? w[5] : w[3]);
        u32x2v q2; q2.x = (unsigned)(h ? w[0] : w[4]); q2.y = (unsigned)(h ? w[1] : w[5]);
        *(v4u*)(row + (h ? 32 : 0) + 4 * p) = q4; *(u32x2v*)(row + 16 + 4 * p + (h ? 2 : 0)) = q2; }
    else {
#pragma unroll
        for (int j = 0; j < 3; ++j) { u32x2v q2; q2.x = (unsigned)w[2 * j]; q2.y = (unsigned)w[2 * j + 1]; *(u32x2v*)(row + 16 * j + 2 * b) = q2; } }
    return amax > 0.f ? amax / 7.5f : 1.f;
}
struct TItem { const float* W; const float* g; void* WT; float scale; int ldw, c0, ncv, row_off, ldk, koff, k0, n0; bool f8; };
__device__ __forceinline__ void titem_load(const TItem& d, f32x4 (&v)[8], int lane) {
    const int cj = lane & 7, ks = lane >> 3; const bool ok = d.n0 + 4 * cj < d.ncv;
#pragma unroll
    for (int i = 0; i < 8; ++i) v[i] = ok ? *(const f32x4*)(d.W + (size_t)(d.k0 + 8 * i + ks) * d.ldw + d.c0 + d.n0 + 4 * cj) : (f32x4){0.f, 0.f, 0.f, 0.f};
}
__device__ __forceinline__ void titem_finish(const TItem& d, const f32x4 (&v)[8], LAS float* scr, int lane) {
    const int cj = lane & 7, ks = lane >> 3;
#pragma unroll
    for (int i = 0; i < 8; ++i) { const int kk = 8 * i + ks; const f32x4 w = v[i] * (d.g ? d.g[d.k0 + kk] * d.scale : d.scale);
        LAS float* p = scr + kk * 33 + 4 * cj; p[0] = w.x; p[1] = w.y; p[2] = w.z; p[3] = w.w; }
    LDS_WAIT(); asm volatile("" ::: "memory");
    if (!d.f8) { const int c = lane & 7; bf16* WT = (bf16*)d.WT;
#pragma unroll
        for (int j = 0; j < 4; ++j) { const int n = (lane >> 3) + 8 * j; const LAS float* sp = scr + (8 * c) * 33 + n;
            v4u o; o.x = pk2(sp[0 * 33], sp[1 * 33]); o.y = pk2(sp[2 * 33], sp[3 * 33]); o.z = pk2(sp[4 * 33], sp[5 * 33]); o.w = pk2(sp[6 * 33], sp[7 * 33]);
            *(v4u*)(WT + (size_t)(d.row_off + d.n0 + n) * d.ldk + d.koff + d.k0 + 8 * c) = o; } }
    else { const int n = lane >> 1, hf = lane & 1; const LAS float* sp = scr + (32 * hf) * 33 + n;
        unsigned w[8];
#pragma unroll
        for (int q = 0; q < 8; ++q) { int t = __builtin_amdgcn_cvt_pk_fp8_f32(sp[(4 * q) * 33], sp[(4 * q + 1) * 33], 0, false); t = __builtin_amdgcn_cvt_pk_fp8_f32(sp[(4 * q + 2) * 33], sp[(4 * q + 3) * 33], t, true); w[q] = (unsigned)t; }
        unsigned char* dp = (unsigned char*)d.WT + (size_t)(d.row_off + d.n0 + n) * d.ldk + d.koff + d.k0 + 32 * hf;
        *(v4u*)dp = (v4u){w[0], w[1], w[2], w[3]}; *(v4u*)(dp + 16) = (v4u){w[4], w[5], w[6], w[7]}; }
    LDS_WAIT(); asm volatile("" ::: "memory");
}
__device__ __forceinline__ int rel_bucket(int d) {
    if (d < 16) return d;
    const int v = 16 + (int)(logf((float)d / 16.0f) / 4.852030263919617f * 16.0f);
    return v < 31 ? v : 31;
}
struct Ptrs {
    const float *x, *rel_bias, *g_mix, *w_in, *a_sinks, *c_gain, *w_uk, *w_uv, *w_a, *w_b, *w_c, *w_out, *g_ffn, *w_q, *sub_keys, *peer_u, *peer_v, *g_final;
    float* out; unsigned char* ws;
};
__device__ __forceinline__ void p0_prologue(const Ptrs& P, LAS unsigned char* lds, int gw, int NGW, int wave, int lane) {
    LAS float* scr = (LAS float*)(lds + wave * 16384);
    unsigned char* ws = P.ws;
    constexpr int I_IN1 = 32 * 32, I_IN1B = 32 * 16, I_IN8A = 32 * 48, I_IN8B = 32 * 32, I_IN2 = 32 * 192, I_A = 16 * 64, I_B = 8 * 64, I_C = 8 * 64, I_O = 32 * 64, I_Q = 32 * 64;
    constexpr int I_LAYER = I_IN1 + I_IN1B + I_IN8A + I_IN8B + I_IN2 + I_A + I_B + I_C + I_O + I_Q;
    auto mk = [&](int it) -> TItem {
        const int l = it / I_LAYER; int r = it % I_LAYER; TItem d;
        const float* win = P.w_in + (size_t)l * 2048 * IN_COLS; const float* gm = P.g_mix + l * 2048;
        auto set = [&](const float* W, int ldw, int c0, int ncv, const float* g, float scale, void* WT, int nblk, int ldk, int koff, bool f8) {
            d.W = W; d.ldw = ldw; d.c0 = c0; d.ncv = ncv; d.g = g; d.scale = scale; d.WT = WT; d.row_off = 0; d.ldk = ldk; d.koff = koff; d.k0 = 64 * (r / nblk); d.n0 = 32 * (r % nblk); d.f8 = f8; };
        bf16* WinT = (bf16*)(ws + WS_WIN) + (size_t)l * NPROJ * 2048; unsigned char* Win8 = ws + WS_WG8 + (size_t)l * NPROJ * 2048;
        if (r < I_IN1) { set(win, IN_COLS, 1536, 1024, gm, 1.0f, WinT, 32, 2048, 0, false); d.row_off = 1536; return d; } r -= I_IN1;
        if (r < I_IN1B) { set(win, IN_COLS, 3584, 424, gm, 1.0f, WinT, 16, 2048, 0, false); d.row_off = 3584; return d; } r -= I_IN1B;
        if (r < I_IN8A) { set(win, IN_COLS, 0, 1536, gm, 256.0f, Win8, 48, 2048, 0, true); return d; } r -= I_IN8A;
        if (r < I_IN8B) { set(win, IN_COLS, 2560, 1024, gm, 256.0f, Win8, 32, 2048, 0, true); d.row_off = 2560; return d; } r -= I_IN8B;
        if (r < I_IN2) { set(win, IN_COLS, 4008, 6144, gm, 256.0f, Win8, 192, 2048, 0, true); d.row_off = 4096; return d; } r -= I_IN2;
        if (r < I_A) { set(P.w_a + (size_t)l * 1024 * 2048, 2048, 0, 2048, nullptr, 128.0f, ws + WS_WA + (size_t)l * 2048 * 2048, 64, 2048, 0, true); return d; } r -= I_A;
        if (r < I_B) { set(P.w_b + (size_t)l * 512 * 2048, 2048, 0, 2048, nullptr, 128.0f, ws + WS_WA + (size_t)l * 2048 * 2048, 64, 2048, 1024, true); return d; } r -= I_B;
        if (r < I_C) { set(P.w_c + (size_t)l * 512 * 2048, 2048, 0, 2048, nullptr, 128.0f, ws + WS_WA + (size_t)l * 2048 * 2048, 64, 2048, 1536, true); return d; } r -= I_C;
        if (r < I_O) { set(P.w_out + (size_t)l * 2048 * 2048, 2048, 0, 2048, nullptr, 256.0f, ws + WS_WOUT + (size_t)l * 2048 * 2048, 64, 2048, 0, true); return d; } r -= I_O;
        set(P.w_q + (size_t)l * 2048 * 2048, 2048, 0, 2048, P.g_ffn + l * 2048, 1.0f, (bf16*)(ws + WS_WQ) + (size_t)l * 2048 * 2048, 64, 2048, 0, false); return d; };
    { f32x4 nx[8];
      if (gw < 2 * I_LAYER) { const TItem d0 = mk(gw); titem_load(d0, nx, lane); }
#pragma unroll 1
      for (int it = gw; it < 2 * I_LAYER; it += NGW) {
          const TItem d = mk(it);
          f32x4 a[8];
#pragma unroll
          for (int k = 0; k < 8; ++k) a[k] = nx[k];
          { const TItem dn = mk((it + NGW < 2 * I_LAYER) ? it + NGW : it); titem_load(dn, nx, lane); }
          titem_finish(d, a, scr, lane);
      } }
    { f32x4 nx[8];
      if (gw < 4 * 16384) { const int tb = gw >> 14, e = gw & 16383, l = tb & 1; row6_load((tb < 2 ? P.peer_u : P.peer_v) + ((size_t)l * 16384 + e) * 2048, nx, lane); }
#pragma unroll 1
      for (int it = gw; it < 4 * 16384; it += NGW) {
        const int tb = it >> 14, e = it & 16383, l = tb & 1;
        f32x4 a[8];
#pragma unroll
        for (int k = 0; k < 8; ++k) a[k] = nx[k];
        { const int itn = (it + NGW < 4 * 16384) ? it + NGW : it; const int tbn = itn >> 14, en = itn & 16383, ln = tbn & 1; row6_load((tbn < 2 ? P.peer_u : P.peer_v) + ((size_t)ln * 16384 + en) * 2048, nx, lane); }
        if (tb < 2) { const float sc = row_to_fp6<true>(a, P.g_ffn + l * 2048, ws + WS_U + (size_t)l * TBL_LAYER + (size_t)e * 192, lane); if (lane == 0) ((float*)(ws + WS_USC))[2 * (l * 16384 + e)] = sc; }
        else        { const float sc = row_to_fp6<false>(a, nullptr, ws + WS_V + (size_t)l * TBL_LAYER + (size_t)e * 192, lane); if (lane == 0) ((float*)(ws + WS_USC))[2 * (l * 16384 + e) + 1] = sc; }
      } }
    float* RS = (float*)(ws + WS_RS);
    { f32x4 nx[8];
      if (gw < M) {
#pragma unroll
          for (int i = 0; i < 4; ++i) { const float* p = P.x + (size_t)gw * 2048 + 8 * (lane + 64 * i); nx[2 * i] = *(const f32x4*)p; nx[2 * i + 1] = *(const f32x4*)(p + 4); } }
#pragma unroll 1
      for (int m = gw; m < M; m += NGW) {
          f32x4 a[8];
#pragma unroll
          for (int k = 0; k < 8; ++k) a[k] = nx[k];
          { const int mn = (m + NGW < M) ? m + NGW : m;
#pragma unroll
            for (int i = 0; i < 4; ++i) { const float* p = P.x + (size_t)mn * 2048 + 8 * (lane + 64 * i); nx[2 * i] = *(const f32x4*)p; nx[2 * i + 1] = *(const f32x4*)(p + 4); } }
          float ss = 0.f; bf16* dst = (bf16*)(ws + WS_XB) + (size_t)m * 2048; unsigned char* dst8 = ws + WS_XB8 + (size_t)m * 2048;
#pragma unroll
          for (int i = 0; i < 4; ++i) { const int e0 = 8 * (lane + 64 * i); const f32x4 p = a[2 * i], q = a[2 * i + 1];
              ss += (p.x * p.x + p.y * p.y) + (p.z * p.z + p.w * p.w) + (q.x * q.x + q.y * q.y) + (q.z * q.z + q.w * q.w);
              v4u o; o.x = pk2(p.x, p.y); o.y = pk2(p.z, p.w); o.z = pk2(q.x, q.y); o.w = pk2(q.z, q.w); *(v4u*)(dst + e0) = o;
              int w0 = __builtin_amdgcn_cvt_pk_fp8_f32(p.x, p.y, 0, false); w0 = __builtin_amdgcn_cvt_pk_fp8_f32(p.z, p.w, w0, true); int w1 = __builtin_amdgcn_cvt_pk_fp8_f32(q.x, q.y, 0, false); w1 = __builtin_amdgcn_cvt_pk_fp8_f32(q.z, q.w, w1, true);
              u32x2v o8; o8.x = (unsigned)w0; o8.y = (unsigned)w1; *(u32x2v*)(dst8 + e0) = o8; }
          ss = wave_sum(ss);
          if (lane < 16) RS[m * 16 + lane] = lane == 0 ? ss : 0.f; } }
    { bf16* SKB = (bf16*)(ws + WS_SKB);
      for (int i = gw * 64 + lane; i < 2 * 262144 / 4; i += NGW * 64) { const f32x4 v = *(const f32x4*)(P.sub_keys + 4 * (size_t)i); u32x2v o; o.x = pk2(v.x, v.y); o.y = pk2(v.z, v.w); *(u32x2v*)(SKB + 4 * (size_t)i) = o; } }
    { bf16* WUKB = (bf16*)(ws + WS_WUKB); bf16* WUVT = (bf16*)(ws + WS_WUVT);
      for (int i = gw * 64 + lane; i < 2 * 65536; i += NGW * 64) { const int l = i >> 16, c = (i >> 9) & 127, h = (i >> 6) & 7, d = i & 63;
          WUKB[((size_t)(l * 8 + h) * 128 + c) * 64 + d] = (bf16)f2bf(P.w_uk[i]); WUVT[((size_t)(l * 8 + h) * 64 + d) * 128 + c] = (bf16)f2bf(P.w_uv[i]); } }
    float* biasd = (float*)(ws + WS_BIASD);
    for (int i = gw * 64 + lane; i < 32 * 2048; i += NGW * 64) { const int hh = i >> 11, d = i & 2047; biasd[i] = P.rel_bias[rel_bucket(d) * 32 + hh]; }
}
__device__ __forceinline__ void cn_item(const bf16* PA, const float* gain, bf16* CN, int item, int lane) {
    const int row = 4 * item + (lane >> 4), c8 = 8 * (lane & 15);
    const v4u cv = *(const v4u*)(PA + (size_t)row * PA_LD + C_CL + c8);
    const float f0 = bflo(cv.x), f1 = bfhi(cv.x), f2 = bflo(cv.y), f3 = bfhi(cv.y), f4 = bflo(cv.z), f5 = bfhi(cv.z), f6 = bflo(cv.w), f7 = bfhi(cv.w);
    float ss = ((f0 * f0 + f1 * f1) + (f2 * f2 + f3 * f3)) + ((f4 * f4 + f5 * f5) + (f6 * f6 + f7 * f7));
    ss += lane_xor<1>(ss); ss += lane_xor<2>(ss); ss += lane_xor<4>(ss); ss += lane_xor<8>(ss);
    const float r = rsqrtf(ss * (1.0f / 128.0f) + EPS);
    const f32x4 g0 = *(const f32x4*)(gain + c8), g1 = *(const f32x4*)(gain + c8 + 4);
    v4u o; o.x = pk2(f0 * r * g0.x, f1 * r * g0.y); o.y = pk2(f2 * r * g0.z, f3 * r * g0.w); o.z = pk2(f4 * r * g1.x, f5 * r * g1.y); o.w = pk2(f6 * r * g1.z, f7 * r * g1.w);
    *(v4u*)(CN + (size_t)row * 128 + c8) = o;
}
typedef float f32x16 __attribute__((ext_vector_type(16)));
typedef short s16x4 __attribute__((ext_vector_type(4)));
#define MFMA32(a, b, c) __builtin_amdgcn_mfma_f32_32x32x16_bf16((a), (b), (c), 0, 0, 0)
__device__ __forceinline__ s16x4 vtr(const LAS unsigned char* p) { return __builtin_bit_cast(s16x4, __builtin_amdgcn_ds_read_tr16_b64_v4i16((LAS s16x4*)p)); }
__device__ __forceinline__ float xhalf_max(float v) { const unsigned u = __builtin_bit_cast(unsigned, v); auto rr = __builtin_amdgcn_permlane32_swap(u, u, false, false); return fmaxf(__builtin_bit_cast(float, (unsigned)rr[0]), __builtin_bit_cast(float, (unsigned)rr[1])); }
__device__ __forceinline__ float xhalf_sum(float v) { const unsigned u = __builtin_bit_cast(unsigned, v); auto rr = __builtin_amdgcn_permlane32_swap(u, u, false, false); return __builtin_bit_cast(float, (unsigned)rr[0]) + __builtin_bit_cast(float, (unsigned)rr[1]); }
__device__ __forceinline__ unsigned pkbf(float lo, float hi) { return pg8::cvt_pk_bf16(lo, hi); }
__device__ __forceinline__ unsigned pk4f8(float a, float b, float c, float d) { int w = __builtin_amdgcn_cvt_pk_fp8_f32(a * 16.0f, b * 16.0f, 0, false); return (unsigned)__builtin_amdgcn_cvt_pk_fp8_f32(c * 16.0f, d * 16.0f, w, true); }
template <int DK> __device__ __forceinline__ void qk_tile(const LAS unsigned char* Kt, const bf16x8 (&qf)[DK / 16], f32x16& p0, f32x16& p1, int r, int hh) {
#pragma unroll
    for (int i = 0; i < 16; ++i) { p0[i] = 0.f; p1[i] = 0.f; }
#pragma unroll
    for (int st = 0; st < DK / 16; ++st) {
        const bf16x8 k0 = *(const LAS bf16x8*)(Kt + ((2 * st + hh) * 64 + r) * 16);
        const bf16x8 k1 = *(const LAS bf16x8*)(Kt + ((2 * st + hh) * 64 + 32 + r) * 16);
        p0 = MFMA32(k0, qf[st], p0); p1 = MFMA32(k1, qf[st], p1);
    }
}
__device__ __forceinline__ float softmax_tile(f32x16& p0, f32x16& p1, float& m, float& l) {
    float mt = fmaxf(p0[0], p1[0]);
#pragma unroll
    for (int i = 1; i < 16; ++i) mt = fmaxf(mt, fmaxf(p0[i], p1[i]));
    mt = xhalf_max(mt);
    const float mn = fmaxf(m, mt);
    const float mu = (mn == -INFINITY) ? 0.f : mn;
    const float alpha = __builtin_amdgcn_exp2f(m - mu);
    float s = 0.f;
#pragma unroll
    for (int i = 0; i < 16; ++i) { p0[i] = __builtin_amdgcn_exp2f(p0[i] - mu); p1[i] = __builtin_amdgcn_exp2f(p1[i] - mu); s += p0[i] + p1[i]; }
    l = l * alpha + s; m = mn;
    return alpha;
}
constexpr float LOG2E = 1.4426950408889634f, QK_SCALE2 = 0.125f * LOG2E;
template <int DV> __device__ __forceinline__ void pv_tile(const LAS unsigned char* Vt, const f32x16& p0, const f32x16& p1, f32x16 (&o)[DV / 32], int lane) {
    const LAS unsigned char* vb = Vt + ((lane >> 4) & 1) * 32 + (lane & 3) * 8 + (4 * (lane >> 5) + ((lane & 15) >> 2)) * 64;
#pragma unroll
    for (int s = 0; s < 4; ++s) {
        const f32x16& p = (s < 2) ? p0 : p1; const int b0 = 8 * (s & 1);
        u32x4v pw; pw.x = pkbf(p[b0 + 0], p[b0 + 1]); pw.y = pkbf(p[b0 + 2], p[b0 + 3]); pw.z = pkbf(p[b0 + 4], p[b0 + 5]); pw.w = pkbf(p[b0 + 6], p[b0 + 7]);
        const bf16x8 pf = __builtin_bit_cast(bf16x8, pw);
#pragma unroll
        for (int db = 0; db < DV / 32; ++db) {
            const s16x4 lo = vtr(vb + db * 4096 + s * 1024), hi = vtr(vb + db * 4096 + s * 1024 + 512);
            const bf16x8 vf = (bf16x8){lo[0], lo[1], lo[2], lo[3], hi[0], hi[1], hi[2], hi[3]};
            o[db] = MFMA32(vf, pf, o[db]);
        }
    }
}
__device__ __forceinline__ void sel_unit(const bf16* PA, float* SC, unsigned long long* MASK, int b, int qt, LAS unsigned char* lds, int tid, int wave, int lane) {
    const int r = lane & 31, hh = lane >> 5;
    if (qt >= 8) {
        const int t = 32 * qt + r, row = b * T + t;
        LAS unsigned char* qs = lds + 65536;
        { int tq = tid; asm volatile("" : "+v"(tq));
          v4u tq4[3];
#pragma unroll
          for (int k = 0; k < 3; ++k) { const int c = tq + NWAVES * 64 * k, cc = c < 32 * 33 ? c : 0; const int rr = cc / 33, j = cc - 33 * rr;
              tq4[k] = *(const v4u*)(PA + (size_t)(b * T + 32 * qt + rr) * PA_LD + (j < 32 ? C_IQ + 8 * j : C_IW)); }
#pragma unroll
          for (int k = 0; k < 3; ++k) { const int c = tq + NWAVES * 64 * k; if (c < 32 * 33) { const int rr = c / 33, j = c - 33 * rr; *(LAS v4u*)(qs + rr * 528 + 16 * j) = tq4[k]; } } }
        __syncthreads();
        const int NT = (qt >> 1) + 1;
        int rk = r; asm volatile("" : "+v"(rk));
        const LAS unsigned char* qr = qs + rk * 528 + 16 * hh;
        bf16x8 k00, k01, k10, k11;
        if (wave < NT) { const bf16* kp = PA + (size_t)(b * T + 64 * wave + rk) * PA_LD + C_IK + 8 * hh;
            k00 = *(const bf16x8*)kp; k01 = *(const bf16x8*)(kp + 16); k10 = *(const bf16x8*)(kp + (size_t)32 * PA_LD); k11 = *(const bf16x8*)(kp + (size_t)32 * PA_LD + 16); }
#pragma unroll 1
        for (int tt = wave; tt < NT; tt += NWAVES) {
            const int s0 = 64 * tt;
            const bf16x8 c00 = k00, c01 = k01, c10 = k10, c11 = k11;
            { const int tn = (tt + NWAVES < NT) ? tt + NWAVES : tt;
              const bf16* kp = PA + (size_t)(b * T + 64 * tn + rk) * PA_LD + C_IK + 8 * hh;
              k00 = *(const bf16x8*)kp; k01 = *(const bf16x8*)(kp + 16); k10 = *(const bf16x8*)(kp + (size_t)32 * PA_LD); k11 = *(const bf16x8*)(kp + (size_t)32 * PA_LD + 16); }
            f32x16 s0a, s1a;
#pragma unroll
            for (int i = 0; i < 16; ++i) { s0a[i] = 0.f; s1a[i] = 0.f; }
            bf16x8 q0 = *(const LAS bf16x8*)qr, q1 = *(const LAS bf16x8*)(qr + 32); unsigned iwb = *(const LAS unsigned short*)(qs + rk * 528 + 512);
#pragma unroll 1
            for (int h = 0; h < 8; ++h) {
                const int hn = (h + 1) & 7;
                const bf16x8 q0n = *(const LAS bf16x8*)(qr + 64 * hn), q1n = *(const LAS bf16x8*)(qr + 64 * hn + 32); const unsigned iwn = *(const LAS unsigned short*)(qs + rk * 528 + 512 + 2 * hn);
                const float iwh = __builtin_bit_cast(float, iwb << 16);
                f32x16 a0, a1;
#pragma unroll
                for (int i = 0; i < 16; ++i) { a0[i] = 0.f; a1[i] = 0.f; }
                a0 = MFMA32(c00, q0, a0); a0 = MFMA32(c01, q1, a0);
                a1 = MFMA32(c10, q0, a1); a1 = MFMA32(c11, q1, a1);
#pragma unroll
                for (int i = 0; i < 16; ++i) { s0a[i] = fmaf(iwh, fmaxf(a0[i], 0.f), s0a[i]); s1a[i] = fmaf(iwh, fmaxf(a1[i], 0.f), s1a[i]); }
                q0 = q0n; q1 = q1n; iwb = iwn;
            }
            float* sp = SC + (size_t)row * 2048 + s0 + 4 * hh;
#pragma unroll
            for (int g = 0; g < 4; ++g) { *(f32x4*)(sp + 8 * g) = (f32x4){s0a[4 * g], s0a[4 * g + 1], s0a[4 * g + 2], s0a[4 * g + 3]}; *(f32x4*)(sp + 32 + 8 * g) = (f32x4){s1a[4 * g], s1a[4 * g + 1], s1a[4 * g + 2], s1a[4 * g + 3]}; }
        }
    }
    __syncthreads();
#define SEL_CNT4(pred, a0_, a1_, a2_, a3_, thr_, acc_) do { unsigned long long m0_, m1_, m2_, m3_; \
        asm("v_cmp_" pred "_u32_e64 %0, %4, %8\n\tv_cmp_" pred "_u32_e64 %1, %5, %8\n\tv_cmp_" pred "_u32_e64 %2, %6, %8\n\tv_cmp_" pred "_u32_e64 %3, %7, %8" \
            : "=&s"(m0_), "=&s"(m1_), "=&s"(m2_), "=&s"(m3_) : "v"(a0_), "v"(a1_), "v"(a2_), "v"(a3_), "v"(thr_)); \
        acc_ += (__popcll(m0_) + __popcll(m1_)) + (__popcll(m2_) + __popcll(m3_)); } while (0)
    float nv[32];
    { const int t0 = 32 * qt + 4 * wave; int ls0 = lane; asm volatile("" : "+v"(ls0));
      if (t0 >= 256) { const float* srow = SC + (size_t)(b * T + t0) * 2048 + ls0; const int ng0 = (t0 >> 6) + 1;
#pragma unroll
          for (int g = 0; g < 4; ++g) if (8 * g < ng0) {
#pragma unroll
              for (int jj = 0; jj < 8; ++jj) nv[8 * g + jj] = srow[64 * (8 * g + jj)]; } } }
#pragma unroll 1
    for (int qi = 0; qi < 4; ++qi) {
        const int t = 32 * qt + 4 * wave + qi, row = b * T + t;
        unsigned long long* mrow = MASK + (size_t)row * 32;
        if (t < 256) {
            if (lane < 32) { const int lo = 64 * lane; unsigned long long m = 0ull; if (t >= lo + 63) m = ~0ull; else if (t >= lo) m = (2ull << (t - lo)) - 1ull; mrow[lane] = m; }
            continue;
        }
        int ls = lane; asm volatile("" : "+v"(ls));
        unsigned keys[32];
#pragma unroll
        for (int j = 0; j < 32; ++j) keys[j] = (64 * j + ls <= t) ? fkey(nv[j]) : 0u;
        if (qi < 3) { const float* srow = SC + (size_t)(row + 1) * 2048 + ls; const int ngn = ((t + 1) >> 6) + 1;
#pragma unroll
            for (int g = 0; g < 4; ++g) if (8 * g < ngn) {
#pragma unroll
                for (int jj = 0; jj < 8; ++jj) nv[8 * g + jj] = srow[64 * (8 * g + jj)]; } }
        unsigned tau = 0u;
#pragma unroll 1
        for (int bit = 31; bit >= 0; --bit) {
            const unsigned cand = tau | (1u << bit); int cnt = 0;
#pragma unroll
            for (int g = 0; g < 8; ++g) SEL_CNT4("ge", keys[4 * g], keys[4 * g + 1], keys[4 * g + 2], keys[4 * g + 3], cand, cnt);
            if (cnt >= 256) tau = cand;
            if (cnt == 256) break;
        }
        int need = 256;
#pragma unroll
        for (int g = 0; g < 8; ++g) { int c_ = 0; SEL_CNT4("gt", keys[4 * g], keys[4 * g + 1], keys[4 * g + 2], keys[4 * g + 3], tau, c_); need -= c_; }
#pragma unroll
        for (int j = 0; j < 32; ++j) {
            unsigned long long eq, gt;
            asm("v_cmp_eq_u32_e64 %0, %2, %3\n\tv_cmp_gt_u32_e64 %1, %2, %3" : "=&s"(eq), "=&s"(gt) : "v"(keys[j]), "v"(tau));
            const int c = __popcll(eq); unsigned long long take;
            if (c <= need) { take = eq; need -= c; } else { take = __ballot((keys[j] == tau) && (mbcnt64(eq) < need)); need = 0; }
            if (lane == 0) mrow[j] = gt | take;
        }
    }
#undef SEL_CNT4
    __syncthreads();
}
constexpr int AT_K0 = 0, AT_K1 = 8192, AT_V0 = 16384, AT_V1 = 24576, AT_RB = 32768, MOBA_RBN = 2048 + 320;
__device__ __forceinline__ void moba_unit(const bf16* PA, const float* biasd, const float* KM, bf16* YB, int b, int h, int n, LAS unsigned char* lds, int tid, int wave, int lane) {
    const int r = lane & 31, hh = lane >> 5;
    const int t = 256 * n + 32 * wave + r, row = b * T + t;
    LAS float* RB = (LAS float*)(lds + AT_RB);
    __syncthreads();
    { int tf = tid; asm volatile("" : "+v"(tf)); float tv[4];
#pragma unroll
      for (int k = 0; k < 4; ++k) tv[k] = biasd[(16 + h) * 2048 + 2047 - (tf + NWAVES * 64 * k)];
#pragma unroll
      for (int k = 0; k < 4; ++k) RB[tf + NWAVES * 64 * k] = tv[k] * LOG2E;
      if (tf + 2048 < MOBA_RBN) RB[tf + 2048] = -INFINITY; }
    bf16x8 qf[4];
    const bf16* qp = PA + (size_t)row * PA_LD + C_QB + h * 64;
#pragma unroll
    for (int st = 0; st < 4; ++st) qf[st] = *(const bf16x8*)(qp + 16 * st + 8 * hh);
    unsigned selmask = (1u << n) - 1u;
    if (n > 3) {
        int z = 0; asm volatile("" : "+v"(z));
        float gv[8];
#pragma unroll
        for (int nn = 0; nn < 8; ++nn) gv[nn] = 0.f;
#pragma unroll 1
        for (int d8 = 0; d8 < 8; ++d8) {
            const v4u qv = *(const v4u*)(qp + 8 * d8);
            const float q0 = bflo(qv.x), q1 = bfhi(qv.x), q2 = bflo(qv.y), q3 = bfhi(qv.y), q4 = bflo(qv.z), q5 = bfhi(qv.z), q6 = bflo(qv.w), q7 = bfhi(qv.w);
#pragma unroll
            for (int nn = 0; nn < 7; ++nn) { const float* kmp = KM + ((b * 8 + nn) * 8 + h) * 64 + 8 * d8 + z; const f32x4 ka = *(const f32x4*)kmp, kb = *(const f32x4*)(kmp + 4);
                gv[nn] += (q0 * ka.x + q1 * ka.y) + (q2 * ka.z + q3 * ka.w) + (q4 * kb.x + q5 * kb.y) + (q6 * kb.z + q7 * kb.w); }
        }
#pragma unroll
        for (int nn = 0; nn < 8; ++nn) if (nn >= n) gv[nn] = -INFINITY;
        selmask = 0u;
#pragma unroll
        for (int rr = 0; rr < 3; ++rr) { int bi = 0; float bv = gv[0];
#pragma unroll
            for (int nn = 1; nn < 8; ++nn) if (gv[nn] > bv) { bv = gv[nn]; bi = nn; }
            selmask |= 1u << bi;
#pragma unroll
            for (int nn = 0; nn < 8; ++nn) if (nn == bi) gv[nn] = -INFINITY; }
    }
    f32x16 o[2];
#pragma unroll
    for (int i = 0; i < 16; ++i) { o[0][i] = 0.f; o[1][i] = 0.f; }
    float m = -INFINITY, l = 0.f;
    const int NT = 4 * (n + 1);
    const int skey = tid >> 3, sc = tid & 7;
    const bf16* Kg = PA + (size_t)(b * T + skey) * PA_LD + C_KB + h * 64 + sc * 8;
    const bf16* Vg = PA + (size_t)(b * T + skey) * PA_LD + C_VB + h * 64 + sc * 8;
    const int kwo = (sc * 64 + skey) * 16, vwo = (sc >> 2) * 4096 + skey * 64 + (sc & 3) * 16;
    v4u kreg = *(const v4u*)Kg, vreg = *(const v4u*)Vg;
    *(LAS v4u*)(lds + AT_K0 + kwo) = kreg; *(LAS v4u*)(lds + AT_V0 + vwo) = vreg;
    __syncthreads();
#pragma unroll 1
    for (int tt = 0; tt < NT; ++tt) {
        const int s0 = 64 * tt, buf = tt & 1;
        if (tt + 1 < NT) { kreg = *(const v4u*)(Kg + (size_t)(s0 + 64) * PA_LD); vreg = *(const v4u*)(Vg + (size_t)(s0 + 64) * PA_LD); }
        const bool own = (tt >> 2) == n;
        if (!own || s0 <= 256 * n + 32 * wave + 31) {
            f32x16 p0, p1;
            qk_tile<64>(lds + (buf ? AT_K1 : AT_K0), qf, p0, p1, r, hh);
            const int dl = t - s0 - 4 * hh;
            const bool selv = own || ((selmask >> (tt >> 2)) & 1u);
            const LAS float* rb = selv ? RB + (2047 - dl) : RB + 2176;
#pragma unroll
            for (int i = 0; i < 16; ++i) { const int c0 = (i & 3) + 8 * (i >> 2); p0[i] = fmaf(p0[i], QK_SCALE2, rb[c0]); p1[i] = fmaf(p1[i], QK_SCALE2, rb[c0 + 32]); }
            const float alpha = softmax_tile(p0, p1, m, l);
            if (__any(alpha != 1.0f)) {
#pragma unroll
                for (int i = 0; i < 16; ++i) { o[0][i] *= alpha; o[1][i] *= alpha; } }
            pv_tile<64>(lds + (buf ? AT_V1 : AT_V0), p0, p1, o, lane);
        }
        if (tt + 1 < NT) { *(LAS v4u*)(lds + (buf ? AT_K0 : AT_K1) + kwo) = kreg; *(LAS v4u*)(lds + (buf ? AT_V0 : AT_V1) + vwo) = vreg; }
        __syncthreads();
    }
    const float inv = 1.0f / xhalf_sum(l);
    unsigned char* yp = (unsigned char*)YB + (size_t)row * 2048 + 1024 + h * 64 + 4 * hh;
#pragma unroll
    for (int db = 0; db < 2; ++db)
#pragma unroll
        for (int g = 0; g < 4; ++g) *(unsigned*)(yp + 32 * db + 8 * g) = pk4f8(o[db][4 * g] * inv, o[db][4 * g + 1] * inv, o[db][4 * g + 2] * inv, o[db][4 * g + 3] * inv);
}
constexpr int SWA_RBN = 260;
__device__ __forceinline__ void swa_unit(const bf16* PA, const float* biasd, const float* sinks, bf16* YA, int b, int kvh, int qb, LAS unsigned char* lds, int tid, int wave, int lane) {
    const int r = lane & 31, hh = lane >> 5, g = wave >> 1, hq = kvh * 4 + g;
    const int t = 64 * qb + 32 * (wave & 1) + r, row = b * T + t;
    LAS float* RBall = (LAS float*)(lds + AT_RB);
    __syncthreads();
    { int tf = tid; asm volatile("" : "+v"(tf)); float tv[3];
#pragma unroll
      for (int k = 0; k < 3; ++k) { const int j = tf + NWAVES * 64 * k; const int jc = j < 4 * SWA_RBN ? j : 0; const int gg = jc / SWA_RBN, jj = jc - gg * SWA_RBN; tv[k] = biasd[(kvh * 4 + gg) * 2048 + ((jj >= 64 && jj < 192) ? 191 - jj : 0)]; }
#pragma unroll
      for (int k = 0; k < 3; ++k) { const int j = tf + NWAVES * 64 * k; if (j < 4 * SWA_RBN) { const int gg = j / SWA_RBN, jj = j - gg * SWA_RBN; RBall[j] = (jj >= 64 && jj < 192) ? tv[k] * LOG2E : -INFINITY; } } }
    const LAS float* RB = RBall + g * SWA_RBN;
    bf16x8 qf[4];
    const bf16* qp = PA + (size_t)row * PA_LD + C_QA + hq * 64;
#pragma unroll
    for (int st = 0; st < 4; ++st) qf[st] = *(const bf16x8*)(qp + 16 * st + 8 * hh);
    f32x16 o[2];
#pragma unroll
    for (int i = 0; i < 16; ++i) { o[0][i] = 0.f; o[1][i] = 0.f; }
    float m = -INFINITY, l = 0.f;
    const int tt0 = qb >= 2 ? qb - 2 : 0;
    const int skey = tid >> 3, sc = tid & 7;
    const bf16* Kg = PA + (size_t)(b * T + skey) * PA_LD + C_KA + kvh * 64 + sc * 8;
    const bf16* Vg = PA + (size_t)(b * T + skey) * PA_LD + C_VA + kvh * 64 + sc * 8;
    const int kwo = (sc * 64 + skey) * 16, vwo = (sc >> 2) * 4096 + skey * 64 + (sc & 3) * 16;
    v4u kreg = *(const v4u*)(Kg + (size_t)(64 * tt0) * PA_LD), vreg = *(const v4u*)(Vg + (size_t)(64 * tt0) * PA_LD);
    *(LAS v4u*)(lds + AT_K0 + kwo) = kreg; *(LAS v4u*)(lds + AT_V0 + vwo) = vreg;
    __syncthreads();
#pragma unroll 1
    for (int tt = tt0; tt <= qb; ++tt) {
        const int s0 = 64 * tt, buf = (tt - tt0) & 1;
        if (tt < qb) { kreg = *(const v4u*)(Kg + (size_t)(s0 + 64) * PA_LD); vreg = *(const v4u*)(Vg + (size_t)(s0 + 64) * PA_LD); }
        {
            f32x16 p0, p1;
            qk_tile<64>(lds + (buf ? AT_K1 : AT_K0), qf, p0, p1, r, hh);
            const int dl = t - s0 - 4 * hh;
            const LAS float* rb = RB + (191 - dl);
#pragma unroll
            for (int i = 0; i < 16; ++i) { const int c0 = (i & 3) + 8 * (i >> 2); p0[i] = fmaf(p0[i], QK_SCALE2, rb[c0]); p1[i] = fmaf(p1[i], QK_SCALE2, rb[c0 + 32]); }
            const float alpha = softmax_tile(p0, p1, m, l);
            if (__any(alpha != 1.0f)) {
#pragma unroll
                for (int i = 0; i < 16; ++i) { o[0][i] *= alpha; o[1][i] *= alpha; } }
            pv_tile<64>(lds + (buf ? AT_V1 : AT_V0), p0, p1, o, lane);
        }
        if (tt < qb) { *(LAS v4u*)(lds + (buf ? AT_K0 : AT_K1) + kwo) = kreg; *(LAS v4u*)(lds + (buf ? AT_V0 : AT_V1) + vwo) = vreg; }
        __syncthreads();
    }
    const float inv = 1.0f / (xhalf_sum(l) + __builtin_amdgcn_exp2f(sinks[hq] * LOG2E - m));
    unsigned char* yp = (unsigned char*)YA + (size_t)row * 2048 + hq * 64 + 4 * hh;
#pragma unroll
    for (int db = 0; db < 2; ++db)
#pragma unroll
        for (int gq = 0; gq < 4; ++gq) *(unsigned*)(yp + 32 * db + 8 * gq) = pk4f8(o[db][4 * gq] * inv, o[db][4 * gq + 1] * inv, o[db][4 * gq + 2] * inv, o[db][4 * gq + 3] * inv);
}
constexpr int DS_K0 = 0, DS_V0 = 16384, DS_K1 = 32768, DS_V1 = 49152, DS_RB = 65536, DS_RBN = 2048 + 128;
static_assert(DS_RB + 8 * DS_RBN * 4 <= LDSCTL_OFF, "DSA LDS map");
__device__ __forceinline__ bf16x8 pack8(const f32x4 a, const f32x4 b) { u32x4v w; w.x = pkbf(a.x, a.y); w.y = pkbf(a.z, a.w); w.z = pkbf(b.x, b.y); w.w = pkbf(b.z, b.w); return __builtin_bit_cast(bf16x8, w); }
__device__ __forceinline__ void dsa_unit(const bf16* CN, const bf16* PA, const unsigned long long* MASK, const float* biasd, const bf16* WUKB, const bf16* WUVT, bf16* YC, int b, int qt, LAS unsigned char* lds, int tid, int wave, int lane) {
    const int r = lane & 31, hh = lane >> 5, h = wave;
    const int t = 32 * qt + r, row = b * T + t;
    __syncthreads();
    static_assert(8 * DS_RBN == 34 * NWAVES * 64, "DSA bias table fill");
    { int tf = tid; asm volatile("" : "+v"(tf));
#pragma unroll 1
      for (int hfill = 0; hfill < 2; ++hfill) { float tv[17];
#pragma unroll
          for (int k = 0; k < 17; ++k) { const int j = tf + NWAVES * 64 * (17 * hfill + k); const int hd = j / DS_RBN, jj = j - hd * DS_RBN; tv[k] = biasd[(24 + hd) * 2048 + (jj < 2048 ? 2047 - jj : 0)]; }
#pragma unroll
          for (int k = 0; k < 17; ++k) { const int j = tf + NWAVES * 64 * (17 * hfill + k); const int hd = j / DS_RBN, jj = j - hd * DS_RBN; ((LAS float*)(lds + DS_RB))[j] = jj < 2048 ? tv[k] * LOG2E : 0.f; } } }
    const LAS float* RB = (const LAS float*)(lds + DS_RB) + h * DS_RBN;
    bf16x8 qa[8];
    { const bf16* qp = PA + (size_t)row * PA_LD + C_QC + h * 64;
      int rq = r; asm volatile("" : "+v"(rq));
      bf16x8 qh[4];
#pragma unroll
      for (int st = 0; st < 4; ++st) qh[st] = *(const bf16x8*)(qp + 16 * st + 8 * hh);
#pragma unroll
      for (int cb = 0; cb < 4; ++cb) { f32x16 acc;
#pragma unroll
          for (int i = 0; i < 16; ++i) acc[i] = 0.f;
#pragma unroll
          for (int st = 0; st < 4; ++st) acc = MFMA32(*(const bf16x8*)(WUKB + ((size_t)h * 128 + 32 * cb + rq) * 64 + 16 * st + 8 * hh), qh[st], acc);
          qa[2 * cb] = pack8((f32x4){acc[0], acc[1], acc[2], acc[3]}, (f32x4){acc[4], acc[5], acc[6], acc[7]});
          qa[2 * cb + 1] = pack8((f32x4){acc[8], acc[9], acc[10], acc[11]}, (f32x4){acc[12], acc[13], acc[14], acc[15]});
          asm volatile("" ::: "memory"); } }
    f32x16 o[4];
#pragma unroll
    for (int db = 0; db < 4; ++db)
#pragma unroll
        for (int i = 0; i < 16; ++i) o[db][i] = 0.f;
    float m = -INFINITY, l = 0.f;
    const int NT = (qt >> 1) + 1;
    const int skey = tid >> 4, sc = tid & 15;
    const bf16* Cg = CN + (size_t)(b * T + skey) * 128 + sc * 8;
    const int kwo = (sc * 64 + skey) * 16, vwo = (sc >> 2) * 4096 + skey * 64 + (sc & 3) * 16;
    v4u c0r = *(const v4u*)Cg, c1r = *(const v4u*)(Cg + 32 * 128);
    *(LAS v4u*)(lds + DS_K0 + kwo) = c0r; *(LAS v4u*)(lds + DS_K0 + kwo + 512) = c1r; *(LAS v4u*)(lds + DS_V0 + vwo) = c0r; *(LAS v4u*)(lds + DS_V0 + vwo + 2048) = c1r;
    const unsigned long long* mrow = MASK + (size_t)row * 32;
    __syncthreads();
#pragma unroll 1
    for (int tt = 0; tt < NT; ++tt) {
        const int s0 = 64 * tt, buf = tt & 1;
        if (tt + 1 < NT) { c0r = *(const v4u*)(Cg + (size_t)(s0 + 64) * 128); c1r = *(const v4u*)(Cg + (size_t)(s0 + 96) * 128); }
        const unsigned long long mw = mrow[tt];
        {
            const LAS unsigned char* Kt = lds + DS_K0 + buf * 32768;
            f32x16 p0, p1;
#pragma unroll
            for (int i = 0; i < 16; ++i) { p0[i] = 0.f; p1[i] = 0.f; }
#pragma unroll
            for (int ks = 0; ks < 8; ++ks) {
                const LAS unsigned char* ka = Kt + ((2 * ks) * 64 + r) * 16 + 8 * hh;
                const s16x4 a0 = *(const LAS s16x4*)ka, a1 = *(const LAS s16x4*)(ka + 1024), b0 = *(const LAS s16x4*)(ka + 512), b1 = *(const LAS s16x4*)(ka + 1024 + 512);
                p0 = MFMA32(((bf16x8){a0[0], a0[1], a0[2], a0[3], a1[0], a1[1], a1[2], a1[3]}), qa[ks], p0);
                p1 = MFMA32(((bf16x8){b0[0], b0[1], b0[2], b0[3], b1[0], b1[1], b1[2], b1[3]}), qa[ks], p1);
                if ((ks & 3) == 3) asm volatile("" ::: "memory");
            }
            const int dl = t - s0 - 4 * hh;
            const LAS float* rb = RB + (2047 - dl);
            const unsigned wlo = (unsigned)mw >> (4 * hh), whi = (unsigned)(mw >> 32) >> (4 * hh);
#pragma unroll
            for (int i = 0; i < 16; ++i) { const int c0 = (i & 3) + 8 * (i >> 2);
                const float v0 = fmaf(p0[i], QK_SCALE2, rb[c0]), v1 = fmaf(p1[i], QK_SCALE2, rb[c0 + 32]);
                p0[i] = ((wlo >> c0) & 1u) ? v0 : -INFINITY; p1[i] = ((whi >> c0) & 1u) ? v1 : -INFINITY;
                if ((i & 3) == 3) asm volatile("" ::: "memory"); }
            const float alpha = softmax_tile(p0, p1, m, l);
            if (__any(alpha != 1.0f)) {
#pragma unroll
            for (int db = 0; db < 4; ++db)
#pragma unroll
                for (int i = 0; i < 16; ++i) o[db][i] *= alpha; }
            pv_tile<128>(lds + DS_V0 + buf * 32768, p0, p1, o, lane);
        }
        if (tt + 1 < NT) { LAS unsigned char* Kn = lds + DS_K0 + (32768 - buf * 32768); LAS unsigned char* Vn = lds + DS_V0 + (32768 - buf * 32768);
            *(LAS v4u*)(Kn + kwo) = c0r; *(LAS v4u*)(Kn + kwo + 512) = c1r; *(LAS v4u*)(Vn + vwo) = c0r; *(LAS v4u*)(Vn + vwo + 2048) = c1r; }
        __syncthreads();
    }
    const float inv = 1.0f / xhalf_sum(l);
    int re = r; asm volatile("" : "+v"(re));
    unsigned char* yp = (unsigned char*)YC + (size_t)(b * T + 32 * qt + re) * 2048 + 1536 + h * 64 + 4 * hh;
#pragma unroll
    for (int db2 = 0; db2 < 2; ++db2) {
        f32x16 acc;
#pragma unroll
        for (int i = 0; i < 16; ++i) acc[i] = 0.f;
#pragma unroll
        for (int ks = 0; ks < 8; ++ks) {
            const int cb = ks >> 1, b0 = 8 * (ks & 1);
            const bf16x8 ob = pack8((f32x4){o[cb][b0] * inv, o[cb][b0 + 1] * inv, o[cb][b0 + 2] * inv, o[cb][b0 + 3] * inv}, (f32x4){o[cb][b0 + 4] * inv, o[cb][b0 + 5] * inv, o[cb][b0 + 6] * inv, o[cb][b0 + 7] * inv});
            const bf16* wp = WUVT + ((size_t)h * 64 + 32 * db2 + re) * 128 + 16 * ks + 4 * hh;
            const s16x4 w0 = *(const s16x4*)wp, w1 = *(const s16x4*)(wp + 8);
            const bf16x8 wf = (bf16x8){w0[0], w0[1], w0[2], w0[3], w1[0], w1[1], w1[2], w1[3]};
            acc = MFMA32(wf, ob, acc);
            if (ks & 1) asm volatile("" ::: "memory");
        }
#pragma unroll
        for (int g = 0; g < 4; ++g) *(unsigned*)(yp + 32 * db2 + 8 * g) = pk4f8(acc[4 * g], acc[4 * g + 1], acc[4 * g + 2], acc[4 * g + 3]);
    }
}
#ifndef NREP_ROUTE
#define NREP_ROUTE 1
#endif
constexpr int PU_RI = 0, PU_RG = 16384, PU_RSTD = 32768, PU_TOP = 33024, PU_EX = PU_TOP + 8 * 8192, PU_END = PU_EX + 8 * 4096;
static_assert(PU_END <= LDSCTL_OFF, "PEER unit LDS map");
#define CE_DESC(a, b) do { const unsigned hi_ = (a) > (b) ? (a) : (b); (b) = (a) > (b) ? (b) : (a); (a) = hi_; } while (0)
template <int B, typename A> __device__ __forceinline__ void sort16_desc(A& v) {
#pragma unroll
    for (int ks = 1; ks <= 4; ++ks)
#pragma unroll
        for (int js = ks - 1; js >= 0; --js)
#pragma unroll
            for (int i = 0; i < 16; ++i) { const int k = 1 << ks, j = 1 << js, l = i ^ j; if (l > i) { if ((i & k) == 0) CE_DESC(v[B + i], v[B + l]); else CE_DESC(v[B + l], v[B + i]); } }
}
template <int B0, int B1, typename A> __device__ __forceinline__ void merge16_desc(A& v) {
#pragma unroll
    for (int i = 0; i < 16; ++i) v[B0 + i] = v[B0 + i] > v[B1 + 15 - i] ? v[B0 + i] : v[B1 + 15 - i];
#pragma unroll
    for (int js = 3; js >= 0; --js)
#pragma unroll
        for (int i = 0; i < 16; ++i) { const int j = 1 << js, l = i ^ j; if (l > i) CE_DESC(v[B0 + i], v[B0 + l]); }
}
template <typename A> __device__ __forceinline__ void top16_of_64(A& v) {
    sort16_desc<0>(v); sort16_desc<16>(v); merge16_desc<0, 16>(v);
    sort16_desc<32>(v); sort16_desc<48>(v); merge16_desc<32, 48>(v);
    merge16_desc<0, 32>(v);
}
__device__ __forceinline__ void peer_route(const Ptrs& P, int l, int unit, LAS unsigned char* lds, int tid, int wave, int lane) {
    unsigned char* ws = P.ws;
    float* RSTD = (float*)(ws + WS_RSTD) + unit * 32; int* RI = (int*)(ws + WS_RI) + (size_t)unit * 32 * 128; float* RG = (float*)(ws + WS_RG) + (size_t)unit * 32 * 128;
    const bf16* QP = (const bf16*)(ws + WS_QP);
    const int r0 = unit * 32;
    const float* rowssB = (const float*)(ws + WS_ROWSSB);
    __syncthreads();
#pragma unroll 1
    for (int rrep = 0; rrep < NREP_ROUTE; ++rrep)
    {
        const int r = lane & 31, hh = lane >> 5, h = wave;
        const bf16* SKB = (const bf16*)(ws + WS_SKB) + (size_t)(l * 8 + h) * 2 * 16384;
        float rs; { const float* pp = rowssB + (size_t)(r0 + r) * 32; float a = 0.f;
#pragma unroll
            for (int j = 0; j < 8; ++j) { const f32x4 v = *(const f32x4*)(pp + 4 * j); a += (v.x + v.y) + (v.z + v.w); }
            rs = rsqrtf(a * (1.0f / 2048.0f) + EPS); }
        if (hh == 0 && h == 0) RSTD[r] = rs;
        LAS float* EXL = (LAS float*)(lds + PU_EX) + wave * 1024;
        LAS unsigned* TOPL = (LAS unsigned*)(lds + PU_TOP) + wave * 2048;
#pragma unroll 1
        for (int p = 0; p < 2; ++p) {
            bf16x8 qf[8];
            { int rq = r; asm volatile("" : "+v"(rq)); const bf16* qr2 = QP + (size_t)(r0 + rq) * 2048 + h * 256 + p * 128 + 8 * hh;
#pragma unroll
            for (int st = 0; st < 8; ++st) qf[st] = *(const bf16x8*)(qr2 + 16 * st); }
            unsigned kv[64];
            int rk = r; asm volatile("" : "+v"(rk));
            const bf16* skp = SKB + ((size_t)p * 128 + rk) * 128 + 8 * hh;
            bf16x8 sf[8];
#pragma unroll
            for (int st = 0; st < 8; ++st) sf[st] = *(const bf16x8*)(skp + 16 * st);
#pragma unroll
            for (int kb = 0; kb < 4; ++kb) {
                f32x16 acc;
#pragma unroll
                for (int i = 0; i < 16; ++i) acc[i] = 0.f;
                bf16x8 cf[8];
#pragma unroll
                for (int st = 0; st < 8; ++st) cf[st] = sf[st];
                if (kb < 3) {
#pragma unroll
                    for (int st = 0; st < 8; ++st) sf[st] = *(const bf16x8*)(skp + (size_t)(32 * (kb + 1)) * 128 + 16 * st); }
#pragma unroll
                for (int st = 0; st < 8; ++st) acc = MFMA32(cf[st], qf[st], acc);
#pragma unroll
                for (int i = 0; i < 16; ++i) kv[16 * kb + i] = (fkey(acc[i]) & ~127u) | (unsigned)(127 - (32 * kb + (i & 3) + 8 * (i >> 2) + 4 * hh));
                asm volatile("" ::: "memory");
            }
            top16_of_64(kv);
#pragma unroll
            for (int i = 0; i < 16; ++i) { const unsigned own = kv[i]; auto rr = __builtin_amdgcn_permlane32_swap(own, own, false, false); kv[16 + i] = (rr[0] == own) ? rr[1] : rr[0]; }
            merge16_desc<0, 16>(kv);
#pragma unroll
            for (int it = 0; it < 16; ++it) TOPL[(p * 16 + it) * 64 + lane] = kv[it];
        }
        LDS_WAIT(); asm volatile("" ::: "memory");
        unsigned ck[64];
        { float sa[16], sb[16];
#pragma unroll
          for (int j = 0; j < 16; ++j) { sa[j] = funkey(TOPL[j * 64 + lane] & ~127u); sb[j] = funkey(TOPL[(16 + j) * 64 + lane] & ~127u); }
          int pi = 0;
#pragma unroll
          for (int a = 0; a < 16; ++a)
#pragma unroll
              for (int bq = 0; bq < 16; ++bq) if ((a + 1) * (bq + 1) <= 16) { ck[pi] = (fkey(sa[a] + sb[bq]) & ~255u) | (unsigned)(255 - (a * 16 + bq)); ++pi; }
#pragma unroll
          for (int i = 50; i < 64; ++i) ck[i] = 0u; }
        top16_of_64(ck);
        float mx = 0.f, sm = 0.f;
#pragma unroll
        for (int it = 0; it < 16; ++it) {
            const unsigned m = ck[it];
            const int ab = 255 - (int)(m & 255u), a = ab >> 4, bq = ab & 15;
            const unsigned ka = TOPL[a * 64 + lane], kb2 = TOPL[(16 + bq) * 64 + lane];
            const float sc = funkey(m & ~255u) * rs;
            if (it == 0) mx = sc;
            const float e = __expf(sc - mx); sm += e;
            EXL[it * 64 + lane] = e;
            if (hh == 0) RI[r * 128 + h * 16 + it] = (127 - (int)(ka & 127u)) * 128 + (127 - (int)(kb2 & 127u));
        }
        LDS_WAIT(); asm volatile("" ::: "memory");
        const float inv = 1.0f / sm;
        if (hh == 0) {
#pragma unroll
            for (int it = 0; it < 16; ++it) RG[r * 128 + h * 16 + it] = EXL[it * 64 + lane] * inv;
        }
        LDS_WAIT(); asm volatile("" ::: "memory");
    }
}

#define PU_ISSUE(dst, eis, r0_) do { _Pragma("unroll") for (int rd = 0; rd < 4; ++rd) { const v4u* up = (const v4u*)(U6s + ((unsigned)eis[(r0_) + rd] * 192u + 16u * (unsigned)piece)); dst[rd][0] = up[0]; dst[rd][1] = up[4]; dst[rd][2] = up[8]; } } while (0)
#define PU_COMP(src, r0_) do { _Pragma("unroll") for (int rd = 0; rd < 4; ++rd) { \
        const v4u r0 = src[rd][0], r1 = src[rd][1], r2 = src[rd][2]; \
        const v6i_t ca = {(int)r0.x, (int)r0.y, (int)r0.z, (int)r0.w, (int)r1.x, (int)r1.y}, cb = {(int)r1.z, (int)r1.w, (int)r2.x, (int)r2.y, (int)r2.z, (int)r2.w}; \
        const v16u_t ua = __builtin_bit_cast(v16u_t, __builtin_amdgcn_cvt_scalef32_pk32_bf16_fp6(ca, 1.0f)), ub = __builtin_bit_cast(v16u_t, __builtin_amdgcn_cvt_scalef32_pk32_bf16_fp6(cb, 1.0f)); \
        float a0 = 0.f, a1 = 0.f, a2 = 0.f, a3 = 0.f; \
        _Pragma("unroll") for (int k = 0; k < 8; ++k) { a0 = dot2(ua[2 * k], xq[k].x, a0); a1 = dot2(ua[2 * k + 1], xq[k].y, a1); a2 = dot2(ub[2 * k], xq[k].z, a2); a3 = dot2(ub[2 * k + 1], xq[k].w, a3); } \
        float d = (a0 + a1) + (a2 + a3); d += lane_xor<1>(d); d += lane_xor<2>(d); \
        dd[(r0_) + rd] = d; } } while (0)
#define PU_SB() do { asm volatile("" ::: "memory"); __builtin_amdgcn_sched_barrier(0); } while (0)
__device__ __forceinline__ void peer_u_pass(const Ptrs& P, int l, int G, int vbx, int wave, int lane) {
    unsigned char* ws = P.ws;
    const int xs = vbx & 7, wr = vbx >> 3, nW = G >> 3;
    const int* RI = (const int*)(ws + WS_RI); float* PD = (float*)(ws + WS_PD); const bf16* XB = (const bf16*)(ws + WS_XB);
    const int slot = lane >> 2, piece = lane & 3;
    const int tstep = nW * NWAVES;
    const unsigned char* U6s = ws + WS_U + (size_t)l * TBL_LAYER + (size_t)xs * TBL_SLICE;
    int t = wr * NWAVES + wave;
    v4u xq[8], rowsA[4][3], rowsB[4][3]; int ein[8];
    { int e0[8]; const int* ri = RI + (size_t)t * 128 + slot;
#pragma unroll
      for (int rd = 0; rd < 8; ++rd) e0[rd] = ri[16 * rd];
      const int t1 = (t + tstep < M) ? t + tstep : t; const int* rn = RI + (size_t)t1 * 128 + slot; const bf16* xr = XB + (size_t)t * 2048 + 256 * xs + 8 * piece;
#pragma unroll
      for (int rd = 0; rd < 8; ++rd) ein[rd] = rn[16 * rd];
#pragma unroll
      for (int k = 0; k < 8; ++k) xq[k] = *(const v4u*)(xr + 32 * k);
      PU_SB();
      PU_ISSUE(rowsA, e0, 0); PU_ISSUE(rowsB, e0, 4); PU_SB(); }
#pragma unroll 1
    for (; t < M; t += tstep) {
        const int t1 = (t + tstep < M) ? t + tstep : t, t2 = (t + 2 * tstep < M) ? t + 2 * tstep : t1;
        v4u xn[8]; int ei2[8];
        { const int* ri = RI + (size_t)t2 * 128 + slot; const bf16* xr = XB + (size_t)t1 * 2048 + 256 * xs + 8 * piece;
#pragma unroll
          for (int rd = 0; rd < 8; ++rd) ei2[rd] = ri[16 * rd];
#pragma unroll
          for (int k = 0; k < 8; ++k) xn[k] = *(const v4u*)(xr + 32 * k); }
        float* pd = PD + ((size_t)xs * M + t) * 128 + slot;
        float dd[8];
        PU_SB(); PU_COMP(rowsA, 0); PU_SB();
        PU_ISSUE(rowsA, ein, 0); PU_SB();
        PU_COMP(rowsB, 4); PU_SB();
        PU_ISSUE(rowsB, ein, 4); PU_SB();
        if (piece == 0) {
#pragma unroll
            for (int rd = 0; rd < 8; ++rd) pd[16 * rd] = dd[rd]; }
#pragma unroll
        for (int k = 0; k < 8; ++k) xq[k] = xn[k];
#pragma unroll
        for (int rd = 0; rd < 8; ++rd) ein[rd] = ei2[rd];
    }
}
#undef PU_ISSUE
#undef PU_COMP
#undef PU_SB
__device__ __forceinline__ void peer_combine(const Ptrs& P, int l, int gw, int NGW, int lane) {
    unsigned char* ws = P.ws;
    const int* RI = (const int*)(ws + WS_RI); const float* RG = (const float*)(ws + WS_RG); const float* PD = (const float*)(ws + WS_PD); unsigned* W = (unsigned*)(ws + WS_W);
    const f32x2v* SCL = (const f32x2v*)(ws + WS_USC) + l * 16384; const float* RSTD = (const float*)(ws + WS_RSTD);
    float pd[2][8], rg[2], rstd; int ei[2];
    int z = 0; asm volatile("" : "+v"(z));
#define PC_LOAD(t_) do { rstd = RSTD[(t_) + z]; _Pragma("unroll") for (int hf = 0; hf < 2; ++hf) { const int k = lane + 64 * hf; \
        _Pragma("unroll") for (int sl = 0; sl < 8; ++sl) pd[hf][sl] = PD[((size_t)sl * M + (t_)) * 128 + k]; \
        ei[hf] = RI[(size_t)(t_) * 128 + k]; rg[hf] = RG[(size_t)(t_) * 128 + k]; } } while (0)
    if (gw < M) PC_LOAD(gw);
#pragma unroll 1
    for (int t = gw; t < M; t += NGW) {
        const float rs = rstd; const int e0 = ei[0], e1 = ei[1]; const float g0 = rg[0], g1 = rg[1];
        float a0 = 0.f, a1 = 0.f;
#pragma unroll
        for (int sl = 0; sl < 8; ++sl) { a0 += pd[0][sl]; a1 += pd[1][sl]; }
        const f32x2v s0 = SCL[e0], s1 = SCL[e1];
        { const int tn = (t + NGW < M) ? t + NGW : t; PC_LOAD(tn); }
        const float w0 = g0 * gelu_tanh(a0 * s0.x * rs) * s0.y, w1 = g1 * gelu_tanh(a1 * s1.x * rs) * s1.y;
        W[(size_t)t * 128 + lane] = (pk2(w0, 0.f) << 16) | (unsigned)e0; W[(size_t)t * 128 + lane + 64] = (pk2(w1, 0.f) << 16) | (unsigned)e1;
    }
#undef PC_LOAD
}
#define PV_LOAD(dst, k0) do { const v4u eq0_ = *(const LAS v4u*)(ELb + qd * 128 + (k0)), eq1_ = *(const LAS v4u*)(ELb + qd * 128 + (k0) + 4); \
    _Pragma("unroll") for (int kk = 0; kk < 8; ++kk) { const unsigned ei_ = (kk < 4 ? eq0_[kk & 3] : eq1_[kk & 3]) & 0xffffu; const unsigned char* rp_ = V6s + (ei_ * 192u + c8o); \
        dst[kk][0] = *(const u32x2v*)rp_; dst[kk][1] = *(const u32x2v*)(rp_ + 64); dst[kk][2] = *(const u32x2v*)(rp_ + 128); } } while (0)
#define PV_FMA(src, k0) do { const v4u wq0_ = *(const LAS v4u*)(ELb + qd * 128 + (k0)), wq1_ = *(const LAS v4u*)(ELb + qd * 128 + (k0) + 4); \
    _Pragma("unroll") for (int kk = 0; kk < 8; ++kk) { const float w_ = __builtin_bit_cast(float, (kk < 4 ? wq0_[kk & 3] : wq1_[kk & 3]) & 0xffff0000u); const f32x2v wk_ = (f32x2v){w_, w_}; \
        const v6i_t c_ = {(int)src[kk][0].x, (int)src[kk][0].y, (int)src[kk][1].x, (int)src[kk][1].y, (int)src[kk][2].x, (int)src[kk][2].y}; \
        const v32f_t d_ = __builtin_amdgcn_cvt_scalef32_pk32_f32_fp6(c_, 1.0f); \
        _Pragma("unroll") for (int i_ = 0; i_ < 16; ++i_) o[i_] = (f32x2v){d_[2 * i_], d_[2 * i_ + 1]} * wk_ + o[i_]; \
        __builtin_amdgcn_sched_barrier(0); } } while (0)
__device__ __forceinline__ void peer_v_pass(const Ptrs& P, int l, int G, int vbx, LAS unsigned char* lds, int wave, int lane) {
    unsigned char* ws = P.ws;
    const int xs = vbx & 7, wr = vbx >> 3, nW = G >> 3;
    const unsigned* W = (const unsigned*)(ws + WS_W);
    bf16* XB = (bf16*)(ws + WS_XB); float* RS = (float*)(ws + WS_RS);
    const int gstep = nW * NWAVES;
    const unsigned char* V6s = ws + WS_V + (size_t)l * TBL_LAYER + (size_t)xs * TBL_SLICE;
    int tg = wr * NWAVES + wave, par = 0;
    { LAS unsigned* EL0 = (LAS unsigned*)(lds + wave * 8192);
      const unsigned* wp = W + (size_t)(8 * tg) * 128;
      int ln0 = lane; asm volatile("" : "+v"(ln0));
#pragma unroll
      for (int j = 0; j < 16; ++j) EL0[ln0 + 64 * j] = wp[ln0 + 64 * j]; }
    LDS_WAIT(); asm volatile("" ::: "memory");
#pragma unroll 1
    for (; tg < M / 8; tg += gstep, par ^= 1) {
        const LAS unsigned* ELb = (const LAS unsigned*)(lds + wave * 8192 + par * 4096);
        int ln = lane; asm volatile("" : "+v"(ln));
        const int qd = ln >> 3, b8 = ln & 7;
        const unsigned c8o = 8u * (unsigned)b8;
        const int t = 8 * tg + qd;
        u32x2v vA[8][3], vB[8][3];
        PV_LOAD(vA, 0);
        unsigned nel[16];
        { const int tgn = (tg + gstep < M / 8) ? tg + gstep : tg;
          const unsigned* wp = W + (size_t)(8 * tgn) * 128;
#pragma unroll
          for (int j = 0; j < 16; ++j) nel[j] = wp[ln + 64 * j]; }
        const size_t col0 = (size_t)t * 2048 + 256 * xs + 4 * b8;
        u32x2v xres[8];
#pragma unroll
        for (int k = 0; k < 8; ++k) xres[k] = *(const u32x2v*)(XB + col0 + 32 * k);
        f32x2v o[16];
#pragma unroll
        for (int i = 0; i < 16; ++i) o[i] = (f32x2v){0.f, 0.f};
#define PV_SB() do { asm volatile("" ::: "memory"); __builtin_amdgcn_sched_barrier(0); } while (0)
        PV_SB(); PV_LOAD(vB, 8); PV_FMA(vA, 0); PV_SB();
        PV_LOAD(vA, 16); PV_FMA(vB, 8); PV_SB();
        PV_LOAD(vB, 24); PV_FMA(vA, 16); PV_SB();
        PV_LOAD(vA, 32); PV_FMA(vB, 24); PV_SB();
        PV_LOAD(vB, 40); PV_FMA(vA, 32); PV_SB();
        PV_LOAD(vA, 48); PV_FMA(vB, 40); PV_SB();
        PV_LOAD(vB, 56); PV_FMA(vA, 48); PV_SB();
        PV_LOAD(vA, 64); PV_FMA(vB, 56); PV_SB();
        PV_LOAD(vB, 72); PV_FMA(vA, 64); PV_SB();
        PV_LOAD(vA, 80); PV_FMA(vB, 72); PV_SB();
        PV_LOAD(vB, 88); PV_FMA(vA, 80); PV_SB();
        PV_LOAD(vA, 96); PV_FMA(vB, 88); PV_SB();
        PV_LOAD(vB, 104); PV_FMA(vA, 96); PV_SB();
        PV_LOAD(vA, 112); PV_FMA(vB, 104); PV_SB();
        PV_LOAD(vB, 120); PV_FMA(vA, 112); PV_SB();
        PV_FMA(vB, 120); PV_SB();
#undef PV_SB
        { LAS unsigned* ELn = (LAS unsigned*)(lds + wave * 8192 + (par ^ 1) * 4096);
#pragma unroll
          for (int j = 0; j < 16; ++j) ELn[ln + 64 * j] = nel[j]; }
        LDS_WAIT(); asm volatile("" ::: "memory");
        float ss = 0.f;
#pragma unroll
        for (int k = 0; k < 8; ++k) {
            const u32x2v xa = xres[k];
            const f32x4 na = (f32x4){bflo(xa.x) + o[2 * k].x, bfhi(xa.x) + o[2 * k].y, bflo(xa.y) + o[2 * k + 1].x, bfhi(xa.y) + o[2 * k + 1].y};
            u32x2v pk; pk.x = pk2(na.x, na.y); pk.y = pk2(na.z, na.w); *(u32x2v*)(XB + col0 + 32 * k) = pk;
            int w0 = __builtin_amdgcn_cvt_pk_fp8_f32(na.x, na.y, 0, false); w0 = __builtin_amdgcn_cvt_pk_fp8_f32(na.z, na.w, w0, true);
            *(unsigned*)(ws + WS_XB8 + col0 + 32 * k) = (unsigned)w0;
            ss += (na.x * na.x + na.y * na.y) + (na.z * na.z + na.w * na.w); }
        ss += lane_xor<1>(ss); ss += lane_xor<2>(ss); ss += lane_xor<4>(ss);
        if (b8 == 0) RS[t * 16 + xs] = ss;
    }
}
#undef PV_LOAD
#undef PV_FMA
__device__ __forceinline__ void final_norm(const Ptrs& P, int gw, int NGW, int lane) {
    const float* RS = (const float*)(P.ws + WS_RS);
#pragma unroll 1
    for (int t = gw; t < M; t += NGW) {
        const float pv = lane < 16 ? RS[t * 16 + lane] : 0.f;
        const float rf = rsqrtf(wave_sum(pv) * (1.0f / 2048.0f) + EPS);
        const bf16* xr = (const bf16*)(P.ws + WS_XB) + (size_t)t * 2048; float* orow = P.out + (size_t)t * 2048;
#pragma unroll
        for (int i = 0; i < 4; ++i) { const int e0 = 8 * (lane + 64 * i); const v4u v = *(const v4u*)(xr + e0); const f32x4 g0 = *(const f32x4*)(P.g_final + e0), g1 = *(const f32x4*)(P.g_final + e0 + 4);
            *(f32x4*)(orow + e0) = (f32x4){bflo(v.x) * rf * g0.x, bfhi(v.x) * rf * g0.y, bflo(v.y) * rf * g0.z, bfhi(v.y) * rf * g0.w};
            *(f32x4*)(orow + e0 + 4) = (f32x4){bflo(v.z) * rf * g1.x, bfhi(v.z) * rf * g1.y, bflo(v.w) * rf * g1.z, bfhi(v.w) * rf * g1.w}; }
    }
}
#ifndef MK_PER_PHASE
#define MK_PER_PHASE 0
#endif
struct Args { const float* in[18]; float* out; unsigned char* ws; int ph_lo, ph_hi; };
__global__ void __launch_bounds__(NWAVES * 64, 2) mega_fwd(Args args) {
    extern __shared__ __attribute__((aligned(16))) unsigned char lds_raw[];
    LAS unsigned char* lds = (LAS unsigned char*)lds_raw;
    const int tid0 = threadIdx.x, wave = __builtin_amdgcn_readfirstlane(tid0 >> 6);
    const int G = gridDim.x, bx = blockIdx.x; const int vcu0 = (G % 8 == 0) ? (bx % 8) * (G / 8) + bx / 8 : bx;
    const int gw0 = vcu0 * NWAVES + wave, NGW = G * NWAVES;
    Ptrs P;
    P.x = args.in[0]; P.rel_bias = args.in[1]; P.g_mix = args.in[2]; P.w_in = args.in[3]; P.a_sinks = args.in[4]; P.c_gain = args.in[5]; P.w_uk = args.in[6]; P.w_uv = args.in[7];
    P.w_a = args.in[8]; P.w_b = args.in[9]; P.w_c = args.in[10]; P.w_out = args.in[11]; P.g_ffn = args.in[12]; P.w_q = args.in[13]; P.sub_keys = args.in[14]; P.peer_u = args.in[15]; P.peer_v = args.in[16]; P.g_final = args.in[17];
    P.out = args.out; P.ws = args.ws;
    unsigned char* ws = args.ws;
    gu32* ctl = (gu32*)(ws + WS_CTL);
    for (int u = tid0; u < (LDS_BYTES - LDSCTL_OFF) / 4; u += NWAVES * 64) ((LAS unsigned*)(lds + LDSCTL_OFF))[u] = 0u;
    __syncthreads();
    volatile LAS unsigned* MISC = (volatile LAS unsigned*)(lds + MISC_OFF);
    XcdBarrier bar; bar.bar = (unsigned*)(ctl + CW_BAR); bar.x = 0; bar.st = nullptr;
    if (!MK_PER_PHASE) bar = xcd_barrier_post((unsigned*)(ctl + CW_BAR), MISC + 8);
    const int lo = args.ph_lo, hi = args.ph_hi;
#ifndef PH_MASK
#define PH_MASK 0xffff
#endif
#define IN(k) (lo <= (k) && (k) < hi)
#define EN(j) ((PH_MASK >> (j)) & 1)
#ifndef REP_MASK
#define REP_MASK 0
#endif
#define NREP(j) (((REP_MASK >> (j)) & 1) ? 2 : 1)
#define SEAM(k) do { if (IN(k) && IN((k) + 1)) xcd_barrier(bar); } while (0)
    bf16* XB = (bf16*)(ws + WS_XB); bf16* PA = (bf16*)(ws + WS_PA); bf16* GT = (bf16*)(ws + WS_GT); bf16* MG = (bf16*)(ws + WS_MG); bf16* QP = (bf16*)(ws + WS_QP);
    bf16* YA = (bf16*)(ws + WS_YA); bf16* YB = YA; bf16* YC = YA; bf16* CN = (bf16*)(ws + WS_CN);
    unsigned long long* MASK = (unsigned long long*)(ws + WS_MASK);
    float* rowssA = (float*)(ws + WS_RS); const float* biasd = (const float*)(ws + WS_BIASD);
    LAS unsigned char* wscr = lds + wave * 16384;

#define FRESH() int lane = lane_id_(); asm volatile("" : "+v"(lane)); int tid = wave * 64 + lane; (void)tid
    if (EN(0) && IN(0)) { FRESH(); for (int rep = 0; rep < NREP(0); ++rep) p0_prologue(P, lds, gw0, NGW, wave, lane); }
    SEAM(0);
    const bool loc = !MK_PER_PHASE && (G == 256) && (MISC[10] == 1u);
    const int X = __builtin_amdgcn_readfirstlane(loc ? (int)bar.x : (bx & 7)), J = __builtin_amdgcn_readfirstlane(loc ? (int)MISC[11] : (bx >> 3));
    const int vbx = (G == 256) ? J * 8 + X : bx;
    const int vcu = (G == 256) ? X * 32 + J : vcu0;
    const int gw = vcu * NWAVES + wave;
#define SEAML(k) do { if (IN(k) && IN((k) + 1)) { if (loc) xcd_barrier_local(bar); else xcd_barrier(bar); } } while (0)
#pragma unroll 1
    for (int l = 0; l < DEPTH; ++l) {
        const int pb = 1 + 10 * l;
        float* KM = (float*)(ws + WS_KMEAN) + (size_t)l * 32768;
        float* rowssB = (float*)(ws + WS_ROWSSB);
        if (EN(1) && IN(pb + 0)) {
#pragma unroll 1
            for (int rep = 0; rep < NREP(1); ++rep) {
            { pg8::Gemm g{XB, (const bf16*)(ws + WS_WIN) + (size_t)l * NPROJ * 2048, M, 4096, 2048}; pg8::SplitOrder S; S.init(G, vbx, true);
              pg8::EpiProj E{PA, KM, rowssA};
              pg8::gemm_phase<pg8::EpiProj, pg8::SplitOrder, true, true>(lds, g, S, E, wave); }
            { pg8::Gemm g{(const bf16*)(ws + WS_XB8), (const bf16*)(ws + WS_WG8 + (size_t)l * NPROJ * 2048), M, NPROJ, 2048}; pg8::SplitOrder S; S.init(G, vbx, false);
              pg8::EpiIn8 E{PA, (unsigned char*)GT, rowssA};
              pg8::gemm_phase<pg8::EpiIn8, pg8::SplitOrder, true, true, true>(lds, g, S, E, wave); }
            }
        }
        SEAML(pb + 0);
        if (EN(2) && IN(pb + 1)) { FRESH();
#pragma unroll 1
            for (int rep = 0; rep < NREP(2); ++rep)
#pragma unroll 1
            for (int u = vcu; u < 512; u += G) {
                const int bb = (u & 255) >> 5, ii = u & 31, qt = (u < 256) ? ii : 63 - ii;
                sel_unit(PA, (float*)(ws + WS_SC), MASK, bb, qt, lds, tid, wave, lane);
            }
            if (G == 256) { for (int k = 0; k < 2; ++k) cn_item(PA, P.c_gain + l * 128, CN, X * 512 + J * 8 + wave + 256 * k, lane); }
            else for (int i = gw; i < M / 4; i += NGW) cn_item(PA, P.c_gain + l * 128, CN, i, lane);
#pragma unroll 1
            for (int rep = 0; rep < NREP(3); ++rep)
#pragma unroll 1
            for (int u = vcu, k = 0; u < 1024; u += G, ++k) { if (G == 256) swa_unit(PA, biasd, P.a_sinks + l * 16, YA, X, k, J, lds, tid, wave, lane);
                else swa_unit(PA, biasd, P.a_sinks + l * 16, YA, u >> 7, (u >> 5) & 3, u & 31, lds, tid, wave, lane); }
            __syncthreads();
        }
        SEAML(pb + 1);
        if (EN(3) && IN(pb + 2)) { FRESH();
#pragma unroll 1
            for (int rep = 0; rep < NREP(4); ++rep)
#pragma unroll 1
            for (int u = vcu; u < 512; u += G) {
                const int bb = (u & 255) >> 5, ii = u & 31, qt = (u < 256) ? ii : 63 - ii;
                dsa_unit(CN, PA, MASK, biasd, (const bf16*)(ws + WS_WUKB) + (size_t)l * 65536, (const bf16*)(ws + WS_WUVT) + (size_t)l * 65536, YC, bb, qt, lds, tid, wave, lane);
            }
            __syncthreads();
#pragma unroll 1
            for (int rep = 0; rep < NREP(5); ++rep)
#pragma unroll 1
            for (int u = vcu; u < 512; u += G) {
                const int bh = (u & 255) >> 2, pr = u & 3, nblk = (u < 256) ? pr : 7 - pr;
                moba_unit(PA, biasd, KM, YB, bh >> 3, bh & 7, nblk, lds, tid, wave, lane);
            }
            __syncthreads();
        }
        SEAML(pb + 2);
        if (EN(4) && IN(pb + 3)) {
            pg8::StaticOrder S; S.init(M, 2048, G, vbx);
            pg8::Gemm g{YA, (const bf16*)(ws + WS_WA + (size_t)l * 2048 * 2048), M, 2048, 2048}; pg8::EpiGate3 E{(unsigned char*)MG, (const unsigned char*)GT};
#pragma unroll 1
            for (int rep = 0; rep < NREP(6); ++rep) pg8::gemm_phase<pg8::EpiGate3, pg8::StaticOrder, true, true, true>(lds, g, S, E, wave);
        }
        SEAML(pb + 3);
        if (EN(5) && IN(pb + 4)) {
            pg8::Gemm g{MG, (const bf16*)(ws + WS_WOUT + (size_t)l * 2048 * 2048), M, 2048, 2048}; pg8::StaticOrder S; S.init(M, 2048, G, vbx);
            pg8::EpiResid E{XB, rowssB, 0.000244140625f};
            pg8::gemm_phase<pg8::EpiResid, pg8::StaticOrder, true, true, true>(lds, g, S, E, wave);
        }
        SEAML(pb + 4);
        if (EN(6) && IN(pb + 5)) {
            pg8::Gemm g{XB, (const bf16*)(ws + WS_WQ) + (size_t)l * 2048 * 2048, M, 2048, 2048}; pg8::StaticOrder S; S.init(M, 2048, G, vbx);
            pg8::EpiQ E{QP};
#pragma unroll 1
            for (int rep = 0; rep < NREP(7); ++rep) pg8::gemm_phase<pg8::EpiQ, pg8::StaticOrder, true, true>(lds, g, S, E, wave);
        }
        SEAML(pb + 5);
        if (EN(7) && IN(pb + 6)) { FRESH();
            for (int u = vcu, k = 0; u < M / 32; u += G, ++k) peer_route(P, l, (G == 256) ? X * 64 + J + 32 * k : u, lds, tid, wave, lane);
        }
        SEAM(pb + 6);
        if (EN(8) && IN(pb + 7)) { FRESH(); peer_u_pass(P, l, G, vbx, wave, lane); }
        SEAM(pb + 7);
        if (EN(9) && IN(pb + 8)) { FRESH(); peer_combine(P, l, gw, NGW, lane); }
        SEAM(pb + 8);
        if (EN(10) && IN(pb + 9)) { FRESH(); peer_v_pass(P, l, G, vbx, lds, wave, lane); }
        SEAM(pb + 9);
    }
    if (IN(21)) { FRESH(); final_norm(P, gw, NGW, lane); }
#undef IN
#undef SEAM
}

extern "C" void kernel_launch(void* const* d_in, const int* in_sizes, int n_in, void* d_out, int out_size, void* d_ws, size_t ws_size, hipStream_t stream) {
    static int grid = 0;
    if (grid == 0) {
        if (n_in != 18 || out_size != M * D || ws_size < WS_END) { fprintf(stderr, "kernel_launch: unexpected problem (n_in %d, out %d, ws %zu); nothing launched\n", n_in, out_size, ws_size); grid = -1; return; }
        int dev = 0, cus = 0, per_cu = 0;
        if (hipGetDevice(&dev) != hipSuccess || hipDeviceGetAttribute(&cus, hipDeviceAttributeMultiprocessorCount, dev) != hipSuccess) { grid = -1; return; }
        if (hipFuncSetAttribute((const void*)mega_fwd, hipFuncAttributeMaxDynamicSharedMemorySize, LDS_BYTES) != hipSuccess) { fprintf(stderr, "kernel_launch: hipFuncSetAttribute failed\n"); grid = -1; return; }
        if (hipOccupancyMaxActiveBlocksPerMultiprocessor(&per_cu, (const void*)mega_fwd, NWAVES * 64, LDS_BYTES) != hipSuccess || per_cu < 1) { fprintf(stderr, "kernel_launch: occupancy query reports %d workgroups per CU\n", per_cu); }
        (void)hipGetLastError();
        grid = cus;
    }
    if (grid < 0) return;
    if (hipMemsetAsync((char*)d_ws + WS_CTL, 0, CTL_ZERO_BYTES, stream) != hipSuccess) { fprintf(stderr, "kernel_launch: hipMemsetAsync failed\n"); return; }
    Args a{};
    for (int i = 0; i < 18; ++i) a.in[i] = (const float*)d_in[i];
    a.out = (float*)d_out; a.ws = (unsigned char*)d_ws;
#if MK_PER_PHASE
    for (int p = 0; p < NPHASE; ++p) { a.ph_lo = p; a.ph_hi = p + 1; hipLaunchKernelGGL(mega_fwd, dim3(grid), dim3(NWAVES * 64), LDS_BYTES, stream, a); }
#else
    a.ph_lo = 0; a.ph_hi = NPHASE;
    hipLaunchKernelGGL(mega_fwd, dim3(grid), dim3(NWAVES * 64), LDS_BYTES, stream, a);
#endif
    const hipError_t le = hipPeekAtLastError();
    if (le != hipSuccess) fprintf(stderr, "kernel_launch: launch failed: %s\n", hipGetErrorName(le));
}
```

```cpp
#include <hip/hip_runtime.h>
#include <cstdio>
#include <cstdint>
__device__ __forceinline__ int lane_id_() { return (int)__builtin_amdgcn_mbcnt_hi(~0u, __builtin_amdgcn_mbcnt_lo(~0u, 0u)); }
template <int K> __device__ __forceinline__ float lane_xor(float v) {
    static_assert(K == 1 || K == 2 || K == 4 || K == 8 || K == 16, "lane_xor: 1, 2, 4, 8, 16");
    if constexpr (K == 16) return __builtin_bit_cast(float, __builtin_amdgcn_ds_swizzle(__builtin_bit_cast(int, v), (16 << 10) | 0x1F));
    else return __builtin_bit_cast(float, __builtin_amdgcn_mov_dpp(__builtin_bit_cast(int, v), K == 1 ? 0xB1 : K == 2 ? 0x4E : K == 4 ? 0x124 : 0x128, 0xF, 0xF, true));
}
__device__ __forceinline__ float half_sum(float v) { const unsigned u = __builtin_bit_cast(unsigned, v); auto rr = __builtin_amdgcn_permlane32_swap(u, u, false, false); return __builtin_bit_cast(float, (unsigned)rr[0]) + __builtin_bit_cast(float, (unsigned)rr[1]); }
__device__ __forceinline__ float half_max(float v) { const unsigned u = __builtin_bit_cast(unsigned, v); auto rr = __builtin_amdgcn_permlane32_swap(u, u, false, false); return fmaxf(__builtin_bit_cast(float, (unsigned)rr[0]), __builtin_bit_cast(float, (unsigned)rr[1])); }
namespace pg8 {
#define PG8_LAS __attribute__((address_space(3)))
typedef unsigned short bf16_t;
typedef short bf16x8 __attribute__((ext_vector_type(8)));
typedef float f32x4 __attribute__((ext_vector_type(4)));
typedef unsigned u32x4 __attribute__((ext_vector_type(4)));
constexpr int BM = 256, BK = 64, HALF = 128, HTB = HALF * BK * 2  , STAGE_BYTES = 8 * HTB, NXCD = 8, WGM = 8;

__host__ __device__ __forceinline__ int lds_byte(int r, int c) { const int st = (r >> 4) * 2 + (c >> 5), rr = r & 15, cc = c & 31, ob = rr * 64 + cc * 2; return st * 1024 + (ob ^ (((ob >> 9) & 1) << 5)); }
__host__ __device__ __forceinline__ void stage_rc(int b, int& R, int& C) { const int st = b / 1024, sb = b % 1024, swz = sb ^ (((sb >> 9) & 1) << 5); R = (st >> 1) * 16 + swz / 64; C = (st & 1) * 32 + (swz % 64) / 2; }
__host__ __device__ __forceinline__ int perm32(int rho) { const int n = rho >> 4, i = rho & 15; return 8 * (i >> 2) + 4 * n + (i & 3); }

struct Unit { int pm, pn; };
struct Gemm { const bf16_t* A; const bf16_t* Bt; int M, N, K; };

struct StaticOrder {
    int nM, nN, nwg, G, c;
    __host__ __device__ void init(int M, int N, int G_, int c_) { nM = M / BM; nN = N / BM; nwg = nM * nN; G = G_; c = c_; }
    __host__ __device__ bool next(int i, Unit& u) const {
        const long L = (long)i * G + c; if (L >= nwg) return false;
        int wgid = (int)L; { const int q = nwg / NXCD, r = nwg % NXCD, xcd = wgid % NXCD, off = wgid / NXCD; wgid = (xcd < r ? xcd * (q + 1) : r * (q + 1) + (xcd - r) * q) + off; }
        const int nig = WGM * nN, gid = wgid / nig, fm = gid * WGM, gsz = (nM - fm) < WGM ? (nM - fm) : WGM;
        u.pm = fm + ((wgid % nig) % gsz); u.pn = (wgid % nig) / gsz; return true;
    }
    __device__ __forceinline__ void a_ready(const Unit&) const {}
    __device__ __forceinline__ void done(const Unit&) const {}
};

struct SplitOrder {
    int x, j, G, c; bool bf;
    __host__ __device__ void init(int G_, int c_, bool bf_) { G = G_; c = c_; x = c_ & 7; j = c_ >> 3; bf = bf_; }
    __host__ __device__ bool next(int i, Unit& u) const {
        const int ncol = bf ? 6 : 34; int pm, pk;
        if (G == 256) { const int nA = bf ? 2 : 8, nB = bf ? 0 : 10; const int cnt = j < 24 ? nA : nB; if (i >= cnt) return false;
            const int t = (j < 24 ? nA * j : 24 * nA + nB * (j - 24)) + i; pm = 8 * x + (t & 7); pk = t >> 3; }
        else { const long t = (long)i * G + c; if (t >= 64L * ncol) return false; pm = (int)(t & 63); pk = (int)(t >> 6); }
        u.pm = pm; u.pn = bf ? (pk < 4 ? 6 + pk : 10 + pk) : (pk < 6 ? pk : pk < 10 ? pk + 4 : pk + 6);
        return true;
    }
    __device__ __forceinline__ void a_ready(const Unit&) const {}
    __device__ __forceinline__ void done(const Unit&) const {}
};

typedef float f32x2c __attribute__((ext_vector_type(2))); typedef __bf16 bf16x2c __attribute__((ext_vector_type(2)));
__device__ __forceinline__ unsigned cvt_pk_bf16(float lo, float hi) { const f32x2c v = {lo, hi}; return __builtin_bit_cast(unsigned, __builtin_convertvector(v, bf16x2c)); }
typedef float f32x2 __attribute__((ext_vector_type(2)));
typedef unsigned u32x2 __attribute__((ext_vector_type(2)));
__device__ __forceinline__ float bf_lo(unsigned u) { return __builtin_bit_cast(float, u << 16); }
__device__ __forceinline__ float bf_hi(unsigned u) { return __builtin_bit_cast(float, u & 0xffff0000u); }
__device__ __forceinline__ float sigmoidf_(float v) { return 1.0f / (1.0f + __expf(-v)); }

__device__ __forceinline__ void rstd8(const float* rowss, int row0, float scale, float (&rsv)[8]) {
#pragma unroll
    for (int h = 0; h < 2; ++h) {
#pragma unroll
        for (int m = 0; m < 4; ++m) { const int row = row0 + h * HALF + m * 16; const f32x4* rp = (const f32x4*)(rowss + (size_t)row * 16); const f32x4 a = rp[0], b = rp[1];
            const float rsum = ((a[0] + a[1]) + (a[2] + a[3])) + ((b[0] + b[1]) + (b[2] + b[3]));
            rsv[4 * h + m] = rsqrtf(rsum * (1.0f / 2048.0f) + 1e-6f) * scale; }
        asm volatile("" ::: "memory"); }
}
struct EpiProj {
    static constexpr bool PERM = true, AFTER_DRAIN = false, MIDK = false;
    bf16_t* PA; float* KMS; const float* rowss;
    __device__ __forceinline__ void operator()(const f32x4 (&acc)[2][2][4][2], const Unit& u, int wr, int wc, int fr, int fq) const {
        asm volatile("" : "+v"(fr), "+v"(fq));
        const int row0 = u.pm * BM + wr * 64 + fr;
        const int col0 = u.pn * BM + wc * 32 + 8 * fq;
        float rsv[8]; rstd8(rowss, row0, 1.0f, rsv);
#pragma unroll
        for (int ai = 0; ai < 2; ++ai)
#pragma unroll
            for (int m = 0; m < 4; ++m) { const int row = row0 + ai * HALF + m * 16;
                const float rs = rsv[4 * ai + m];
                bf16_t* rowp = PA + (size_t)row * 4096 + col0;
#pragma unroll
                for (int bj = 0; bj < 2; ++bj) { const f32x4 v0 = acc[ai][bj][m][0] * rs, v1 = acc[ai][bj][m][1] * rs;
                    u32x4 w; w.x = cvt_pk_bf16(v0[0], v0[1]); w.y = cvt_pk_bf16(v0[2], v0[3]); w.z = cvt_pk_bf16(v1[0], v1[1]); w.w = cvt_pk_bf16(v1[2], v1[3]);
                    *(u32x4*)(rowp + bj * HALF) = w; } }
        if ((u.pn == 8) || (u.pn == 9)) {
            float* kp = KMS + (size_t)u.pm * 512 + (u.pn - 8) * BM + wc * 32 + 8 * fq;
#pragma unroll
            for (int bj = 0; bj < 2; ++bj)
#pragma unroll
                for (int n = 0; n < 2; ++n) { f32x4 cs = (f32x4){0.f, 0.f, 0.f, 0.f};
#pragma unroll
                    for (int ai = 0; ai < 2; ++ai)
#pragma unroll
                        for (int m = 0; m < 4; ++m) cs = cs + acc[ai][bj][m][n] * rsv[4 * ai + m];
#pragma unroll
                    for (int e = 0; e < 4; ++e) { float v = cs[e];
                        v += lane_xor<1>(v); v += lane_xor<2>(v); v += lane_xor<4>(v); v += lane_xor<8>(v);
                        if (fr == 0) atomicAdd(kp + bj * HALF + 4 * n + e, v); } }
        }
    }
};
struct EpiGate3 {
    static constexpr bool PERM = true, AFTER_DRAIN = false, MIDK = true;
    static constexpr int KB1 = 8, KB2 = 12;
    unsigned char* MG; const unsigned char* GT;
    static __device__ __forceinline__ float fl(float g) { return fmaxf(g, 2.4318695068359375e-04f); }
    static __device__ __forceinline__ float b0(unsigned w) { return (float)(w & 0xffu); }
    static __device__ __forceinline__ float b1(unsigned w) { return (float)((w >> 8) & 0xffu); }
    static __device__ __forceinline__ float b2(unsigned w) { return (float)((w >> 16) & 0xffu); }
    static __device__ __forceinline__ float b3(unsigned w) { return (float)(w >> 24); }
    __device__ __forceinline__ void mid(f32x4 (&acc)[2][2][4][2], const Unit& u, int t, int wr, int wc, int fr, int fq) const {
        asm volatile("" : "+v"(fr), "+v"(fq));
        const int gnum = (t == KB1) ? 0 : 2048;
        const int row0 = u.pm * BM + wr * 64 + fr; const int col0 = u.pn * BM + wc * 64 + 16 * fq;
        u32x4 nv[2][4], dv[2][4];
#pragma unroll
        for (int ai = 0; ai < 2; ++ai)
#pragma unroll
            for (int m = 0; m < 4; ++m) { const unsigned char* gp = GT + (size_t)(row0 + ai * HALF + m * 16) * 6144 + gnum + col0;
                nv[ai][m] = *(const u32x4*)gp; dv[ai][m] = *(const u32x4*)(gp + 2048); }
#pragma unroll
        for (int ai = 0; ai < 2; ++ai) {
#pragma unroll
            for (int m = 0; m < 4; ++m)
#pragma unroll
                for (int bj = 0; bj < 2; ++bj) { const u32x2 n_ = bj ? (u32x2){nv[ai][m].z, nv[ai][m].w} : (u32x2){nv[ai][m].x, nv[ai][m].y}, d_ = bj ? (u32x2){dv[ai][m].z, dv[ai][m].w} : (u32x2){dv[ai][m].x, dv[ai][m].y};
                    const f32x4 r0 = (f32x4){fl(b0(n_.x)) * __builtin_amdgcn_rcpf(fl(b0(d_.x))), fl(b1(n_.x)) * __builtin_amdgcn_rcpf(fl(b1(d_.x))), fl(b2(n_.x)) * __builtin_amdgcn_rcpf(fl(b2(d_.x))), fl(b3(n_.x)) * __builtin_amdgcn_rcpf(fl(b3(d_.x)))};
                    const f32x4 r1 = (f32x4){fl(b0(n_.y)) * __builtin_amdgcn_rcpf(fl(b0(d_.y))), fl(b1(n_.y)) * __builtin_amdgcn_rcpf(fl(b1(d_.y))), fl(b2(n_.y)) * __builtin_amdgcn_rcpf(fl(b2(d_.y))), fl(b3(n_.y)) * __builtin_amdgcn_rcpf(fl(b3(d_.y)))};
                    acc[ai][bj][m][0] = acc[ai][bj][m][0] * r0; acc[ai][bj][m][1] = acc[ai][bj][m][1] * r1; }
            asm volatile("" ::: "memory");
        }
    }
    __device__ __forceinline__ void operator()(const f32x4 (&acc)[2][2][4][2], const Unit& u, int wr, int wc, int fr, int fq) const {
        asm volatile("" : "+v"(fr), "+v"(fq));
        const int row0 = u.pm * BM + wr * 64 + fr; const int col0 = u.pn * BM + wc * 32 + 8 * fq; const int gcol = u.pn * BM + wc * 64 + 16 * fq;
        constexpr float GS = 0.0078125f / 255.0f;
#pragma unroll
        for (int ai = 0; ai < 2; ++ai)
#pragma unroll
            for (int m = 0; m < 4; ++m) { const int row = row0 + ai * HALF + m * 16;
                const u32x4 g4 = *(const u32x4*)(GT + (size_t)row * 6144 + 4096 + gcol); unsigned char* op = MG + (size_t)row * 2048 + col0;
#pragma unroll
                for (int bj = 0; bj < 2; ++bj) { const u32x2 gv = bj ? (u32x2){g4.z, g4.w} : (u32x2){g4.x, g4.y};
                    const f32x4 v0 = acc[ai][bj][m][0] * ((f32x4){fl(b0(gv.x)), fl(b1(gv.x)), fl(b2(gv.x)), fl(b3(gv.x))} * GS);
                    const f32x4 v1 = acc[ai][bj][m][1] * ((f32x4){fl(b0(gv.y)), fl(b1(gv.y)), fl(b2(gv.y)), fl(b3(gv.y))} * GS);
                    int w0 = __builtin_amdgcn_cvt_pk_fp8_f32(v0[0], v0[1], 0, false); w0 = __builtin_amdgcn_cvt_pk_fp8_f32(v0[2], v0[3], w0, true);
                    int w1 = __builtin_amdgcn_cvt_pk_fp8_f32(v1[0], v1[1], 0, false); w1 = __builtin_amdgcn_cvt_pk_fp8_f32(v1[2], v1[3], w1, true);
                    u32x2 w; w.x = (unsigned)w0; w.y = (unsigned)w1; *(u32x2*)(op + bj * HALF) = w; }
                asm volatile("" ::: "memory"); }
    }
};
struct EpiIn8 {
    static constexpr bool PERM = true, AFTER_DRAIN = false, MIDK = false;
    bf16_t* PA; unsigned char* GT; const float* rowss;
    static __device__ __forceinline__ float g255(float v) { return __builtin_rintf(255.0f * __builtin_amdgcn_rcpf(1.0f + __expf(-v))); }
    static __device__ __forceinline__ unsigned pk4(const f32x4& v) { unsigned w = __builtin_amdgcn_cvt_pk_u8_f32(g255(v[0]), 0, 0u); w = __builtin_amdgcn_cvt_pk_u8_f32(g255(v[1]), 1, w); w = __builtin_amdgcn_cvt_pk_u8_f32(g255(v[2]), 2, w); return __builtin_amdgcn_cvt_pk_u8_f32(g255(v[3]), 3, w); }
    __device__ __forceinline__ void operator()(const f32x4 (&acc)[2][2][4][2], const Unit& u, int wr, int wc, int fr, int fq) const {
        asm volatile("" : "+v"(fr), "+v"(fq));
        const bool gate = u.pn >= 16;
        const int row0 = u.pm * BM + wr * 64 + fr; const int col0 = (gate ? u.pn - 16 : u.pn) * BM + wc * 32 + 8 * fq;
        float rsv[8]; rstd8(rowss, row0, 0.00390625f, rsv);
#pragma unroll
        for (int ai = 0; ai < 2; ++ai)
#pragma unroll
            for (int m = 0; m < 4; ++m) { const int row = row0 + ai * HALF + m * 16;
                const float rs = rsv[4 * ai + m];
                if (gate) { u32x4 w;
                    w.x = pk4(acc[ai][0][m][0] * rs); w.y = pk4(acc[ai][0][m][1] * rs); w.z = pk4(acc[ai][1][m][0] * rs); w.w = pk4(acc[ai][1][m][1] * rs);
                    *(u32x4*)(GT + (size_t)row * 6144 + (u.pn - 16) * BM + wc * 64 + 16 * fq) = w; }
                else { bf16_t* rowp = PA + (size_t)row * 4096 + col0;
#pragma unroll
                    for (int bj = 0; bj < 2; ++bj) { const f32x4 v0 = acc[ai][bj][m][0] * rs, v1 = acc[ai][bj][m][1] * rs;
                        u32x4 w; w.x = cvt_pk_bf16(v0[0], v0[1]); w.y = cvt_pk_bf16(v0[2], v0[3]); w.z = cvt_pk_bf16(v1[0], v1[1]); w.w = cvt_pk_bf16(v1[2], v1[3]);
                        *(u32x4*)(rowp + bj * HALF) = w; } } }
    }
};
struct EpiResid {
    static constexpr bool PERM = true, AFTER_DRAIN = false, MIDK = false;
    bf16_t* xb; float* rowss; float ascale;
    __device__ __forceinline__ void operator()(const f32x4 (&acc)[2][2][4][2], const Unit& u, int wr, int wc, int fr, int fq) const {
        const int col0 = u.pn * BM + wc * 32 + 8 * fq;
#pragma unroll
        for (int ai = 0; ai < 2; ++ai) {
            u32x4 xo[4][2];
#pragma unroll
            for (int m = 0; m < 4; ++m) { const int r = u.pm * BM + ai * HALF + wr * 64 + m * 16 + fr; const size_t off = (size_t)r * 2048 + col0;
#pragma unroll
                for (int bj = 0; bj < 2; ++bj) xo[m][bj] = *(const u32x4*)(xb + off + bj * HALF); }
#pragma unroll
            for (int m = 0; m < 4; ++m) { const int r = u.pm * BM + ai * HALF + wr * 64 + m * 16 + fr; const size_t off = (size_t)r * 2048 + col0; float ss = 0.f;
#pragma unroll
                for (int bj = 0; bj < 2; ++bj) { const u32x4 x_ = xo[m][bj];
                    const f32x4 v0 = (f32x4){bf_lo(x_.x), bf_hi(x_.x), bf_lo(x_.y), bf_hi(x_.y)} + acc[ai][bj][m][0] * ascale, v1 = (f32x4){bf_lo(x_.z), bf_hi(x_.z), bf_lo(x_.w), bf_hi(x_.w)} + acc[ai][bj][m][1] * ascale;
                    ss += ((v0[0] * v0[0] + v0[1] * v0[1]) + (v0[2] * v0[2] + v0[3] * v0[3])) + ((v1[0] * v1[0] + v1[1] * v1[1]) + (v1[2] * v1[2] + v1[3] * v1[3]));
                    u32x4 w; w.x = cvt_pk_bf16(v0[0], v0[1]); w.y = cvt_pk_bf16(v0[2], v0[3]); w.z = cvt_pk_bf16(v1[0], v1[1]); w.w = cvt_pk_bf16(v1[2], v1[3]);
                    *(u32x4*)(xb + off + bj * HALF) = w; }
                ss += lane_xor<16>(ss); ss = half_sum(ss);
                if (fq == 0) rowss[(size_t)r * 32 + u.pn * 4 + wc] = ss; }
            asm volatile("" ::: "memory"); }
    }
};
struct EpiQ {
    static constexpr bool PERM = true, AFTER_DRAIN = false, MIDK = false;
    bf16_t* Q;
    __device__ __forceinline__ void operator()(const f32x4 (&acc)[2][2][4][2], const Unit& u, int wr, int wc, int fr, int fq) const {
        const int row0 = u.pm * BM + wr * 64 + fr; const int col0 = u.pn * BM + wc * 32 + 8 * fq;
#pragma unroll
        for (int ai = 0; ai < 2; ++ai)
#pragma unroll
            for (int m = 0; m < 4; ++m) { const int row = row0 + ai * HALF + m * 16;
                bf16_t* rowp = Q + (size_t)row * 2048 + col0;
#pragma unroll
                for (int bj = 0; bj < 2; ++bj) { const f32x4 v0 = acc[ai][bj][m][0], v1 = acc[ai][bj][m][1];
                    u32x4 w; w.x = cvt_pk_bf16(v0[0], v0[1]); w.y = cvt_pk_bf16(v0[2], v0[3]); w.z = cvt_pk_bf16(v1[0], v1[1]); w.w = cvt_pk_bf16(v1[2], v1[3]);
                    *(u32x4*)(rowp + bj * HALF) = w; } }
    }
};
typedef int v8i_t __attribute__((ext_vector_type(8)));
template <class Epi, class Sched, bool ALIGN_EPI = false, bool SP2 = false, bool F8 = false>
__device__ __forceinline__ void gemm_phase(PG8_LAS unsigned char* lds, const Gemm g, const Sched& S, const Epi& E, const int wave_in) {
    int tid_ = wave_in * 64 + lane_id_(); asm volatile("" : "+v"(tid_));
    const int tid = tid_, wid = __builtin_amdgcn_readfirstlane(tid >> 6), lane = tid & 63, wr = wid >> 2, wc = wid & 3, fr = lane & 15, fq = lane >> 4;
    const int K = g.K, nt = F8 ? K / 128 : K / BK;
    unsigned voffA[2], voffB[2];
#pragma unroll
    for (int i = 0; i < 2; ++i) { int R, C; stage_rc(tid * 16 + i * 8192, R, C); const int Rb = Epi::PERM ? ((R & ~31) + perm32(R & 31)) : R;
        if constexpr (F8) { voffA[i] = (unsigned)(R * K + 2 * C); voffB[i] = (unsigned)(Rb * K + 2 * C); } else { voffA[i] = (unsigned)(R * K + C) * 2u; voffB[i] = (unsigned)(Rb * K + C) * 2u; } }
    const size_t kstep = (size_t)(BK * 2);
    const size_t hstep = (size_t)HALF * K * (F8 ? 1 : 2);
    const size_t tstep = 2 * hstep;
    const unsigned ldsw = (unsigned)wid * 1024u;
    const int aoff = lds_byte(wr * 64 + fr, fq * 8), boff = lds_byte(wc * 32 + fr, fq * 8);
    const int aoff1 = aoff + 1024, boff1 = boff + 1024;
#define PG8_SA(b, h) (((b) * 2 + (h)) * HTB)
#define PG8_SB(b, h) ((4 + (b) * 2 + (h)) * HTB)
#define PG8_STAGE(bufoff, gbase, voff) do { _Pragma("unroll") for (int _i = 0; _i < 2; ++_i) \
        __builtin_amdgcn_global_load_lds((const unsigned*)((const char*)(gbase) + (voff)[_i]), (PG8_LAS unsigned*)(lds + (bufoff) + ldsw + _i * 8192), 16, 0, 0); } while (0)
#define PG8_LDA(dst, b, h) do { if constexpr (F8) { _Pragma("unroll") for (int m = 0; m < 4; ++m) { const u32x4 x0_ = *(const PG8_LAS u32x4*)(lds + PG8_SA(b, h) + aoff + m * 2048), x1_ = *(const PG8_LAS u32x4*)(lds + PG8_SA(b, h) + aoff1 + m * 2048); \
        dst##8[m] = (v8i_t){(int)x0_.x, (int)x0_.y, (int)x0_.z, (int)x0_.w, (int)x1_.x, (int)x1_.y, (int)x1_.z, (int)x1_.w}; } } else { \
        _Pragma("unroll") for (int m = 0; m < 4; ++m) _Pragma("unroll") for (int k = 0; k < 2; ++k) dst[m][k] = *(const PG8_LAS bf16x8*)(lds + PG8_SA(b, h) + aoff + m * 2048 + k * 1024); } } while (0)
#define PG8_LDB(dst, b, h) do { if constexpr (F8) { _Pragma("unroll") for (int n = 0; n < 2; ++n) { const u32x4 x0_ = *(const PG8_LAS u32x4*)(lds + PG8_SB(b, h) + boff + n * 2048), x1_ = *(const PG8_LAS u32x4*)(lds + PG8_SB(b, h) + boff1 + n * 2048); \
        dst##8[n] = (v8i_t){(int)x0_.x, (int)x0_.y, (int)x0_.z, (int)x0_.w, (int)x1_.x, (int)x1_.y, (int)x1_.z, (int)x1_.w}; } } else { \
        _Pragma("unroll") for (int n = 0; n < 2; ++n) _Pragma("unroll") for (int k = 0; k < 2; ++k) dst[n][k] = *(const PG8_LAS bf16x8*)(lds + PG8_SB(b, h) + boff + n * 2048 + k * 1024); } } while (0)
#define PG8_MMA(ai, bj, At, Bt) do { __builtin_amdgcn_s_setprio(1); if constexpr (F8) { _Pragma("unroll") for (int m = 0; m < 4; ++m) _Pragma("unroll") for (int n = 0; n < 2; ++n) \
        asm volatile("v_mfma_scale_f32_16x16x128_f8f6f4 %0, %1, %2, %0, %3, %3 op_sel_hi:[0,0,0]" : "+v"(acc[ai][bj][m][n]) : "v"(Bt##8[n]), "v"(At##8[m]), "v"(sc1_)); } else { \
        _Pragma("unroll") for (int m = 0; m < 4; ++m) _Pragma("unroll") for (int n = 0; n < 2; ++n) _Pragma("unroll") for (int k = 0; k < 2; ++k) \
        acc[ai][bj][m][n] = __builtin_amdgcn_mfma_f32_16x16x32_bf16(Bt[n][k], At[m][k], acc[ai][bj][m][n], 0, 0, 0); } __builtin_amdgcn_s_setprio(0); } while (0)
#define PG8_WAIT_V(n) asm volatile("s_waitcnt vmcnt(" #n ")" ::: "memory")
#define PG8_WAIT_L(n) asm volatile("s_waitcnt lgkmcnt(" #n ")" ::: "memory")
#define PG8_BAR __builtin_amdgcn_s_barrier()
#define PG8_SCHED __builtin_amdgcn_sched_barrier(0)
    Unit cur, nxt; int ui = 0;
    if (!S.next(0, cur)) return;
    f32x4 acc[2][2][4][2];
#pragma unroll
    for (int a = 0; a < 2; ++a)
#pragma unroll
        for (int b = 0; b < 2; ++b)
#pragma unroll
            for (int m = 0; m < 4; ++m)
#pragma unroll
                for (int n = 0; n < 2; ++n) acc[a][b][m][n] = (f32x4){0.f, 0.f, 0.f, 0.f};
    bf16x8 At[4][2], B0[2][2], B1[2][2]; v8i_t At8[4], B08[2], B18[2];
    int sc1_ = 0x7F7F7F7F; asm volatile("" : "+v"(sc1_));
    const char* cA = (const char*)g.A + (size_t)cur.pm * tstep; const char* cB = (const char*)g.Bt + (size_t)cur.pn * tstep;
    S.a_ready(cur);
    if constexpr (SP2) {
        PG8_STAGE(PG8_SB(0, 0), cB, voffB); PG8_STAGE(PG8_SB(0, 1), cB + hstep, voffB); PG8_STAGE(PG8_SA(0, 0), cA, voffA); PG8_STAGE(PG8_SA(0, 1), cA + hstep, voffA);
        if (wr == 1) PG8_BAR;
        PG8_WAIT_V(2); PG8_BAR;
        PG8_STAGE(PG8_SB(1, 0), cB + kstep, voffB); PG8_STAGE(PG8_SA(1, 0), cA + kstep, voffA); PG8_STAGE(PG8_SB(1, 1), cB + hstep + kstep, voffB);
        PG8_WAIT_V(6); PG8_BAR;
    } else {
        PG8_STAGE(PG8_SB(0, 0), cB, voffB); PG8_STAGE(PG8_SA(0, 0), cA, voffA); PG8_STAGE(PG8_SB(0, 1), cB + hstep, voffB); PG8_STAGE(PG8_SA(0, 1), cA + hstep, voffA);
        if (wr == 1) PG8_BAR;
        PG8_WAIT_V(4); PG8_BAR;
        PG8_STAGE(PG8_SB(1, 0), cB + kstep, voffB); PG8_STAGE(PG8_SA(1, 0), cA + kstep, voffA); PG8_STAGE(PG8_SB(1, 1), cB + hstep + kstep, voffB);
        PG8_WAIT_V(6); PG8_BAR;
    }
    for (;;) {
        const bool has_next = S.next(ui + 1, nxt);
        const char* nA = has_next ? (const char*)g.A + (size_t)nxt.pm * tstep : cA; const char* nB = has_next ? (const char*)g.Bt + (size_t)nxt.pn * tstep : cB;
        for (int t = 0; t < nt; t += 2) {
            if constexpr (Epi::MIDK) { if (t == Epi::KB1 || t == Epi::KB2) E.mid(acc, cur, t, wr, wc, fr, fq); }
            const bool last = (t == nt - 2);
            const char* a1 = cA + (size_t)(t + 1) * kstep;
            const char* a2 = last ? nA : cA + (size_t)(t + 2) * kstep; const char* b2 = last ? nB : cB + (size_t)(t + 2) * kstep;
            const char* a3 = a2 + kstep; const char* b3 = b2 + kstep;
            if (last && has_next) S.a_ready(nxt);
            if constexpr (SP2) {
            PG8_LDB(B0, 0, 0); PG8_LDB(B1, 0, 1); PG8_SCHED; PG8_LDA(At, 0, 0); PG8_STAGE(PG8_SA(1, 1), a1 + hstep, voffA);
            PG8_WAIT_V(8); PG8_WAIT_L(0); PG8_BAR; PG8_MMA(0, 0, At, B0); PG8_MMA(0, 1, At, B1); PG8_BAR; PG8_SCHED;
            PG8_LDA(At, 0, 1); PG8_STAGE(PG8_SB(0, 0), b2, voffB); PG8_STAGE(PG8_SB(0, 1), b2 + hstep, voffB); PG8_STAGE(PG8_SA(0, 0), a2, voffA);
            PG8_WAIT_V(8); PG8_WAIT_L(0); PG8_BAR; PG8_MMA(1, 0, At, B0); PG8_MMA(1, 1, At, B1); PG8_BAR; PG8_SCHED;
            PG8_LDB(B0, 1, 0); PG8_LDB(B1, 1, 1); PG8_SCHED; PG8_LDA(At, 1, 0); PG8_STAGE(PG8_SA(0, 1), a2 + hstep, voffA);
            PG8_WAIT_V(8); PG8_WAIT_L(0); PG8_BAR; PG8_MMA(0, 0, At, B0); PG8_MMA(0, 1, At, B1); PG8_BAR; PG8_SCHED;
            PG8_LDA(At, 1, 1); PG8_STAGE(PG8_SB(1, 0), b3, voffB); PG8_STAGE(PG8_SB(1, 1), b3 + hstep, voffB); PG8_STAGE(PG8_SA(1, 0), a3, voffA);
            PG8_WAIT_V(8); PG8_WAIT_L(0); PG8_BAR; PG8_MMA(1, 0, At, B0); PG8_MMA(1, 1, At, B1); PG8_BAR; PG8_SCHED;
            } else {
            PG8_LDB(B0, 0, 0); PG8_SCHED; PG8_LDA(At, 0, 0); PG8_STAGE(PG8_SA(1, 1), a1 + hstep, voffA);
            PG8_WAIT_L(8); PG8_BAR; PG8_WAIT_L(0); PG8_MMA(0, 0, At, B0); PG8_BAR; PG8_SCHED;
            PG8_LDB(B1, 0, 1); PG8_STAGE(PG8_SB(0, 0), b2, voffB);
            PG8_BAR; PG8_WAIT_L(0); PG8_MMA(0, 1, At, B1); PG8_BAR;
            PG8_LDA(At, 0, 1); PG8_STAGE(PG8_SA(0, 0), a2, voffA);
            PG8_BAR; PG8_WAIT_L(0); PG8_MMA(1, 0, At, B0); PG8_BAR; PG8_SCHED;
            PG8_STAGE(PG8_SB(0, 1), b2 + hstep, voffB);
            PG8_WAIT_V(6); PG8_BAR; PG8_MMA(1, 1, At, B1); PG8_BAR;
            PG8_LDB(B0, 1, 0); PG8_SCHED; PG8_LDA(At, 1, 0); PG8_STAGE(PG8_SA(0, 1), a2 + hstep, voffA);
            PG8_WAIT_L(8); PG8_BAR; PG8_WAIT_L(0); PG8_MMA(0, 0, At, B0); PG8_BAR; PG8_SCHED;
            PG8_LDB(B1, 1, 1); PG8_STAGE(PG8_SB(1, 0), b3, voffB);
            PG8_BAR; PG8_WAIT_L(0); PG8_MMA(0, 1, At, B1); PG8_BAR;
            PG8_LDA(At, 1, 1); PG8_STAGE(PG8_SA(1, 0), a3, voffA);
            PG8_BAR; PG8_WAIT_L(0); PG8_MMA(1, 0, At, B0); PG8_BAR; PG8_SCHED;
            PG8_STAGE(PG8_SB(1, 1), b3 + hstep, voffB);
            PG8_WAIT_V(6); PG8_BAR; PG8_MMA(1, 1, At, B1); PG8_BAR;
            }
        }
        if constexpr (ALIGN_EPI) { if (wr == 0) PG8_BAR; }
        if constexpr (F8) asm volatile("s_nop 15\n\ts_nop 15" ::: "memory");
        if constexpr (!Epi::AFTER_DRAIN) { E(acc, cur, wr, wc, fr, fq); S.done(cur); }
        if (!has_next) break;
#pragma unroll
        for (int a = 0; a < 2; ++a)
#pragma unroll
            for (int b = 0; b < 2; ++b)
#pragma unroll
                for (int m = 0; m < 4; ++m)
#pragma unroll
                    for (int n = 0; n < 2; ++n) acc[a][b][m][n] = (f32x4){0.f, 0.f, 0.f, 0.f};
        cur = nxt; cA = nA; cB = nB; ++ui;
        if constexpr (ALIGN_EPI) { if (wr == 1) PG8_BAR; }
    }
    PG8_WAIT_V(0);
    if constexpr (!ALIGN_EPI) { if (wr == 0) PG8_BAR; }
    PG8_BAR;
    if constexpr (Epi::AFTER_DRAIN) { E.fused(acc, cur, wr, wc, fr, fq, lds, wid, lane); S.done(cur); }
#undef PG8_SA
#undef PG8_SB
#undef PG8_STAGE
#undef PG8_LDA
#undef PG8_LDB
#undef PG8_MMA
#undef PG8_WAIT_V
#undef PG8_WAIT_L
#undef PG8_BAR
#undef PG8_SCHED
}
}
#define PG8_SP2 true
#define GAS __attribute__((address_space(1)))
#define LAS __attribute__((address_space(3)))
typedef unsigned short bf16;
typedef unsigned v4u __attribute__((ext_vector_type(4)));
typedef float f32x4 __attribute__((ext_vector_type(4)));
typedef short bf16x8 __attribute__((ext_vector_type(8)));
typedef GAS unsigned gu32;
typedef GAS unsigned long long gu64;
#define RLX_AGENT __ATOMIC_RELAXED, __HIP_MEMORY_SCOPE_AGENT
#define LDS_WAIT() asm volatile("s_waitcnt lgkmcnt(0)" ::: "memory")
#define VM_WAIT() asm volatile("s_waitcnt vmcnt(0)" ::: "memory")
__device__ __forceinline__ unsigned long long rt() { return __builtin_amdgcn_s_memrealtime(); }
__device__ __forceinline__ unsigned f2bf(float f) { unsigned u = __builtin_bit_cast(unsigned, f); return (u + 0x7fffu + ((u >> 16) & 1u)) >> 16; }
__device__ __forceinline__ unsigned pk2(float lo, float hi) { return f2bf(lo) | (f2bf(hi) << 16); }

#define XB_TMO      128
#define XB_XCNT(j)  (256  + 64 * (j))
#define XB_XSUB(j)  (1280 + 64 * (j))
#define XB_XGEN(j)  (2304 + 64 * (j))
#define XB_TOP      3328
#define XB_TOPGEN   3392
#define XCD_BAR_WORDS 3456
#define XB_SPIN_CAP (1u << 18)

__device__ __forceinline__ unsigned xb_ld(unsigned* p)              { return __hip_atomic_load(p, __ATOMIC_RELAXED, __HIP_MEMORY_SCOPE_AGENT); }
__device__ __forceinline__ unsigned xb_add(unsigned* p, unsigned v) { return __hip_atomic_fetch_add(p, v, __ATOMIC_RELAXED, __HIP_MEMORY_SCOPE_AGENT); }
__device__ __forceinline__ unsigned xb_xcc_id() { return (unsigned)__builtin_amdgcn_s_getreg((3 << 11) | 20) & 0xFu; }
#define XB_SPIN(cond, bar) do { unsigned _sp = 0; while (cond) { __builtin_amdgcn_s_sleep(1); \
    if ((++_sp & 255u) == 0u) { if (xb_ld(&(bar)[XB_TMO])) break; if (_sp > XB_SPIN_CAP) { atomicAdd(&(bar)[XB_TMO], 1u); break; } } } } while (0)

struct XcdBarrier {
    unsigned* bar; unsigned x;
    volatile LAS unsigned* st;
};

__device__ __forceinline__ XcdBarrier xcd_barrier_post(unsigned* bar, volatile LAS unsigned* st) {
    XcdBarrier b; b.bar = bar; b.x = xb_xcc_id(); b.st = st;
    if (threadIdx.x == 0) st[3] = xb_add(&bar[XB_XCNT(b.x)], 1u);
    return b;
}
__device__ __forceinline__ void xcd_barrier_complete(unsigned* bar, unsigned x, unsigned& nloc, unsigned& nx, unsigned& uni) {
    const unsigned G = gridDim.x * gridDim.y * gridDim.z;
    unsigned sum, cnt, mine, bad, sp = 0u;
    for (;;) {
        sum = 0u; cnt = 0u; mine = 0u; bad = 0u;
#pragma unroll
        for (unsigned j = 0; j < 16; ++j) { const unsigned c = xb_ld(&bar[XB_XCNT(j)]); sum += c; cnt += (c > 0u) ? 1u : 0u; mine = (j == x) ? c : mine; bad += (c != 0u && (c != 32u || j >= 8u)) ? 1u : 0u; }
        if (sum == G) break;
        __builtin_amdgcn_s_sleep(1);
        if ((++sp & 255u) == 0u) { if (xb_ld(&bar[XB_TMO])) break; if (sp > XB_SPIN_CAP) { atomicAdd(&bar[XB_TMO], 1u); break; } }
    }
    nloc = mine > 0u ? mine : 1u; nx = cnt > 0u ? cnt : 1u;
    uni = (sum == G && G == 256u && cnt == 8u && bad == 0u) ? 1u : 2u;
}

__device__ __forceinline__ void xcd_barrier(const XcdBarrier& b) {
    asm volatile("s_waitcnt vmcnt(0)" ::: "memory");
    __syncthreads();
    if (threadIdx.x == 0) {
        unsigned* bar = b.bar;
        __builtin_amdgcn_s_waitcnt(0);
        unsigned nloc = b.st[0], nx = b.st[1];
        if (nloc == 0u) { unsigned uni; xcd_barrier_complete(bar, b.x, nloc, nx, uni); b.st[0] = nloc; b.st[1] = nx; b.st[2] = uni; }
        const unsigned old = xb_add(&bar[XB_XSUB(b.x)], 1u);
        const unsigned gen = old / nloc;
        if (old + 1u == (gen + 1u) * nloc) {
            __builtin_amdgcn_fence(__ATOMIC_RELEASE, "agent");
            asm volatile("s_waitcnt vmcnt(0)" ::: "memory");
            const unsigned og = xb_add(&bar[XB_TOP], 1u);
            const unsigned tg = og / nx;
            if (og + 1u == (tg + 1u) * nx) xb_add(&bar[XB_TOPGEN], 1u);
            else XB_SPIN(xb_ld(&bar[XB_TOPGEN]) == tg, bar);
            __builtin_amdgcn_fence(__ATOMIC_ACQUIRE, "agent");
            xb_add(&bar[XB_XGEN(b.x)], 1u);
            asm volatile("s_waitcnt vmcnt(0)" ::: "memory");
        } else {
            XB_SPIN(xb_ld(&bar[XB_XGEN(b.x)]) == gen, bar);
            __builtin_amdgcn_fence(__ATOMIC_ACQUIRE, "agent");
            asm volatile("s_waitcnt vmcnt(0)" ::: "memory");
        }
    }
    __syncthreads();
}
__device__ __forceinline__ void xcd_barrier_local(const XcdBarrier& b) {
    asm volatile("s_waitcnt vmcnt(0)" ::: "memory");
    __syncthreads();
    if (threadIdx.x == 0) {
        unsigned* bar = b.bar;
        __builtin_amdgcn_s_waitcnt(0);
        const unsigned nloc = b.st[0];
        const unsigned old = xb_add(&bar[XB_XSUB(b.x)], 1u);
        const unsigned gen = old / nloc;
        if (old + 1u == (gen + 1u) * nloc) xb_add(&bar[XB_XGEN(b.x)], 1u);
        else XB_SPIN(xb_ld(&bar[XB_XGEN(b.x)]) == gen, bar);
        __builtin_amdgcn_fence(__ATOMIC_ACQUIRE, "agent");
        asm volatile("s_waitcnt vmcnt(0)" ::: "memory");
    }
    __syncthreads();
}
namespace cfg {
constexpr int NWAVES = 8;
constexpr int M = 16384, D = 2048, T = 2048, NBATCH = 8, DEPTH = 2;
constexpr int IN_COLS = 10152, NPROJ = 10240, PA_LD = 4096, GT_LD = 6144;
constexpr int C_QA = 0, C_KA = 1024, C_VA = 1280, C_QB = 1536, C_KB = 2048, C_VB = 2560, C_QC = 3072, C_CL = 3584, C_IQ = 3712, C_IK = 3968, C_IW = 4000;
constexpr float EPS = 1e-6f;
constexpr size_t MiB = 1u << 20;
constexpr size_t WS_CTL = 0, CTL_ZERO_BYTES = 1 * MiB;
constexpr size_t WS_ROWSSB = 842 * MiB;
constexpr size_t WS_ROWSSA = 1 * MiB;
constexpr size_t WS_KMEAN = 512 * 1024;
constexpr size_t WS_BIASD = 1 * MiB + 256 * 1024;
constexpr size_t WS_WUKB = 1 * MiB + 512 * 1024;
constexpr size_t WS_WUVT = 1 * MiB + 768 * 1024;
constexpr size_t WS_CN = 2 * MiB;
constexpr size_t WS_MASK = 6 * MiB;
constexpr size_t WS_WA = 10 * MiB, WS_WB = 18 * MiB, WS_WC = 22 * MiB, WS_WOUT = 26 * MiB, WS_WQ = 42 * MiB, WS_WIN = 58 * MiB;
constexpr size_t WS_U = 138 * MiB, WS_V = 266 * MiB;
constexpr size_t WS_USC = WS_U + 64 * MiB;
constexpr size_t WS_XB8 = WS_U + 80 * MiB;
constexpr size_t WS_WG8 = WS_V + 80 * MiB;
constexpr size_t WS_XB = 394 * MiB;
constexpr size_t WS_PA = 458 * MiB;
constexpr size_t WS_MG = 682 * MiB, WS_QP = 714 * MiB;
constexpr size_t WS_GT = 586 * MiB;
constexpr size_t WS_YA = 778 * MiB, WS_YB = 810 * MiB, WS_YC = 826 * MiB;
constexpr size_t WS_SKB = 844 * MiB;
constexpr size_t WS_SC = 845 * MiB;
constexpr size_t WS_PD = WS_SC;
constexpr size_t WS_RI = 973 * MiB, WS_RG = 981 * MiB, WS_W = 989 * MiB;
constexpr size_t WS_RSTD = 997 * MiB;
constexpr size_t WS_RS = 998 * MiB;
constexpr size_t WS_END = 999 * MiB;
constexpr int CW_BAR = 4096;
constexpr int RING_BYTES = 131072, LDS_BYTES = 147456, LDSCTL_OFF = LDS_BYTES - 512, MISC_OFF = LDSCTL_OFF + 320;
constexpr int NPHASE = 22;
}
using namespace cfg;
typedef unsigned u32x4v __attribute__((ext_vector_type(4)));
typedef unsigned u32x2v __attribute__((ext_vector_type(2)));
typedef float f32x2v __attribute__((ext_vector_type(2)));
typedef __bf16 bf16x2_t __attribute__((ext_vector_type(2)));
__device__ __forceinline__ float bflo(unsigned u) { return __builtin_bit_cast(float, u << 16); }
__device__ __forceinline__ float bfhi(unsigned u) { return __builtin_bit_cast(float, u & 0xffff0000u); }
__device__ __forceinline__ float bf1(bf16 v) { return __builtin_bit_cast(float, (unsigned)v << 16); }
__device__ __forceinline__ float dot2(unsigned a, unsigned b, float c) { return __builtin_amdgcn_fdot2_f32_bf16(__builtin_bit_cast(bf16x2_t, a), __builtin_bit_cast(bf16x2_t, b), c, false); }
__device__ __forceinline__ float dot8(v4u a, v4u b, float c) { c = dot2(a.x, b.x, c); c = dot2(a.y, b.y, c); c = dot2(a.z, b.z, c); c = dot2(a.w, b.w, c); return c; }
__device__ __forceinline__ float wave_sum(float v) {
    v += lane_xor<1>(v); v += lane_xor<2>(v); v += lane_xor<4>(v); v += lane_xor<8>(v); v += lane_xor<16>(v); v = half_sum(v);
    return v;
}
__device__ __forceinline__ float wave_max(float v) {
    v = fmaxf(v, lane_xor<1>(v)); v = fmaxf(v, lane_xor<2>(v)); v = fmaxf(v, lane_xor<4>(v)); v = fmaxf(v, lane_xor<8>(v)); v = fmaxf(v, lane_xor<16>(v)); v = half_max(v);
    return v;
}
__device__ __forceinline__ unsigned fkey(float f) { const unsigned u = __builtin_bit_cast(unsigned, f); return u ^ ((unsigned)((int)u >> 31) | 0x80000000u); }
__device__ __forceinline__ float funkey(unsigned k) { return __builtin_bit_cast(float, (k & 0x80000000u) ? (k ^ 0x80000000u) : ~k); }
__device__ __forceinline__ int mbcnt64(unsigned long long m) { return (int)__builtin_amdgcn_mbcnt_hi((unsigned)(m >> 32), __builtin_amdgcn_mbcnt_lo((unsigned)m, 0u)); }
__device__ __forceinline__ float rdlane(float v, int l) { return __builtin_bit_cast(float, __builtin_amdgcn_readlane(__builtin_bit_cast(int, v), l)); }
__device__ __forceinline__ float gelu_tanh(float x) { const float u = 0.7978845608028654f * (x + 0.044715f * x * x * x); const float e = __expf(2.0f * u); const float th = 1.0f - 2.0f / (e + 1.0f); return 0.5f * x * (1.0f + th); }
typedef int v6i_t __attribute__((ext_vector_type(6)));
typedef __bf16 v32b_t __attribute__((ext_vector_type(32)));
typedef float v32f_t __attribute__((ext_vector_type(32)));
typedef unsigned v16u_t __attribute__((ext_vector_type(16)));
constexpr size_t TBL_SLICE = (size_t)16384 * 192, TBL_LAYER = 8 * TBL_SLICE;
__device__ __forceinline__ void row6_load(const float* src, f32x4 (&a)[8], int lane) {
    const int s = lane >> 3, b = lane & 7;
#pragma unroll
    for (int k = 0; k < 8; ++k) a[k] = __builtin_nontemporal_load((const f32x4*)(src + 256 * s + 32 * k + 4 * b));
}
template <bool UL>
__device__ __forceinline__ float row_to_fp6(f32x4 (&a)[8], const float* g, unsigned char* dst, int lane) {
    const int s = lane >> 3, b = lane & 7;
    float amax = 0.f;
#pragma unroll
    for (int k = 0; k < 8; ++k) { const int e0 = 256 * s + 32 * k + 4 * b;
        if (g) a[k] = a[k] * *(const f32x4*)(g + e0);
        amax = fmaxf(amax, fmaxf(fmaxf(fabsf(a[k].x), fabsf(a[k].y)), fmaxf(fabsf(a[k].z), fabsf(a[k].w)))); }
    amax = wave_max(amax);
    const float enc = amax > 0.f ? 7.5f / amax : 1.f;
    v32b_t v;
#pragma unroll
    for (int k = 0; k < 8; ++k) { v[4 * k] = (__bf16)(a[k].x * enc); v[4 * k + 1] = (__bf16)(a[k].y * enc); v[4 * k + 2] = (__bf16)(a[k].z * enc); v[4 * k + 3] = (__bf16)(a[k].w * enc); }
    const v6i_t w = __builtin_amdgcn_cvt_scalef32_pk32_fp6_bf16(v, 1.0f);
    unsigned* row = (unsigned*)(dst + (size_t)s * TBL_SLICE);
    if (UL) { const int p = b >> 1; const bool h = b & 1;
        v4u q4; q4.x = (unsigned)(h ? w[2] : w[0]); q4.y = (unsigned)(h ? w[3] : w[1]); q4.z = (unsigned)(h ? w[4] : w[2]); q4.w = (unsigned)(h ? w[5] : w[3]);
        u32x2v q2; q2.x = (unsigned)(h ? w[0] : w[4]); q2.y = (unsigned)(h ? w[1] : w[5]);
        *(v4u*)(row + (h ? 32 : 0) + 4 * p) = q4; *(u32x2v*)(row + 16 + 4 * p + (h ? 2 : 0)) = q2; }
    else {
#pragma unroll
        for (int j = 0; j < 1; ++j) { v4u q4; q4.x = (unsigned)w[0]; q4.y = (unsigned)w[1]; q4.z = (unsigned)w[2]; q4.w = (unsigned)w[3]; *(v4u*)(row + 4 * b) = q4;
            u32x2v q2; q2.x = (unsigned)w[4]; q2.y = (unsigned)w[5]; *(u32x2v*)(row + 32 + 2 * b) = q2; } }
    return amax > 0.f ? amax / 7.5f : 1.f;
}
struct TItem { const float* W; const float* g; void* WT; float scale; int ldw, c0, ncv, row_off, ldk, koff, k0, n0; bool f8; };
__device__ __forceinline__ void titem_load(const TItem& d, f32x4 (&v)[8], int lane) {
    const int cj = lane & 7, ks = lane >> 3; const bool ok = d.n0 + 4 * cj < d.ncv;
#pragma unroll
    for (int i = 0; i < 8; ++i) v[i] = ok ? *(const f32x4*)(d.W + (size_t)(d.k0 + 8 * i + ks) * d.ldw + d.c0 + d.n0 + 4 * cj) : (f32x4){0.f, 0.f, 0.f, 0.f};
}
__device__ __forceinline__ void titem_finish(const TItem& d, const f32x4 (&v)[8], LAS float* scr, int lane) {
    const int cj = lane & 7, ks = lane >> 3;
#pragma unroll
    for (int i = 0; i < 8; ++i) { const int kk = 8 * i + ks; const f32x4 w = v[i] * (d.g ? d.g[d.k0 + kk] * d.scale : d.scale);
        LAS float* p = scr + kk * 33 + 4 * cj; p[0] = w.x; p[1] = w.y; p[2] = w.z; p[3] = w.w; }
    LDS_WAIT(); asm volatile("" ::: "memory");
    if (!d.f8) { const int c = lane & 7; bf16* WT = (bf16*)d.WT;
#pragma unroll
        for (int j = 0; j < 4; ++j) { const int n = (lane >> 3) + 8 * j; const LAS float* sp = scr + (8 * c) * 33 + n;
            v4u o; o.x = pk2(sp[0 * 33], sp[1 * 33]); o.y = pk2(sp[2 * 33], sp[3 * 33]); o.z = pk2(sp[4 * 33], sp[5 * 33]); o.w = pk2(sp[6 * 33], sp[7 * 33]);
            *(v4u*)(WT + (size_t)(d.row_off + d.n0 + n) * d.ldk + d.koff + d.k0 + 8 * c) = o; } }
    else { const int n = lane >> 1, hf = lane & 1; const LAS float* sp = scr + (32 * hf) * 33 + n;
        unsigned w[8];
#pragma unroll
        for (int q = 0; q < 8; ++q) { int t = __builtin_amdgcn_cvt_pk_fp8_f32(sp[(4 * q) * 33], sp[(4 * q + 1) * 33], 0, false); t = __builtin_amdgcn_cvt_pk_fp8_f32(sp[(4 * q + 2) * 33], sp[(4 * q + 3) * 33], t, true); w[q] = (unsigned)t; }
        unsigned char* dp = (unsigned char*)d.WT + (size_t)(d.row_off + d.n0 + n) * d.ldk + d.koff + d.k0 + 32 * hf;
        *(v4u*)dp = (v4u){w[0], w[1], w[2], w[3]}; *(v4u*)(dp + 16) = (v4u){w[4], w[5], w[6], w[7]}; }
    LDS_WAIT(); asm volatile("" ::: "memory");
}
__device__ __forceinline__ int rel_bucket(int d) {
    if (d < 16) return d;
    const int v = 16 + (int)(logf((float)d / 16.0f) / 4.852030263919617f * 16.0f);
    return v < 31 ? v : 31;
}
struct Ptrs {
    const float *x, *rel_bias, *g_mix, *w_in, *a_sinks, *c_gain, *w_uk, *w_uv, *w_a, *w_b, *w_c, *w_out, *g_ffn, *w_q, *sub_keys, *peer_u, *peer_v, *g_final;
    float* out; unsigned char* ws;
};
__device__ __forceinline__ void p0_prologue(const Ptrs& P, LAS unsigned char* lds, int gw, int NGW, int wave, int lane) {
    LAS float* scr = (LAS float*)(lds + wave * 16384);
    unsigned char* ws = P.ws;
    constexpr int I_IN1 = 32 * 32, I_IN1B = 32 * 16, I_IN8A = 32 * 48, I_IN8B = 32 * 32, I_IN2 = 32 * 192, I_A = 16 * 64, I_B = 8 * 64, I_C = 8 * 64, I_O = 32 * 64, I_Q = 32 * 64;
    constexpr int I_LAYER = I_IN1 + I_IN1B + I_IN8A + I_IN8B + I_IN2 + I_A + I_B + I_C + I_O + I_Q;
    auto mk = [&](int it) -> TItem {
        const int l = it / I_LAYER; int r = it % I_LAYER; TItem d;
        const float* win = P.w_in + (size_t)l * 2048 * IN_COLS; const float* gm = P.g_mix + l * 2048;
        auto set = [&](const float* W, int ldw, int c0, int ncv, const float* g, float scale, void* WT, int nblk, int ldk, int koff, bool f8) {
            d.W = W; d.ldw = ldw; d.c0 = c0; d.ncv = ncv; d.g = g; d.scale = scale; d.WT = WT; d.row_off = 0; d.ldk = ldk; d.koff = koff; d.k0 = 64 * (r / nblk); d.n0 = 32 * (r % nblk); d.f8 = f8; };
        bf16* WinT = (bf16*)(ws + WS_WIN) + (size_t)l * NPROJ * 2048; unsigned char* Win8 = ws + WS_WG8 + (size_t)l * NPROJ * 2048;
        if (r < I_IN1) { set(win, IN_COLS, 1536, 1024, gm, 1.0f, WinT, 32, 2048, 0, false); d.row_off = 1536; return d; } r -= I_IN1;
        if (r < I_IN1B) { set(win, IN_COLS, 3584, 424, gm, 1.0f, WinT, 16, 2048, 0, false); d.row_off = 3584; return d; } r -= I_IN1B;
        if (r < I_IN8A) { set(win, IN_COLS, 0, 1536, gm, 256.0f, Win8, 48, 2048, 0, true); return d; } r -= I_IN8A;
        if (r < I_IN8B) { set(win, IN_COLS, 2560, 1024, gm, 256.0f, Win8, 32, 2048, 0, true); d.row_off = 2560; return d; } r -= I_IN8B;
        if (r < I_IN2) { set(win, IN_COLS, 4008, 6144, gm, 256.0f, Win8, 192, 2048, 0, true); d.row_off = 4096; return d; } r -= I_IN2;
        if (r < I_A) { set(P.w_a + (size_t)l * 1024 * 2048, 2048, 0, 2048, nullptr, 128.0f, ws + WS_WA + (size_t)l * 2048 * 2048, 64, 2048, 0, true); return d; } r -= I_A;
        if (r < I_B) { set(P.w_b + (size_t)l * 512 * 2048, 2048, 0, 2048, nullptr, 128.0f, ws + WS_WA + (size_t)l * 2048 * 2048, 64, 2048, 1024, true); return d; } r -= I_B;
        if (r < I_C) { set(P.w_c + (size_t)l * 512 * 2048, 2048, 0, 2048, nullptr, 128.0f, ws + WS_WA + (size_t)l * 2048 * 2048, 64, 2048, 1536, true); return d; } r -= I_C;
        if (r < I_O) { set(P.w_out + (size_t)l * 2048 * 2048, 2048, 0, 2048, nullptr, 256.0f, ws + WS_WOUT + (size_t)l * 2048 * 2048, 64, 2048, 0, true); return d; } r -= I_O;
        set(P.w_q + (size_t)l * 2048 * 2048, 2048, 0, 2048, P.g_ffn + l * 2048, 1.0f, (bf16*)(ws + WS_WQ) + (size_t)l * 2048 * 2048, 64, 2048, 0, false); return d; };
    { f32x4 nx[8];
      if (gw < 2 * I_LAYER) { const TItem d0 = mk(2 * I_LAYER - 1 - gw); titem_load(d0, nx, lane); }
#pragma unroll 1
      for (int it = gw; it < 2 * I_LAYER; it += NGW) {
          const TItem d = mk(2 * I_LAYER - 1 - it);
          f32x4 a[8];
#pragma unroll
          for (int k = 0; k < 8; ++k) a[k] = nx[k];
          { const TItem dn = mk(2 * I_LAYER - 1 - ((it + NGW < 2 * I_LAYER) ? it + NGW : it)); titem_load(dn, nx, lane); }
          titem_finish(d, a, scr, lane);
      } }
    { f32x4 nx[8];
      if (gw < 4 * 16384) { const int tb = gw >> 14, e = gw & 16383, l = tb & 1; row6_load((tb < 2 ? P.peer_u : P.peer_v) + ((size_t)l * 16384 + e) * 2048, nx, lane); }
#pragma unroll 1
      for (int it = gw; it < 4 * 16384; it += NGW) {
        const int tb = it >> 14, e = it & 16383, l = tb & 1;
        f32x4 a[8];
#pragma unroll
        for (int k = 0; k < 8; ++k) a[k] = nx[k];
        { const int itn = (it + NGW < 4 * 16384) ? it + NGW : it; const int tbn = itn >> 14, en = itn & 16383, ln = tbn & 1; row6_load((tbn < 2 ? P.peer_u : P.peer_v) + ((size_t)ln * 16384 + en) * 2048, nx, lane); }
        if (tb < 2) { const float sc = row_to_fp6<true>(a, P.g_ffn + l * 2048, ws + WS_U + (size_t)l * TBL_LAYER + (size_t)e * 192, lane); if (lane == 0) ((float*)(ws + WS_USC))[2 * (l * 16384 + e)] = sc; }
        else        { const float sc = row_to_fp6<false>(a, nullptr, ws + WS_V + (size_t)l * TBL_LAYER + (size_t)e * 192, lane); if (lane == 0) ((float*)(ws + WS_USC))[2 * (l * 16384 + e) + 1] = sc; }
      } }
    float* RS = (float*)(ws + WS_RS);
    { f32x4 nx[8];
      if (gw < M) {
#pragma unroll
          for (int i = 0; i < 4; ++i) { const float* p = P.x + (size_t)gw * 2048 + 8 * (lane + 64 * i); nx[2 * i] = __builtin_nontemporal_load((const f32x4*)p); nx[2 * i + 1] = __builtin_nontemporal_load((const f32x4*)(p + 4)); } }
#pragma unroll 1
      for (int m = gw; m < M; m += NGW) {
          f32x4 a[8];
#pragma unroll
          for (int k = 0; k < 8; ++k) a[k] = nx[k];
          { const int mn = (m + NGW < M) ? m + NGW : m;
#pragma unroll
            for (int i = 0; i < 4; ++i) { const float* p = P.x + (size_t)mn * 2048 + 8 * (lane + 64 * i); nx[2 * i] = __builtin_nontemporal_load((const f32x4*)p); nx[2 * i + 1] = __builtin_nontemporal_load((const f32x4*)(p + 4)); } }
          float ss = 0.f; bf16* dst = (bf16*)(ws + WS_XB) + (size_t)m * 2048; unsigned char* dst8 = ws + WS_XB8 + (size_t)m * 2048;
#pragma unroll
          for (int i = 0; i < 4; ++i) { const int e0 = 8 * (lane + 64 * i); const f32x4 p = a[2 * i], q = a[2 * i + 1];
              ss += (p.x * p.x + p.y * p.y) + (p.z * p.z + p.w * p.w) + (q.x * q.x + q.y * q.y) + (q.z * q.z + q.w * q.w);
              v4u o; o.x = pk2(p.x, p.y); o.y = pk2(p.z, p.w); o.z = pk2(q.x, q.y); o.w = pk2(q.z, q.w); *(v4u*)(dst + e0) = o;
              int w0 = __builtin_amdgcn_cvt_pk_fp8_f32(p.x, p.y, 0, false); w0 = __builtin_amdgcn_cvt_pk_fp8_f32(p.z, p.w, w0, true); int w1 = __builtin_amdgcn_cvt_pk_fp8_f32(q.x, q.y, 0, false); w1 = __builtin_amdgcn_cvt_pk_fp8_f32(q.z, q.w, w1, true);
              u32x2v o8; o8.x = (unsigned)w0; o8.y = (unsigned)w1; *(u32x2v*)(dst8 + e0) = o8; }
          ss = wave_sum(ss);
          if (lane < 16) RS[m * 16 + lane] = lane == 0 ? ss : 0.f; } }
    { bf16* SKB = (bf16*)(ws + WS_SKB);
      for (int i = gw * 64 + lane; i < 2 * 262144 / 4; i += NGW * 64) { const f32x4 v = *(const f32x4*)(P.sub_keys + 4 * (size_t)i); u32x2v o; o.x = pk2(v.x, v.y); o.y = pk2(v.z, v.w); *(u32x2v*)(SKB + 4 * (size_t)i) = o; } }
    { bf16* WUKB = (bf16*)(ws + WS_WUKB); bf16* WUVT = (bf16*)(ws + WS_WUVT);
      for (int i = gw * 64 + lane; i < 2 * 65536; i += NGW * 64) { const int l = i >> 16, c = (i >> 9) & 127, h = (i >> 6) & 7, d = i & 63;
          WUKB[((size_t)(l * 8 + h) * 128 + c) * 64 + d] = (bf16)f2bf(P.w_uk[i]); WUVT[((size_t)(l * 8 + h) * 64 + d) * 128 + c] = (bf16)f2bf(P.w_uv[i]); } }
    float* biasd = (float*)(ws + WS_BIASD);
    for (int i = gw * 64 + lane; i < 32 * 2048; i += NGW * 64) { const int hh = i >> 11, d = i & 2047; biasd[i] = P.rel_bias[rel_bucket(d) * 32 + hh]; }
}
__device__ __forceinline__ void cn_item(const bf16* PA, const float* gain, bf16* CN, int item, int lane) {
    const int row = 4 * item + (lane >> 4), c8 = 8 * (lane & 15);
    const v4u cv = *(const v4u*)(PA + (size_t)row * PA_LD + C_CL + c8);
    const float f0 = bflo(cv.x), f1 = bfhi(cv.x), f2 = bflo(cv.y), f3 = bfhi(cv.y), f4 = bflo(cv.z), f5 = bfhi(cv.z), f6 = bflo(cv.w), f7 = bfhi(cv.w);
    float ss = ((f0 * f0 + f1 * f1) + (f2 * f2 + f3 * f3)) + ((f4 * f4 + f5 * f5) + (f6 * f6 + f7 * f7));
    ss += lane_xor<1>(ss); ss += lane_xor<2>(ss); ss += lane_xor<4>(ss); ss += lane_xor<8>(ss);
    const float r = rsqrtf(ss * (1.0f / 128.0f) + EPS);
    const f32x4 g0 = *(const f32x4*)(gain + c8), g1 = *(const f32x4*)(gain + c8 + 4);
    v4u o; o.x = pk2(f0 * r * g0.x, f1 * r * g0.y); o.y = pk2(f2 * r * g0.z, f3 * r * g0.w); o.z = pk2(f4 * r * g1.x, f5 * r * g1.y); o.w = pk2(f6 * r * g1.z, f7 * r * g1.w);
    *(v4u*)(CN + (size_t)row * 128 + c8) = o;
}
typedef float f32x16 __attribute__((ext_vector_type(16)));
typedef short s16x4 __attribute__((ext_vector_type(4)));
#define MFMA32(a, b, c) __builtin_amdgcn_mfma_f32_32x32x16_bf16((a), (b), (c), 0, 0, 0)
__device__ __forceinline__ s16x4 vtr(const LAS unsigned char* p) { return __builtin_bit_cast(s16x4, __builtin_amdgcn_ds_read_tr16_b64_v4i16((LAS s16x4*)p)); }
__device__ __forceinline__ float xhalf_max(float v) { const unsigned u = __builtin_bit_cast(unsigned, v); auto rr = __builtin_amdgcn_permlane32_swap(u, u, false, false); return fmaxf(__builtin_bit_cast(float, (unsigned)rr[0]), __builtin_bit_cast(float, (unsigned)rr[1])); }
__device__ __forceinline__ float xhalf_sum(float v) { const unsigned u = __builtin_bit_cast(unsigned, v); auto rr = __builtin_amdgcn_permlane32_swap(u, u, false, false); return __builtin_bit_cast(float, (unsigned)rr[0]) + __builtin_bit_cast(float, (unsigned)rr[1]); }
__device__ __forceinline__ unsigned pkbf(float lo, float hi) { return pg8::cvt_pk_bf16(lo, hi); }
__device__ __forceinline__ unsigned pk4f8(float a, float b, float c, float d) { int w = __builtin_amdgcn_cvt_pk_fp8_f32(a * 16.0f, b * 16.0f, 0, false); return (unsigned)__builtin_amdgcn_cvt_pk_fp8_f32(c * 16.0f, d * 16.0f, w, true); }
template <int DK> __device__ __forceinline__ void qk_tile(const LAS unsigned char* Kt, const bf16x8 (&qf)[DK / 16], f32x16& p0, f32x16& p1, int r, int hh) {
#pragma unroll
    for (int i = 0; i < 16; ++i) { p0[i] = 0.f; p1[i] = 0.f; }
#pragma unroll
    for (int st = 0; st < DK / 16; ++st) {
        const bf16x8 k0 = *(const LAS bf16x8*)(Kt + ((2 * st + hh) * 64 + r) * 16);
        const bf16x8 k1 = *(const LAS bf16x8*)(Kt + ((2 * st + hh) * 64 + 32 + r) * 16);
        p0 = MFMA32(k0, qf[st], p0); p1 = MFMA32(k1, qf[st], p1);
    }
}
__device__ __forceinline__ float softmax_tile(f32x16& p0, f32x16& p1, float& m, float& l) {
    float mt = fmaxf(p0[0], p1[0]);
#pragma unroll
    for (int i = 1; i < 16; ++i) mt = fmaxf(mt, fmaxf(p0[i], p1[i]));
    mt = xhalf_max(mt);
    const float mn = fmaxf(m, mt);
    const float mu = (mn == -INFINITY) ? 0.f : mn;
    const float alpha = __builtin_amdgcn_exp2f(m - mu);
    float s = 0.f;
#pragma unroll
    for (int i = 0; i < 16; ++i) { p0[i] = __builtin_amdgcn_exp2f(p0[i] - mu); p1[i] = __builtin_amdgcn_exp2f(p1[i] - mu); s += p0[i] + p1[i]; }
    l = l * alpha + s; m = mn;
    return alpha;
}
constexpr float LOG2E = 1.4426950408889634f, QK_SCALE2 = 0.125f * LOG2E;
template <int DV> __device__ __forceinline__ void pv_tile(const LAS unsigned char* Vt, const f32x16& p0, const f32x16& p1, f32x16 (&o)[DV / 32], int lane) {
    const LAS unsigned char* vb = Vt + ((lane >> 4) & 1) * 32 + (lane & 3) * 8 + (4 * (lane >> 5) + ((lane & 15) >> 2)) * 64;
#pragma unroll
    for (int s = 0; s < 4; ++s) {
        const f32x16& p = (s < 2) ? p0 : p1; const int b0 = 8 * (s & 1);
        u32x4v pw; pw.x = pkbf(p[b0 + 0], p[b0 + 1]); pw.y = pkbf(p[b0 + 2], p[b0 + 3]); pw.z = pkbf(p[b0 + 4], p[b0 + 5]); pw.w = pkbf(p[b0 + 6], p[b0 + 7]);
        const bf16x8 pf = __builtin_bit_cast(bf16x8, pw);
#pragma unroll
        for (int db = 0; db < DV / 32; ++db) {
            const s16x4 lo = vtr(vb + db * 4096 + s * 1024), hi = vtr(vb + db * 4096 + s * 1024 + 512);
            const bf16x8 vf = (bf16x8){lo[0], lo[1], lo[2], lo[3], hi[0], hi[1], hi[2], hi[3]};
            o[db] = MFMA32(vf, pf, o[db]);
        }
    }
}
__device__ __forceinline__ void sel_unit(const bf16* PA, float* SC, unsigned long long* MASK, int b, int qt, LAS unsigned char* lds, int tid, int wave, int lane) {
    const int r = lane & 31, hh = lane >> 5;
    if (qt >= 8) {
        const int t = 32 * qt + r, row = b * T + t;
        LAS unsigned char* qs = lds + 65536;
        { int tq = tid; asm volatile("" : "+v"(tq));
          v4u tq4[3];
#pragma unroll
          for (int k = 0; k < 3; ++k) { const int c = tq + NWAVES * 64 * k, cc = c < 32 * 33 ? c : 0; const int rr = cc / 33, j = cc - 33 * rr;
              tq4[k] = *(const v4u*)(PA + (size_t)(b * T + 32 * qt + rr) * PA_LD + (j < 32 ? C_IQ + 8 * j : C_IW)); }
#pragma unroll
          for (int k = 0; k < 3; ++k) { const int c = tq + NWAVES * 64 * k; if (c < 32 * 33) { const int rr = c / 33, j = c - 33 * rr; *(LAS v4u*)(qs + rr * 528 + 16 * j) = tq4[k]; } } }
        __syncthreads();
        const int NT = (qt >> 1) + 1;
        int rk = r; asm volatile("" : "+v"(rk));
        const LAS unsigned char* qr = qs + rk * 528 + 16 * hh;
        bf16x8 k00, k01, k10, k11;
        if (wave < NT) { const bf16* kp = PA + (size_t)(b * T + 64 * wave + rk) * PA_LD + C_IK + 8 * hh;
            k00 = *(const bf16x8*)kp; k01 = *(const bf16x8*)(kp + 16); k10 = *(const bf16x8*)(kp + (size_t)32 * PA_LD); k11 = *(const bf16x8*)(kp + (size_t)32 * PA_LD + 16); }
#pragma unroll 1
        for (int tt = wave; tt < NT; tt += NWAVES) {
            const int s0 = 64 * tt;
            const bf16x8 c00 = k00, c01 = k01, c10 = k10, c11 = k11;
            { const int tn = (tt + NWAVES < NT) ? tt + NWAVES : tt;
              const bf16* kp = PA + (size_t)(b * T + 64 * tn + rk) * PA_LD + C_IK + 8 * hh;
              k00 = *(const bf16x8*)kp; k01 = *(const bf16x8*)(kp + 16); k10 = *(const bf16x8*)(kp + (size_t)32 * PA_LD); k11 = *(const bf16x8*)(kp + (size_t)32 * PA_LD + 16); }
            f32x16 s0a, s1a;
#pragma unroll
            for (int i = 0; i < 16; ++i) { s0a[i] = 0.f; s1a[i] = 0.f; }
            bf16x8 q0 = *(const LAS bf16x8*)qr, q1 = *(const LAS bf16x8*)(qr + 32); unsigned iwb = *(const LAS unsigned short*)(qs + rk * 528 + 512);
#pragma unroll 1
            for (int h = 0; h < 8; ++h) {
                const int hn = (h + 1) & 7;
                const bf16x8 q0n = *(const LAS bf16x8*)(qr + 64 * hn), q1n = *(const LAS bf16x8*)(qr + 64 * hn + 32); const unsigned iwn = *(const LAS unsigned short*)(qs + rk * 528 + 512 + 2 * hn);
                const float iwh = __builtin_bit_cast(float, iwb << 16);
                f32x16 a0, a1;
#pragma unroll
                for (int i = 0; i < 16; ++i) { a0[i] = 0.f; a1[i] = 0.f; }
                a0 = MFMA32(c00, q0, a0); a0 = MFMA32(c01, q1, a0);
                a1 = MFMA32(c10, q0, a1); a1 = MFMA32(c11, q1, a1);
#pragma unroll
                for (int i = 0; i < 16; ++i) { s0a[i] = fmaf(iwh, fmaxf(a0[i], 0.f), s0a[i]); s1a[i] = fmaf(iwh, fmaxf(a1[i], 0.f), s1a[i]); }
                q0 = q0n; q1 = q1n; iwb = iwn;
            }
            { LAS unsigned char* tl = lds + wave * 8192; int rw = rk; asm volatile("" : "+v"(rw));
#pragma unroll
              for (int g = 0; g < 4; ++g) { *(LAS f32x4*)(tl + rw * 256 + (((2 * g + hh) ^ (rw & 15)) << 4)) = (f32x4){s0a[4 * g], s0a[4 * g + 1], s0a[4 * g + 2], s0a[4 * g + 3]};
                  *(LAS f32x4*)(tl + rw * 256 + (((8 + 2 * g + hh) ^ (rw & 15)) << 4)) = (f32x4){s1a[4 * g], s1a[4 * g + 1], s1a[4 * g + 2], s1a[4 * g + 3]}; }
              LDS_WAIT(); asm volatile("" ::: "memory");
              const int rr0 = (rw + 32 * hh) >> 4, cc = (rw + 32 * hh) & 15;
              float* sp = SC + (size_t)(b * T + 32 * qt) * 2048 + s0 + 4 * cc;
#pragma unroll
              for (int it = 0; it < 8; ++it) { const int rr = 4 * it + rr0; *(f32x4*)(sp + (size_t)rr * 2048) = *(const LAS f32x4*)(tl + rr * 256 + ((cc ^ (rr & 15)) << 4)); }
              LDS_WAIT(); asm volatile("" ::: "memory"); }
        }
    }
    __syncthreads();
#define SEL_CNT4(pred, a0_, a1_, a2_, a3_, thr_, acc_) do { unsigned long long m0_, m1_, m2_, m3_; \
        asm("v_cmp_" pred "_u32_e64 %0, %4, %8\n\tv_cmp_" pred "_u32_e64 %1, %5, %8\n\tv_cmp_" pred "_u32_e64 %2, %6, %8\n\tv_cmp_" pred "_u32_e64 %3, %7, %8" \
            : "=&s"(m0_), "=&s"(m1_), "=&s"(m2_), "=&s"(m3_) : "v"(a0_), "v"(a1_), "v"(a2_), "v"(a3_), "v"(thr_)); \
        acc_ += (__popcll(m0_) + __popcll(m1_)) + (__popcll(m2_) + __popcll(m3_)); } while (0)
    float nv[32];
    { const int t0 = 32 * qt + 4 * wave; int ls0 = lane; asm volatile("" : "+v"(ls0));
      if (t0 >= 256) { const float* srow = SC + (size_t)(b * T + t0) * 2048 + ls0; const int ng0 = (t0 >> 6) + 1;
#pragma unroll
          for (int g = 0; g < 4; ++g) if (8 * g < ng0) {
#pragma unroll
              for (int jj = 0; jj < 8; ++jj) nv[8 * g + jj] = srow[64 * (8 * g + jj)]; } } }
#pragma unroll 1
    for (int qi = 0; qi < 4; ++qi) {
        const int t = 32 * qt + 4 * wave + qi, row = b * T + t;
        unsigned long long* mrow = MASK + (size_t)row * 32;
        if (t < 256) {
            if (lane < 32) { const int lo = 64 * lane; unsigned long long m = 0ull; if (t >= lo + 63) m = ~0ull; else if (t >= lo) m = (2ull << (t - lo)) - 1ull; mrow[lane] = m; }
            continue;
        }
        int ls = lane; asm volatile("" : "+v"(ls));
        unsigned keys[32];
#pragma unroll
        for (int j = 0; j < 32; ++j) keys[j] = ((j >> 3) <= (t >> 9)) ? ((64 * j + ls <= t) ? fkey(nv[j]) : 0u) : 0u;
        if (qi < 3) { const float* srow = SC + (size_t)(row + 1) * 2048 + ls; const int ngn = ((t + 1) >> 6) + 1;
#pragma unroll
            for (int g = 0; g < 4; ++g) if (8 * g < ngn) {
#pragma unroll
                for (int jj = 0; jj < 8; ++jj) nv[8 * g + jj] = srow[64 * (8 * g + jj)]; } }
        unsigned tau = 0u;
#define SEL_SEARCH(NG) do { _Pragma("unroll 1") for (int bit = 31; bit >= 0; --bit) { \
            const unsigned cand = tau | (1u << bit); int cnt = 0; \
            _Pragma("unroll") for (int g = 0; g < (NG); ++g) SEL_CNT4("ge", keys[4 * g], keys[4 * g + 1], keys[4 * g + 2], keys[4 * g + 3], cand, cnt); \
            if (cnt >= 256) tau = cand; \
            if (cnt == 256) break; } } while (0)
        { const int sp = t >> 9;
          if (sp == 0) SEL_SEARCH(2); else if (sp == 1) SEL_SEARCH(4); else if (sp == 2) SEL_SEARCH(6); else SEL_SEARCH(8); }
#undef SEL_SEARCH
        int need = 256; unsigned mlo = 0u, mhi = 0u;
#pragma unroll
        for (int g = 0; g < 8; ++g) if ((g >> 1) <= (t >> 9)) { int c_ = 0; SEL_CNT4("gt", keys[4 * g], keys[4 * g + 1], keys[4 * g + 2], keys[4 * g + 3], tau, c_); need -= c_; }
#pragma unroll
        for (int j = 0; j < 32; ++j) if ((j >> 3) <= (t >> 9)) {
            unsigned long long eq, gt;
            asm("v_cmp_eq_u32_e64 %0, %2, %3\n\tv_cmp_gt_u32_e64 %1, %2, %3" : "=&s"(eq), "=&s"(gt) : "v"(keys[j]), "v"(tau));
            const int c = __popcll(eq); unsigned long long take;
            if (c <= need) { take = eq; need -= c; } else { take = __ballot((keys[j] == tau) && (mbcnt64(eq) < need)); need = 0; }
            const unsigned long long mm = gt | take;
            asm("v_writelane_b32 %0, %2, %4\n\tv_writelane_b32 %1, %3, %4" : "+v"(mlo), "+v"(mhi) : "s"((unsigned)mm), "s"((unsigned)(mm >> 32)), "n"(j));
        }
        if (lane < 32) mrow[lane] = ((unsigned long long)mhi << 32) | mlo;
    }
#undef SEL_CNT4
    __syncthreads();
}
constexpr int AT_K0 = 0, AT_K1 = 8192, AT_V0 = 16384, AT_V1 = 24576, AT_RB = 32768, MOBA_RBN = 2048 + 320;
__device__ __forceinline__ void moba_unit(const bf16* PA, const float* biasd, const float* KM, bf16* YB, int b, int h, int n, LAS unsigned char* lds, int tid, int wave, int lane) {
    const int r = lane & 31, hh = lane >> 5;
    const int t = 256 * n + 32 * wave + r, row = b * T + t;
    LAS float* RB = (LAS float*)(lds + AT_RB);
    __syncthreads();
    { int tf = tid; asm volatile("" : "+v"(tf)); float tv[4];
#pragma unroll
      for (int k = 0; k < 4; ++k) tv[k] = biasd[(16 + h) * 2048 + 2047 - (tf + NWAVES * 64 * k)];
#pragma unroll
      for (int k = 0; k < 4; ++k) RB[tf + NWAVES * 64 * k] = tv[k] * LOG2E;
      if (tf + 2048 < MOBA_RBN) RB[tf + 2048] = -INFINITY; }
    bf16x8 qf[4];
    const bf16* qp = PA + (size_t)row * PA_LD + C_QB + h * 64;
#pragma unroll
    for (int st = 0; st < 4; ++st) qf[st] = *(const bf16x8*)(qp + 16 * st + 8 * hh);
    unsigned selmask = (1u << n) - 1u;
    if (n > 3) {
        int z = 0; asm volatile("" : "+v"(z));
        float gv[8];
#pragma unroll
        for (int nn = 0; nn < 8; ++nn) gv[nn] = 0.f;
#pragma unroll 1
        for (int d8 = 0; d8 < 8; ++d8) {
            const v4u qv = *(const v4u*)(qp + 8 * d8);
            const float q0 = bflo(qv.x), q1 = bfhi(qv.x), q2 = bflo(qv.y), q3 = bfhi(qv.y), q4 = bflo(qv.z), q5 = bfhi(qv.z), q6 = bflo(qv.w), q7 = bfhi(qv.w);
#pragma unroll
            for (int nn = 0; nn < 7; ++nn) { const float* kmp = KM + ((b * 8 + nn) * 8 + h) * 64 + 8 * d8 + z; const f32x4 ka = *(const f32x4*)kmp, kb = *(const f32x4*)(kmp + 4);
                gv[nn] += (q0 * ka.x + q1 * ka.y) + (q2 * ka.z + q3 * ka.w) + (q4 * kb.x + q5 * kb.y) + (q6 * kb.z + q7 * kb.w); }
        }
#pragma unroll
        for (int nn = 0; nn < 8; ++nn) if (nn >= n) gv[nn] = -INFINITY;
        selmask = 0u;
#pragma unroll
        for (int rr = 0; rr < 3; ++rr) { int bi = 0; float bv = gv[0];
#pragma unroll
            for (int nn = 1; nn < 8; ++nn) if (gv[nn] > bv) { bv = gv[nn]; bi = nn; }
            selmask |= 1u << bi;
#pragma unroll
            for (int nn = 0; nn < 8; ++nn) if (nn == bi) gv[nn] = -INFINITY; }
    }
    f32x16 o[2];
#pragma unroll
    for (int i = 0; i < 16; ++i) { o[0][i] = 0.f; o[1][i] = 0.f; }
    float m = -INFINITY, l = 0.f;
    const int NT = 4 * (n + 1);
    const int skey = tid >> 3, sc = tid & 7;
    const bf16* Kg = PA + (size_t)(b * T + skey) * PA_LD + C_KB + h * 64 + sc * 8;
    const bf16* Vg = PA + (size_t)(b * T + skey) * PA_LD + C_VB + h * 64 + sc * 8;
    const int kwo = (sc * 64 + skey) * 16, vwo = (sc >> 2) * 4096 + skey * 64 + (sc & 3) * 16;
    v4u kreg = *(const v4u*)Kg, vreg = *(const v4u*)Vg;
    *(LAS v4u*)(lds + AT_K0 + kwo) = kreg; *(LAS v4u*)(lds + AT_V0 + vwo) = vreg;
    __syncthreads();
#pragma unroll 1
    for (int tt = 0; tt < NT; ++tt) {
        const int s0 = 64 * tt, buf = tt & 1;
        if (tt + 1 < NT) { kreg = *(const v4u*)(Kg + (size_t)(s0 + 64) * PA_LD); vreg = *(const v4u*)(Vg + (size_t)(s0 + 64) * PA_LD); }
        const bool own = (tt >> 2) == n;
        if (!own || s0 <= 256 * n + 32 * wave + 31) {
            f32x16 p0, p1;
            qk_tile<64>(lds + (buf ? AT_K1 : AT_K0), qf, p0, p1, r, hh);
            const int dl = t - s0 - 4 * hh;
            const bool selv = own || ((selmask >> (tt >> 2)) & 1u);
            const LAS float* rb = selv ? RB + (2047 - dl) : RB + 2176;
#pragma unroll
            for (int i = 0; i < 16; ++i) { const int c0 = (i & 3) + 8 * (i >> 2); p0[i] = fmaf(p0[i], QK_SCALE2, rb[c0]); p1[i] = fmaf(p1[i], QK_SCALE2, rb[c0 + 32]); }
            const float alpha = softmax_tile(p0, p1, m, l);
            if (__any(alpha != 1.0f)) {
#pragma unroll
                for (int i = 0; i < 16; ++i) { o[0][i] *= alpha; o[1][i] *= alpha; } }
            pv_tile<64>(lds + (buf ? AT_V1 : AT_V0), p0, p1, o, lane);
        }
        if (tt + 1 < NT) { *(LAS v4u*)(lds + (buf ? AT_K0 : AT_K1) + kwo) = kreg; *(LAS v4u*)(lds + (buf ? AT_V0 : AT_V1) + vwo) = vreg; }
        __syncthreads();
    }
    const float inv = 1.0f / xhalf_sum(l);
    unsigned char* yp = (unsigned char*)YB + (size_t)row * 2048 + 1024 + h * 64 + 4 * hh;
#pragma unroll
    for (int db = 0; db < 2; ++db)
#pragma unroll
        for (int g = 0; g < 4; ++g) *(unsigned*)(yp + 32 * db + 8 * g) = pk4f8(o[db][4 * g] * inv, o[db][4 * g + 1] * inv, o[db][4 * g + 2] * inv, o[db][4 * g + 3] * inv);
}
constexpr int SWA_RBN = 260;
__device__ __forceinline__ void swa_unit(const bf16* PA, const float* biasd, const float* sinks, bf16* YA, int b, int kvh, int qb, LAS unsigned char* lds, int tid, int wave, int lane) {
    const int r = lane & 31, hh = lane >> 5, g = wave >> 1, hq = kvh * 4 + g;
    const int t = 64 * qb + 32 * (wave & 1) + r, row = b * T + t;
    LAS float* RBall = (LAS float*)(lds + AT_RB);
    __syncthreads();
    { int tf = tid; asm volatile("" : "+v"(tf)); float tv[3];
#pragma unroll
      for (int k = 0; k < 3; ++k) { const int j = tf + NWAVES * 64 * k; const int jc = j < 4 * SWA_RBN ? j : 0; const int gg = jc / SWA_RBN, jj = jc - gg * SWA_RBN; tv[k] = biasd[(kvh * 4 + gg) * 2048 + ((jj >= 64 && jj < 192) ? 191 - jj : 0)]; }
#pragma unroll
      for (int k = 0; k < 3; ++k) { const int j = tf + NWAVES * 64 * k; if (j < 4 * SWA_RBN) { const int gg = j / SWA_RBN, jj = j - gg * SWA_RBN; RBall[j] = (jj >= 64 && jj < 192) ? tv[k] * LOG2E : -INFINITY; } } }
    const LAS float* RB = RBall + g * SWA_RBN;
    bf16x8 qf[4];
    const bf16* qp = PA + (size_t)row * PA_LD + C_QA + hq * 64;
#pragma unroll
    for (int st = 0; st < 4; ++st) qf[st] = *(const bf16x8*)(qp + 16 * st + 8 * hh);
    f32x16 o[2];
#pragma unroll
    for (int i = 0; i < 16; ++i) { o[0][i] = 0.f; o[1][i] = 0.f; }
    float m = -INFINITY, l = 0.f;
    const int tt0 = qb >= 2 ? qb - 2 : 0;
    const int skey = tid >> 3, sc = tid & 7;
    const bf16* Kg = PA + (size_t)(b * T + skey) * PA_LD + C_KA + kvh * 64 + sc * 8;
    const bf16* Vg = PA + (size_t)(b * T + skey) * PA_LD + C_VA + kvh * 64 + sc * 8;
    const int kwo = (sc * 64 + skey) * 16, vwo = (sc >> 2) * 4096 + skey * 64 + (sc & 3) * 16;
    v4u kreg = *(const v4u*)(Kg + (size_t)(64 * tt0) * PA_LD), vreg = *(const v4u*)(Vg + (size_t)(64 * tt0) * PA_LD);
    *(LAS v4u*)(lds + AT_K0 + kwo) = kreg; *(LAS v4u*)(lds + AT_V0 + vwo) = vreg;
    __syncthreads();
#pragma unroll 1
    for (int tt = tt0; tt <= qb; ++tt) {
        const int s0 = 64 * tt, buf = (tt - tt0) & 1;
        if (tt < qb) { kreg = *(const v4u*)(Kg + (size_t)(s0 + 64) * PA_LD); vreg = *(const v4u*)(Vg + (size_t)(s0 + 64) * PA_LD); }
        {
            f32x16 p0, p1;
            qk_tile<64>(lds + (buf ? AT_K1 : AT_K0), qf, p0, p1, r, hh);
            const int dl = t - s0 - 4 * hh;
            const LAS float* rb = RB + (191 - dl);
#pragma unroll
            for (int i = 0; i < 16; ++i) { const int c0 = (i & 3) + 8 * (i >> 2); p0[i] = fmaf(p0[i], QK_SCALE2, rb[c0]); p1[i] = fmaf(p1[i], QK_SCALE2, rb[c0 + 32]); }
            const float alpha = softmax_tile(p0, p1, m, l);
            if (__any(alpha != 1.0f)) {
#pragma unroll
                for (int i = 0; i < 16; ++i) { o[0][i] *= alpha; o[1][i] *= alpha; } }
            pv_tile<64>(lds + (buf ? AT_V1 : AT_V0), p0, p1, o, lane);
        }
        if (tt < qb) { *(LAS v4u*)(lds + (buf ? AT_K0 : AT_K1) + kwo) = kreg; *(LAS v4u*)(lds + (buf ? AT_V0 : AT_V1) + vwo) = vreg; }
        __syncthreads();
    }
    const float inv = 1.0f / (xhalf_sum(l) + __builtin_amdgcn_exp2f(sinks[hq] * LOG2E - m));
    unsigned char* yp = (unsigned char*)YA + (size_t)row * 2048 + hq * 64 + 4 * hh;
#pragma unroll
    for (int db = 0; db < 2; ++db)
#pragma unroll
        for (int gq = 0; gq < 4; ++gq) *(unsigned*)(yp + 32 * db + 8 * gq) = pk4f8(o[db][4 * gq] * inv, o[db][4 * gq + 1] * inv, o[db][4 * gq + 2] * inv, o[db][4 * gq + 3] * inv);
}
constexpr int DS_K0 = 0, DS_V0 = 16384, DS_K1 = 32768, DS_V1 = 49152, DS_RB = 65536, DS_RBN = 2048 + 128;
static_assert(DS_RB + 8 * DS_RBN * 4 <= LDSCTL_OFF, "DSA LDS map");
__device__ __forceinline__ bf16x8 pack8(const f32x4 a, const f32x4 b) { u32x4v w; w.x = pkbf(a.x, a.y); w.y = pkbf(a.z, a.w); w.z = pkbf(b.x, b.y); w.w = pkbf(b.z, b.w); return __builtin_bit_cast(bf16x8, w); }
template <bool FILL>
__device__ __forceinline__ void dsa_unit(const bf16* CN, const bf16* PA, const unsigned long long* MASK, const float* biasd, const bf16* WUKB, const bf16* WUVT, bf16* YC, int b, int qt, LAS unsigned char* lds, int tid, int wave, int lane) {
    const int r = lane & 31, hh = lane >> 5, h = wave;
    const int t = 32 * qt + r, row = b * T + t;
    __syncthreads();
    if constexpr (FILL) {
    static_assert(8 * DS_RBN == 34 * NWAVES * 64, "DSA bias table fill");
    { int tf = tid; asm volatile("" : "+v"(tf));
#pragma unroll 1
      for (int hfill = 0; hfill < 2; ++hfill) { float tv[17];
#pragma unroll
          for (int k = 0; k < 17; ++k) { const int j = tf + NWAVES * 64 * (17 * hfill + k); const int hd = j / DS_RBN, jj = j - hd * DS_RBN; tv[k] = biasd[(24 + hd) * 2048 + (jj < 2048 ? 2047 - jj : 0)]; }
#pragma unroll
          for (int k = 0; k < 17; ++k) { const int j = tf + NWAVES * 64 * (17 * hfill + k); const int hd = j / DS_RBN, jj = j - hd * DS_RBN; ((LAS float*)(lds + DS_RB))[j] = jj < 2048 ? tv[k] * LOG2E : 0.f; } } }
    }
    const LAS float* RB = (const LAS float*)(lds + DS_RB) + h * DS_RBN;
    bf16x8 qa[8];
    { const bf16* qp = PA + (size_t)row * PA_LD + C_QC + h * 64;
      int rq = r; asm volatile("" : "+v"(rq));
      bf16x8 qh[4];
#pragma unroll
      for (int st = 0; st < 4; ++st) qh[st] = *(const bf16x8*)(qp + 16 * st + 8 * hh);
#pragma unroll
      for (int cb = 0; cb < 4; ++cb) { f32x16 acc;
#pragma unroll
          for (int i = 0; i < 16; ++i) acc[i] = 0.f;
#pragma unroll
          for (int st = 0; st < 4; ++st) acc = MFMA32(*(const bf16x8*)(WUKB + ((size_t)h * 128 + 32 * cb + rq) * 64 + 16 * st + 8 * hh), qh[st], acc);
          qa[2 * cb] = pack8((f32x4){acc[0], acc[1], acc[2], acc[3]}, (f32x4){acc[4], acc[5], acc[6], acc[7]});
          qa[2 * cb + 1] = pack8((f32x4){acc[8], acc[9], acc[10], acc[11]}, (f32x4){acc[12], acc[13], acc[14], acc[15]});
          asm volatile("" ::: "memory"); } }
    f32x16 o[4];
#pragma unroll
    for (int db = 0; db < 4; ++db)
#pragma unroll
        for (int i = 0; i < 16; ++i) o[db][i] = 0.f;
    float m = -INFINITY, l = 0.f;
    const int NT = (qt >> 1) + 1;
    const int skey = tid >> 4, sc = tid & 15;
    const bf16* Cg = CN + (size_t)(b * T + skey) * 128 + sc * 8;
    const int kwo = (sc * 64 + skey) * 16, vwo = (sc >> 2) * 4096 + skey * 64 + (sc & 3) * 16;
    v4u c0r = *(const v4u*)Cg, c1r = *(const v4u*)(Cg + 32 * 128);
    *(LAS v4u*)(lds + DS_K0 + kwo) = c0r; *(LAS v4u*)(lds + DS_K0 + kwo + 512) = c1r; *(LAS v4u*)(lds + DS_V0 + vwo) = c0r; *(LAS v4u*)(lds + DS_V0 + vwo + 2048) = c1r;
    const unsigned long long* mrow = MASK + (size_t)row * 32;
    __syncthreads();
#pragma unroll 1
    for (int tt = 0; tt < NT; ++tt) {
        const int s0 = 64 * tt, buf = tt & 1;
        if (tt + 1 < NT) { c0r = *(const v4u*)(Cg + (size_t)(s0 + 64) * 128); c1r = *(const v4u*)(Cg + (size_t)(s0 + 96) * 128); }
        const unsigned long long mw = mrow[tt];
        {
            const LAS unsigned char* Kt = lds + DS_K0 + buf * 32768;
            f32x16 p0, p1;
#pragma unroll
            for (int i = 0; i < 16; ++i) { p0[i] = 0.f; p1[i] = 0.f; }
#pragma unroll
            for (int ks = 0; ks < 8; ++ks) {
                const LAS unsigned char* ka = Kt + ((2 * ks) * 64 + r) * 16 + 8 * hh;
                const s16x4 a0 = *(const LAS s16x4*)ka, a1 = *(const LAS s16x4*)(ka + 1024), b0 = *(const LAS s16x4*)(ka + 512), b1 = *(const LAS s16x4*)(ka + 1024 + 512);
                p0 = MFMA32(((bf16x8){a0[0], a0[1], a0[2], a0[3], a1[0], a1[1], a1[2], a1[3]}), qa[ks], p0);
                p1 = MFMA32(((bf16x8){b0[0], b0[1], b0[2], b0[3], b1[0], b1[1], b1[2], b1[3]}), qa[ks], p1);
                if ((ks & 3) == 3) asm volatile("" ::: "memory");
            }
            const int dl = t - s0 - 4 * hh;
            const LAS float* rb = RB + (2047 - dl);
            const unsigned wlo = (unsigned)mw >> (4 * hh), whi = (unsigned)(mw >> 32) >> (4 * hh);
#pragma unroll
            for (int i = 0; i < 16; ++i) { const int c0 = (i & 3) + 8 * (i >> 2);
                const float v0 = fmaf(p0[i], QK_SCALE2, rb[c0]), v1 = fmaf(p1[i], QK_SCALE2, rb[c0 + 32]);
                const unsigned k0_ = (unsigned)__builtin_amdgcn_sbfe((int)wlo, c0, 1), k1_ = (unsigned)__builtin_amdgcn_sbfe((int)whi, c0, 1);
                p0[i] = __builtin_bit_cast(float, (__builtin_bit_cast(unsigned, v0) & k0_) | (0xff800000u & ~k0_)); p1[i] = __builtin_bit_cast(float, (__builtin_bit_cast(unsigned, v1) & k1_) | (0xff800000u & ~k1_));
                if ((i & 3) == 3) asm volatile("" ::: "memory"); }
            const float alpha = softmax_tile(p0, p1, m, l);
            if (__any(alpha != 1.0f)) {
#pragma unroll
            for (int db = 0; db < 4; ++db)
#pragma unroll
                for (int i = 0; i < 16; ++i) o[db][i] *= alpha; }
            pv_tile<128>(lds + DS_V0 + buf * 32768, p0, p1, o, lane);
        }
        if (tt + 1 < NT) { LAS unsigned char* Kn = lds + DS_K0 + (32768 - buf * 32768); LAS unsigned char* Vn = lds + DS_V0 + (32768 - buf * 32768);
            *(LAS v4u*)(Kn + kwo) = c0r; *(LAS v4u*)(Kn + kwo + 512) = c1r; *(LAS v4u*)(Vn + vwo) = c0r; *(LAS v4u*)(Vn + vwo + 2048) = c1r; }
        __syncthreads();
    }
    const float inv = 1.0f / xhalf_sum(l);
    int re = r; asm volatile("" : "+v"(re));
    unsigned char* yp = (unsigned char*)YC + (size_t)(b * T + 32 * qt + re) * 2048 + 1536 + h * 64 + 4 * hh;
#pragma unroll
    for (int db2 = 0; db2 < 2; ++db2) {
        f32x16 acc;
#pragma unroll
        for (int i = 0; i < 16; ++i) acc[i] = 0.f;
#pragma unroll
        for (int ks = 0; ks < 8; ++ks) {
            const int cb = ks >> 1, b0 = 8 * (ks & 1);
            const bf16x8 ob = pack8((f32x4){o[cb][b0] * inv, o[cb][b0 + 1] * inv, o[cb][b0 + 2] * inv, o[cb][b0 + 3] * inv}, (f32x4){o[cb][b0 + 4] * inv, o[cb][b0 + 5] * inv, o[cb][b0 + 6] * inv, o[cb][b0 + 7] * inv});
            const bf16* wp = WUVT + ((size_t)h * 64 + 32 * db2 + re) * 128 + 16 * ks + 4 * hh;
            const s16x4 w0 = *(const s16x4*)wp, w1 = *(const s16x4*)(wp + 8);
            const bf16x8 wf = (bf16x8){w0[0], w0[1], w0[2], w0[3], w1[0], w1[1], w1[2], w1[3]};
            acc = MFMA32(wf, ob, acc);
            if (ks & 1) asm volatile("" ::: "memory");
        }
#pragma unroll
        for (int g = 0; g < 4; ++g) *(unsigned*)(yp + 32 * db2 + 8 * g) = pk4f8(acc[4 * g], acc[4 * g + 1], acc[4 * g + 2], acc[4 * g + 3]);
    }
}
#ifndef NREP_ROUTE
#define NREP_ROUTE 1
#endif
constexpr int PU_RI = 0, PU_RG = 16384, PU_RSTD = 32768, PU_TOP = 33024, PU_EX = PU_TOP + 8 * 8192, PU_END = PU_EX + 8 * 4096;
static_assert(PU_END <= LDSCTL_OFF, "PEER unit LDS map");
#define CE_DESC(a, b) do { const unsigned hi_ = (a) > (b) ? (a) : (b); (b) = (a) > (b) ? (b) : (a); (a) = hi_; } while (0)
template <int B, typename A> __device__ __forceinline__ void sort16_desc(A& v) {
#pragma unroll
    for (int ks = 1; ks <= 4; ++ks)
#pragma unroll
        for (int js = ks - 1; js >= 0; --js)
#pragma unroll
            for (int i = 0; i < 16; ++i) { const int k = 1 << ks, j = 1 << js, l = i ^ j; if (l > i) { if ((i & k) == 0) CE_DESC(v[B + i], v[B + l]); else CE_DESC(v[B + l], v[B + i]); } }
}
template <int B0, int B1, typename A> __device__ __forceinline__ void merge16_desc(A& v) {
#pragma unroll
    for (int i = 0; i < 16; ++i) v[B0 + i] = v[B0 + i] > v[B1 + 15 - i] ? v[B0 + i] : v[B1 + 15 - i];
#pragma unroll
    for (int js = 3; js >= 0; --js)
#pragma unroll
        for (int i = 0; i < 16; ++i) { const int j = 1 << js, l = i ^ j; if (l > i) CE_DESC(v[B0 + i], v[B0 + l]); }
}
template <typename A> __device__ __forceinline__ void top16_of_64(A& v) {
    sort16_desc<0>(v); sort16_desc<16>(v); merge16_desc<0, 16>(v);
    sort16_desc<32>(v); sort16_desc<48>(v); merge16_desc<32, 48>(v);
    merge16_desc<0, 32>(v);
}
__device__ __forceinline__ void peer_route(const Ptrs& P, int l, int unit, LAS unsigned char* lds, int tid, int wave, int lane) {
    unsigned char* ws = P.ws;
    float* RSTD = (float*)(ws + WS_RSTD) + unit * 32; int* RI = (int*)(ws + WS_RI) + (size_t)unit * 32 * 128; float* RG = (float*)(ws + WS_RG) + (size_t)unit * 32 * 128;
    const bf16* QP = (const bf16*)(ws + WS_QP);
    const int r0 = unit * 32;
    const float* rowssB = (const float*)(ws + WS_ROWSSB);
    __syncthreads();
#pragma unroll 1
    for (int rrep = 0; rrep < NREP_ROUTE; ++rrep)
    {
        const int r = lane & 31, hh = lane >> 5, h = wave;
        const bf16* SKB = (const bf16*)(ws + WS_SKB) + (size_t)(l * 8 + h) * 2 * 16384;
        float rs; { const float* pp = rowssB + (size_t)(r0 + r) * 32; float a = 0.f;
#pragma unroll
            for (int j = 0; j < 8; ++j) { const f32x4 v = *(const f32x4*)(pp + 4 * j); a += (v.x + v.y) + (v.z + v.w); }
            rs = rsqrtf(a * (1.0f / 2048.0f) + EPS); }
        if (hh == 0 && h == 0) RSTD[r] = rs;
        LAS float* EXL = (LAS float*)(lds + PU_EX) + wave * 1024;
        LAS unsigned* TOPL = (LAS unsigned*)(lds + PU_TOP) + wave * 2048;
#pragma unroll 1
        for (int p = 0; p < 2; ++p) {
            bf16x8 qf[8];
            { int rq = r; asm volatile("" : "+v"(rq)); const bf16* qr2 = QP + (size_t)(r0 + rq) * 2048 + h * 256 + p * 128 + 8 * hh;
#pragma unroll
            for (int st = 0; st < 8; ++st) qf[st] = *(const bf16x8*)(qr2 + 16 * st); }
            unsigned kv[64];
            int rk = r; asm volatile("" : "+v"(rk));
            const bf16* skp = SKB + ((size_t)p * 128 + rk) * 128 + 8 * hh;
            bf16x8 sf[8];
#pragma unroll
            for (int st = 0; st < 8; ++st) sf[st] = *(const bf16x8*)(skp + 16 * st);
#pragma unroll
            for (int kb = 0; kb < 4; ++kb) {
                f32x16 acc;
#pragma unroll
                for (int i = 0; i < 16; ++i) acc[i] = 0.f;
                bf16x8 cf[8];
#pragma unroll
                for (int st = 0; st < 8; ++st) cf[st] = sf[st];
                if (kb < 3) {
#pragma unroll
                    for (int st = 0; st < 8; ++st) sf[st] = *(const bf16x8*)(skp + (size_t)(32 * (kb + 1)) * 128 + 16 * st); }
#pragma unroll
                for (int st = 0; st < 8; ++st) acc = MFMA32(cf[st], qf[st], acc);
#pragma unroll
                for (int i = 0; i < 16; ++i) kv[16 * kb + i] = (fkey(acc[i]) & ~127u) | (unsigned)(127 - (32 * kb + (i & 3) + 8 * (i >> 2) + 4 * hh));
                asm volatile("" ::: "memory");
            }
            top16_of_64(kv);
#pragma unroll
            for (int i = 0; i < 16; ++i) { const unsigned own = kv[i]; auto rr = __builtin_amdgcn_permlane32_swap(own, own, false, false); kv[16 + i] = (rr[0] == own) ? rr[1] : rr[0]; }
            merge16_desc<0, 16>(kv);
#pragma unroll
            for (int it = 0; it < 16; ++it) TOPL[(p * 16 + it) * 64 + lane] = kv[it];
        }
        LDS_WAIT(); asm volatile("" ::: "memory");
        unsigned ck[64];
        { float sa[16], sb[16];
#pragma unroll
          for (int j = 0; j < 16; ++j) { sa[j] = funkey(TOPL[j * 64 + lane] & ~127u); sb[j] = funkey(TOPL[(16 + j) * 64 + lane] & ~127u); }
          int pi = 0;
#pragma unroll
          for (int a = 0; a < 16; ++a)
#pragma unroll
              for (int bq = 0; bq < 16; ++bq) if ((a + 1) * (bq + 1) <= 16) { ck[pi] = (fkey(sa[a] + sb[bq]) & ~255u) | (unsigned)(255 - (a * 16 + bq)); ++pi; }
#pragma unroll
          for (int i = 50; i < 64; ++i) ck[i] = 0u; }
        top16_of_64(ck);
        float mx = 0.f, sm = 0.f;
#pragma unroll
        for (int it = 0; it < 16; ++it) {
            const unsigned m = ck[it];
            const int ab = 255 - (int)(m & 255u), a = ab >> 4, bq = ab & 15;
            const unsigned ka = TOPL[a * 64 + lane], kb2 = TOPL[(16 + bq) * 64 + lane];
            const float sc = funkey(m & ~255u) * rs;
            if (it == 0) mx = sc;
            const float e = __expf(sc - mx); sm += e;
            EXL[it * 64 + lane] = e;
            if (hh == 0) RI[r * 128 + h * 16 + it] = (127 - (int)(ka & 127u)) * 128 + (127 - (int)(kb2 & 127u));
        }
        LDS_WAIT(); asm volatile("" ::: "memory");
        const float inv = 1.0f / sm;
        if (hh == 0) {
#pragma unroll
            for (int it = 0; it < 16; ++it) RG[r * 128 + h * 16 + it] = EXL[it * 64 + lane] * inv;
        }
        LDS_WAIT(); asm volatile("" ::: "memory");
    }
}

#define PU_ISSUE(dst, eis, r0_) do { _Pragma("unroll") for (int rd = 0; rd < 4; ++rd) { const v4u* up = (const v4u*)(U6s + ((unsigned)eis[(r0_) + rd] * 192u + 16u * (unsigned)piece)); dst[rd][0] = up[0]; dst[rd][1] = up[4]; dst[rd][2] = up[8]; } } while (0)
#define PU_COMP(src, r0_) do { _Pragma("unroll") for (int rd = 0; rd < 4; ++rd) { \
        const v4u r0 = src[rd][0], r1 = src[rd][1], r2 = src[rd][2]; \
        const v6i_t ca = {(int)r0.x, (int)r0.y, (int)r0.z, (int)r0.w, (int)r1.x, (int)r1.y}, cb = {(int)r1.z, (int)r1.w, (int)r2.x, (int)r2.y, (int)r2.z, (int)r2.w}; \
        const v16u_t ua = __builtin_bit_cast(v16u_t, __builtin_amdgcn_cvt_scalef32_pk32_bf16_fp6(ca, 1.0f)), ub = __builtin_bit_cast(v16u_t, __builtin_amdgcn_cvt_scalef32_pk32_bf16_fp6(cb, 1.0f)); \
        float a0 = 0.f, a1 = 0.f, a2 = 0.f, a3 = 0.f; \
        _Pragma("unroll") for (int k = 0; k < 8; ++k) { a0 = dot2(ua[2 * k], xq[k].x, a0); a1 = dot2(ua[2 * k + 1], xq[k].y, a1); a2 = dot2(ub[2 * k], xq[k].z, a2); a3 = dot2(ub[2 * k + 1], xq[k].w, a3); } \
        float d = (a0 + a1) + (a2 + a3); d += lane_xor<1>(d); d += lane_xor<2>(d); \
        dd[(r0_) + rd] = d; } } while (0)
#define PU_SB() do { asm volatile("" ::: "memory"); __builtin_amdgcn_sched_barrier(0); } while (0)
__device__ __forceinline__ void peer_u_pass(const Ptrs& P, int l, int G, int vbx, int wave, int lane) {
    unsigned char* ws = P.ws;
    const int xs = vbx & 7, wr = vbx >> 3, nW = G >> 3;
    const int* RI = (const int*)(ws + WS_RI); float* PD = (float*)(ws + WS_PD); const bf16* XB = (const bf16*)(ws + WS_XB);
    const int slot = lane >> 2, piece = lane & 3;
    const int tstep = nW * NWAVES;
    const unsigned char* U6s = ws + WS_U + (size_t)l * TBL_LAYER + (size_t)xs * TBL_SLICE;
    int t = wr * NWAVES + wave;
    v4u xq[8], rowsA[4][3], rowsB[4][3]; int ein[8];
    { int e0[8]; const int* ri = RI + (size_t)t * 128 + slot;
#pragma unroll
      for (int rd = 0; rd < 8; ++rd) e0[rd] = ri[16 * rd];
      const int t1 = (t + tstep < M) ? t + tstep : t; const int* rn = RI + (size_t)t1 * 128 + slot; const bf16* xr = XB + (size_t)t * 2048 + 256 * xs + 8 * piece;
#pragma unroll
      for (int rd = 0; rd < 8; ++rd) ein[rd] = rn[16 * rd];
#pragma unroll
      for (int k = 0; k < 8; ++k) xq[k] = *(const v4u*)(xr + 32 * k);
      PU_SB();
      PU_ISSUE(rowsA, e0, 0); PU_ISSUE(rowsB, e0, 4); PU_SB(); }
#pragma unroll 1
    for (; t < M; t += tstep) {
        const int t1 = (t + tstep < M) ? t + tstep : t, t2 = (t + 2 * tstep < M) ? t + 2 * tstep : t1;
        v4u xn[8]; int eiA, eiB;
        { const int* ri = RI + (size_t)t2 * 128 + lane; const bf16* xr = XB + (size_t)t1 * 2048 + 256 * xs + 8 * piece;
          eiA = ri[0]; eiB = ri[64];
#pragma unroll
          for (int k = 0; k < 8; ++k) xn[k] = *(const v4u*)(xr + 32 * k); }
        float* pd = PD + ((size_t)xs * M + t) * 128 + 16 * piece + slot;
        float dd[8];
        PU_SB(); PU_COMP(rowsA, 0); PU_SB();
        PU_ISSUE(rowsA, ein, 0); PU_SB();
        PU_COMP(rowsB, 4); PU_SB();
        PU_ISSUE(rowsB, ein, 4); PU_SB();
        {
          const float s0 = piece == 0 ? dd[0] : piece == 1 ? dd[1] : piece == 2 ? dd[2] : dd[3], s1 = piece == 0 ? dd[4] : piece == 1 ? dd[5] : piece == 2 ? dd[6] : dd[7];
          pd[0] = s0; pd[64] = s1; }
#pragma unroll
        for (int k = 0; k < 8; ++k) xq[k] = xn[k];
#pragma unroll
        for (int rd = 0; rd < 4; ++rd) { ein[rd] = __builtin_amdgcn_ds_bpermute(4 * (16 * rd + slot), eiA); ein[4 + rd] = __builtin_amdgcn_ds_bpermute(4 * (16 * rd + slot), eiB); }
    }
}
#undef PU_ISSUE
#undef PU_COMP
#undef PU_SB
__device__ __forceinline__ void peer_combine(const Ptrs& P, int l, int gw, int NGW, int lane) {
    unsigned char* ws = P.ws;
    const int* RI = (const int*)(ws + WS_RI); const float* RG = (const float*)(ws + WS_RG); const float* PD = (const float*)(ws + WS_PD); unsigned* W = (unsigned*)(ws + WS_W);
    const f32x2v* SCL = (const f32x2v*)(ws + WS_USC) + l * 16384; const float* RSTD = (const float*)(ws + WS_RSTD);
    float pd[2][8], rg[2], rstd; int ei[2];
    int z = 0; asm volatile("" : "+v"(z));
#define PC_LOAD(t_) do { rstd = RSTD[(t_) + z]; _Pragma("unroll") for (int hf = 0; hf < 2; ++hf) { const int k = lane + 64 * hf; \
        _Pragma("unroll") for (int sl = 0; sl < 8; ++sl) pd[hf][sl] = PD[((size_t)sl * M + (t_)) * 128 + k]; \
        ei[hf] = RI[(size_t)(t_) * 128 + k]; rg[hf] = RG[(size_t)(t_) * 128 + k]; } } while (0)
    if (gw < M) PC_LOAD(gw);
#pragma unroll 1
    for (int t = gw; t < M; t += NGW) {
        const float rs = rstd; const int e0 = ei[0], e1 = ei[1]; const float g0 = rg[0], g1 = rg[1];
        float a0 = 0.f, a1 = 0.f;
#pragma unroll
        for (int sl = 0; sl < 8; ++sl) { a0 += pd[0][sl]; a1 += pd[1][sl]; }
        const f32x2v s0 = SCL[e0], s1 = SCL[e1];
        { const int tn = (t + NGW < M) ? t + NGW : t; PC_LOAD(tn); }
        const float w0 = g0 * gelu_tanh(a0 * s0.x * rs) * s0.y, w1 = g1 * gelu_tanh(a1 * s1.x * rs) * s1.y;
        W[(size_t)t * 128 + lane] = (pk2(w0, 0.f) << 16) | (unsigned)e0; W[(size_t)t * 128 + lane + 64] = (pk2(w1, 0.f) << 16) | (unsigned)e1;
    }
#undef PC_LOAD
}
#define PV_LOAD(dst, k0) do { const v4u eq0_ = *(const LAS v4u*)(ELb + qd * 132 + (k0)), eq1_ = *(const LAS v4u*)(ELb + qd * 132 + (k0) + 4); \
    _Pragma("unroll") for (int kk = 0; kk < 8; ++kk) { const unsigned ei_ = (kk < 4 ? eq0_[kk & 3] : eq1_[kk & 3]) & 0xffffu; const unsigned char* rp_ = V6s + (ei_ * 192u + c8o); \
        const v4u lo_ = *(const v4u*)(rp_ + c8o); const u32x2v hi_ = *(const u32x2v*)(rp_ + 128); dst[kk][0] = (u32x2v){lo_.x, lo_.y}; dst[kk][1] = (u32x2v){lo_.z, lo_.w}; dst[kk][2] = hi_; } } while (0)
#define PV_FMA(src, k0) do { const v4u wq0_ = *(const LAS v4u*)(ELb + qd * 132 + (k0)), wq1_ = *(const LAS v4u*)(ELb + qd * 132 + (k0) + 4); \
    _Pragma("unroll") for (int kk = 0; kk < 8; ++kk) { const float w_ = __builtin_bit_cast(float, (kk < 4 ? wq0_[kk & 3] : wq1_[kk & 3]) & 0xffff0000u); const f32x2v wk_ = (f32x2v){w_, w_}; \
        const v6i_t c_ = {(int)src[kk][0].x, (int)src[kk][0].y, (int)src[kk][1].x, (int)src[kk][1].y, (int)src[kk][2].x, (int)src[kk][2].y}; \
        const v32f_t d_ = __builtin_amdgcn_cvt_scalef32_pk32_f32_fp6(c_, 1.0f); \
        _Pragma("unroll") for (int i_ = 0; i_ < 16; ++i_) o[i_] = (f32x2v){d_[2 * i_], d_[2 * i_ + 1]} * wk_ + o[i_]; \
        __builtin_amdgcn_sched_barrier(0); } } while (0)
__device__ __forceinline__ void peer_v_pass(const Ptrs& P, int l, int G, int vbx, LAS unsigned char* lds, int wave, int lane) {
    unsigned char* ws = P.ws;
    const int xs = vbx & 7, wr = vbx >> 3, nW = G >> 3;
    const unsigned* W = (const unsigned*)(ws + WS_W);
    bf16* XB = (bf16*)(ws + WS_XB); float* RS = (float*)(ws + WS_RS);
    const int gstep = nW * NWAVES;
    const unsigned char* V6s = ws + WS_V + (size_t)l * TBL_LAYER + (size_t)xs * TBL_SLICE;
    int tg = wr * NWAVES + wave, par = 0;
    { LAS unsigned* EL0 = (LAS unsigned*)(lds + wave * 8448);
      const unsigned* wp = W + (size_t)(8 * tg) * 128;
      int ln0 = lane; asm volatile("" : "+v"(ln0));
#pragma unroll
      for (int j = 0; j < 16; ++j) EL0[(j >> 1) * 132 + 64 * (j & 1) + ln0] = wp[ln0 + 64 * j]; }
    LDS_WAIT(); asm volatile("" ::: "memory");
#pragma unroll 1
    for (; tg < M / 8; tg += gstep, par ^= 1) {
        const LAS unsigned* ELb = (const LAS unsigned*)(lds + wave * 8448 + par * 4224);
        int ln = lane; asm volatile("" : "+v"(ln));
        const int qd = ln >> 3, b8 = ln & 7;
        const unsigned c8o = 8u * (unsigned)b8;
        const int t = 8 * tg + qd;
        u32x2v vA[8][3], vB[8][3];
        PV_LOAD(vA, 0);
        unsigned nel[16];
        { const int tgn = (tg + gstep < M / 8) ? tg + gstep : tg;
          const unsigned* wp = W + (size_t)(8 * tgn) * 128;
#pragma unroll
          for (int j = 0; j < 16; ++j) nel[j] = wp[ln + 64 * j]; }
        const size_t col0 = (size_t)t * 2048 + 256 * xs + 4 * b8;
        u32x2v xres[8];
#pragma unroll
        for (int k = 0; k < 8; ++k) xres[k] = *(const u32x2v*)(XB + col0 + 32 * k);
        f32x2v o[16];
#pragma unroll
        for (int i = 0; i < 16; ++i) o[i] = (f32x2v){0.f, 0.f};
#define PV_SB() do { asm volatile("" ::: "memory"); __builtin_amdgcn_sched_barrier(0); } while (0)
        PV_SB(); PV_LOAD(vB, 8); PV_FMA(vA, 0); PV_SB();
        PV_LOAD(vA, 16); PV_FMA(vB, 8); PV_SB();
        PV_LOAD(vB, 24); PV_FMA(vA, 16); PV_SB();
        PV_LOAD(vA, 32); PV_FMA(vB, 24); PV_SB();
        PV_LOAD(vB, 40); PV_FMA(vA, 32); PV_SB();
        PV_LOAD(vA, 48); PV_FMA(vB, 40); PV_SB();
        PV_LOAD(vB, 56); PV_FMA(vA, 48); PV_SB();
        PV_LOAD(vA, 64); PV_FMA(vB, 56); PV_SB();
        PV_LOAD(vB, 72); PV_FMA(vA, 64); PV_SB();
        PV_LOAD(vA, 80); PV_FMA(vB, 72); PV_SB();
        PV_LOAD(vB, 88); PV_FMA(vA, 80); PV_SB();
        PV_LOAD(vA, 96); PV_FMA(vB, 88); PV_SB();
        PV_LOAD(vB, 104); PV_FMA(vA, 96); PV_SB();
        PV_LOAD(vA, 112); PV_FMA(vB, 104); PV_SB();
        PV_LOAD(vB, 120); PV_FMA(vA, 112); PV_SB();
        PV_FMA(vB, 120); PV_SB();
#undef PV_SB
        { LAS unsigned* ELn = (LAS unsigned*)(lds + wave * 8448 + (par ^ 1) * 4224);
#pragma unroll
          for (int j = 0; j < 16; ++j) ELn[(j >> 1) * 132 + 64 * (j & 1) + ln] = nel[j]; }
        LDS_WAIT(); asm volatile("" ::: "memory");
        float ss = 0.f;
#pragma unroll
        for (int k = 0; k < 8; ++k) {
            const u32x2v xa = xres[k];
            const f32x4 na = (f32x4){bflo(xa.x) + o[2 * k].x, bfhi(xa.x) + o[2 * k].y, bflo(xa.y) + o[2 * k + 1].x, bfhi(xa.y) + o[2 * k + 1].y};
            u32x2v pk; pk.x = pk2(na.x, na.y); pk.y = pk2(na.z, na.w); *(u32x2v*)(XB + col0 + 32 * k) = pk;
            int w0 = __builtin_amdgcn_cvt_pk_fp8_f32(na.x, na.y, 0, false); w0 = __builtin_amdgcn_cvt_pk_fp8_f32(na.z, na.w, w0, true);
            *(unsigned*)(ws + WS_XB8 + col0 + 32 * k) = (unsigned)w0;
            ss += (na.x * na.x + na.y * na.y) + (na.z * na.z + na.w * na.w); }
        ss += lane_xor<1>(ss); ss += lane_xor<2>(ss); ss += lane_xor<4>(ss);
        if (b8 == 4) RS[t * 16 + xs] = ss;
    }
}
#undef PV_LOAD
#undef PV_FMA
__device__ __forceinline__ void final_norm(const Ptrs& P, int gw, int NGW, int lane) {
    const float* RS = (const float*)(P.ws + WS_RS);
#pragma unroll 1
    for (int t = gw; t < M; t += NGW) {
        const float pv = lane < 16 ? RS[t * 16 + lane] : 0.f;
        const float rf = rsqrtf(wave_sum(pv) * (1.0f / 2048.0f) + EPS);
        const bf16* xr = (const bf16*)(P.ws + WS_XB) + (size_t)t * 2048; float* orow = P.out + (size_t)t * 2048;
#pragma unroll
        for (int i = 0; i < 4; ++i) { const int e0 = 8 * (lane + 64 * i); const v4u v = *(const v4u*)(xr + e0); const f32x4 g0 = *(const f32x4*)(P.g_final + e0), g1 = *(const f32x4*)(P.g_final + e0 + 4);
            *(f32x4*)(orow + e0) = (f32x4){bflo(v.x) * rf * g0.x, bfhi(v.x) * rf * g0.y, bflo(v.y) * rf * g0.z, bfhi(v.y) * rf * g0.w};
            *(f32x4*)(orow + e0 + 4) = (f32x4){bflo(v.z) * rf * g1.x, bfhi(v.z) * rf * g1.y, bflo(v.w) * rf * g1.z, bfhi(v.w) * rf * g1.w}; }
    }
}
#ifndef MK_PER_PHASE
#define MK_PER_PHASE 0
#endif
struct Args { const float* in[18]; float* out; unsigned char* ws; int ph_lo, ph_hi; };
__global__ void __launch_bounds__(NWAVES * 64, 2) mega_fwd(Args args) {
    extern __shared__ __attribute__((aligned(16))) unsigned char lds_raw[];
    LAS unsigned char* lds = (LAS unsigned char*)lds_raw;
    const int tid0 = threadIdx.x, wave = __builtin_amdgcn_readfirstlane(tid0 >> 6);
    const int G = gridDim.x, bx = blockIdx.x; const int vcu0 = (G % 8 == 0) ? (bx % 8) * (G / 8) + bx / 8 : bx;
    const int gw0 = vcu0 * NWAVES + wave, NGW = G * NWAVES;
    Ptrs P;
    P.x = args.in[0]; P.rel_bias = args.in[1]; P.g_mix = args.in[2]; P.w_in = args.in[3]; P.a_sinks = args.in[4]; P.c_gain = args.in[5]; P.w_uk = args.in[6]; P.w_uv = args.in[7];
    P.w_a = args.in[8]; P.w_b = args.in[9]; P.w_c = args.in[10]; P.w_out = args.in[11]; P.g_ffn = args.in[12]; P.w_q = args.in[13]; P.sub_keys = args.in[14]; P.peer_u = args.in[15]; P.peer_v = args.in[16]; P.g_final = args.in[17];
    P.out = args.out; P.ws = args.ws;
    unsigned char* ws = args.ws;
    gu32* ctl = (gu32*)(ws + WS_CTL);
    for (int u = tid0; u < (LDS_BYTES - LDSCTL_OFF) / 4; u += NWAVES * 64) ((LAS unsigned*)(lds + LDSCTL_OFF))[u] = 0u;
    __syncthreads();
    volatile LAS unsigned* MISC = (volatile LAS unsigned*)(lds + MISC_OFF);
    XcdBarrier bar; bar.bar = (unsigned*)(ctl + CW_BAR); bar.x = 0; bar.st = nullptr;
    if (!MK_PER_PHASE) bar = xcd_barrier_post((unsigned*)(ctl + CW_BAR), MISC + 8);
    const int lo = args.ph_lo, hi = args.ph_hi;
#ifndef PH_MASK
#define PH_MASK 0xffff
#endif
#define IN(k) (lo <= (k) && (k) < hi)
#define EN(j) ((PH_MASK >> (j)) & 1)
#ifndef REP_MASK
#define REP_MASK 0
#endif
#define NREP(j) (((REP_MASK >> (j)) & 1) ? 2 : 1)
#define SEAM(k) do { if (IN(k) && IN((k) + 1)) xcd_barrier(bar); } while (0)
    bf16* XB = (bf16*)(ws + WS_XB); bf16* PA = (bf16*)(ws + WS_PA); bf16* GT = (bf16*)(ws + WS_GT); bf16* MG = (bf16*)(ws + WS_MG); bf16* QP = (bf16*)(ws + WS_QP);
    bf16* YA = (bf16*)(ws + WS_YA); bf16* YB = YA; bf16* YC = YA; bf16* CN = (bf16*)(ws + WS_CN);
    unsigned long long* MASK = (unsigned long long*)(ws + WS_MASK);
    float* rowssA = (float*)(ws + WS_RS); const float* biasd = (const float*)(ws + WS_BIASD);
    LAS unsigned char* wscr = lds + wave * 16384;

#define FRESH() int lane = lane_id_(); asm volatile("" : "+v"(lane)); int tid = wave * 64 + lane; (void)tid
    if (EN(0) && IN(0)) { FRESH(); for (int rep = 0; rep < NREP(0); ++rep) p0_prologue(P, lds, gw0, NGW, wave, lane); }
    SEAM(0);
    const bool loc = !MK_PER_PHASE && (G == 256) && (MISC[10] == 1u);
    const int X = __builtin_amdgcn_readfirstlane(loc ? (int)bar.x : (bx & 7)), J = __builtin_amdgcn_readfirstlane(loc ? (int)MISC[11] : (bx >> 3));
    const int vbx = (G == 256) ? J * 8 + X : bx;
    const int vcu = (G == 256) ? X * 32 + J : vcu0;
    const int gw = vcu * NWAVES + wave;
#define SEAML(k) do { if (IN(k) && IN((k) + 1)) { if (loc) xcd_barrier_local(bar); else xcd_barrier(bar); } } while (0)
#pragma unroll 1
    for (int l = 0; l < DEPTH; ++l) {
        const int pb = 1 + 10 * l;
        float* KM = (float*)(ws + WS_KMEAN) + (size_t)l * 32768;
        float* rowssB = (float*)(ws + WS_ROWSSB);
        if (EN(1) && IN(pb + 0)) {
#pragma unroll 1
            for (int rep = 0; rep < NREP(1); ++rep) {
            { pg8::Gemm g{XB, (const bf16*)(ws + WS_WIN) + (size_t)l * NPROJ * 2048, M, 4096, 2048}; pg8::SplitOrder S; S.init(G, vbx, true);
              pg8::EpiProj E{PA, KM, rowssA};
              pg8::gemm_phase<pg8::EpiProj, pg8::SplitOrder, true, true>(lds, g, S, E, wave); }
            { pg8::Gemm g{(const bf16*)(ws + WS_XB8), (const bf16*)(ws + WS_WG8 + (size_t)l * NPROJ * 2048), M, NPROJ, 2048}; pg8::SplitOrder S; S.init(G, vbx, false);
              pg8::EpiIn8 E{PA, (unsigned char*)GT, rowssA};
              pg8::gemm_phase<pg8::EpiIn8, pg8::SplitOrder, true, true, true>(lds, g, S, E, wave); }
            }
        }
        SEAML(pb + 0);
        if (EN(2) && IN(pb + 1)) { FRESH();
#pragma unroll 1
            for (int rep = 0; rep < NREP(2); ++rep)
#pragma unroll 1
            for (int u = vcu; u < 512; u += G) {
                const int bb = (u & 255) >> 5, ii = u & 31, qt = (u < 256) ? ii : 63 - ii;
                sel_unit(PA, (float*)(ws + WS_SC), MASK, bb, qt, lds, tid, wave, lane);
            }
            if (G == 256) { for (int k = 0; k < 2; ++k) cn_item(PA, P.c_gain + l * 128, CN, X * 512 + J * 8 + wave + 256 * k, lane); }
            else for (int i = gw; i < M / 4; i += NGW) cn_item(PA, P.c_gain + l * 128, CN, i, lane);
#pragma unroll 1
            for (int rep = 0; rep < NREP(3); ++rep)
#pragma unroll 1
            for (int u = vcu, k = 0; u < 1024; u += G, ++k) { if (G == 256) swa_unit(PA, biasd, P.a_sinks + l * 16, YA, X, k, J, lds, tid, wave, lane);
                else swa_unit(PA, biasd, P.a_sinks + l * 16, YA, u >> 7, (u >> 5) & 3, u & 31, lds, tid, wave, lane); }
            __syncthreads();
        }
        SEAML(pb + 1);
        if (EN(3) && IN(pb + 2)) { FRESH();
#pragma unroll 1
            for (int rep = 0; rep < NREP(4); ++rep)
#pragma unroll 1
            for (int u = vcu; u < 512; u += G) {
                const int bb = (u & 255) >> 5, ii = u & 31, qt = (u < 256) ? ii : 63 - ii;
                if (u == vcu) dsa_unit<true>(CN, PA, MASK, biasd, (const bf16*)(ws + WS_WUKB) + (size_t)l * 65536, (const bf16*)(ws + WS_WUVT) + (size_t)l * 65536, YC, bb, qt, lds, tid, wave, lane);
                else dsa_unit<false>(CN, PA, MASK, biasd, (const bf16*)(ws + WS_WUKB) + (size_t)l * 65536, (const bf16*)(ws + WS_WUVT) + (size_t)l * 65536, YC, bb, qt, lds, tid, wave, lane);
            }
            __syncthreads();
#pragma unroll 1
            for (int rep = 0; rep < NREP(5); ++rep)
#pragma unroll 1
            for (int u = vcu; u < 512; u += G) {
                const int bh = (u & 255) >> 2, pr = u & 3, nblk = (u < 256) ? pr : 7 - pr;
                moba_unit(PA, biasd, KM, YB, bh >> 3, bh & 7, nblk, lds, tid, wave, lane);
            }
            __syncthreads();
        }
        SEAML(pb + 2);
        if (EN(4) && IN(pb + 3)) {
            pg8::StaticOrder S; S.init(M, 2048, G, vbx);
            pg8::Gemm g{YA, (const bf16*)(ws + WS_WA + (size_t)l * 2048 * 2048), M, 2048, 2048}; pg8::EpiGate3 E{(unsigned char*)MG, (const unsigned char*)GT};
#pragma unroll 1
            for (int rep = 0; rep < NREP(6); ++rep) pg8::gemm_phase<pg8::EpiGate3, pg8::StaticOrder, true, true, true>(lds, g, S, E, wave);
        }
        SEAML(pb + 3);
        if (EN(5) && IN(pb + 4)) {
            pg8::Gemm g{MG, (const bf16*)(ws + WS_WOUT + (size_t)l * 2048 * 2048), M, 2048, 2048}; pg8::StaticOrder S; S.init(M, 2048, G, vbx);
            pg8::EpiResid E{XB, rowssB, 0.000244140625f};
            pg8::gemm_phase<pg8::EpiResid, pg8::StaticOrder, true, true, true>(lds, g, S, E, wave);
        }
        SEAML(pb + 4);
        if (EN(6) && IN(pb + 5)) {
            pg8::Gemm g{XB, (const bf16*)(ws + WS_WQ) + (size_t)l * 2048 * 2048, M, 2048, 2048}; pg8::StaticOrder S; S.init(M, 2048, G, vbx);
            pg8::EpiQ E{QP};
#pragma unroll 1
            for (int rep = 0; rep < NREP(7); ++rep) pg8::gemm_phase<pg8::EpiQ, pg8::StaticOrder, true, true>(lds, g, S, E, wave);
        }
        SEAML(pb + 5);
        if (EN(7) && IN(pb + 6)) { FRESH();
            for (int u = vcu, k = 0; u < M / 32; u += G, ++k) peer_route(P, l, (G == 256) ? X * 64 + J + 32 * k : u, lds, tid, wave, lane);
        }
        SEAM(pb + 6);
        if (EN(8) && IN(pb + 7)) { FRESH(); peer_u_pass(P, l, G, vbx, wave, lane); }
        SEAM(pb + 7);
        if (EN(9) && IN(pb + 8)) { FRESH(); peer_combine(P, l, gw, NGW, lane); }
        SEAM(pb + 8);
        if (EN(10) && IN(pb + 9)) { FRESH(); peer_v_pass(P, l, G, vbx, lds, wave, lane); }
        SEAM(pb + 9);
    }
    if (IN(21)) { FRESH(); final_norm(P, gw, NGW, lane); }
#undef IN
#undef SEAM
}

extern "C" void kernel_launch(void* const* d_in, const int* in_sizes, int n_in, void* d_out, int out_size, void* d_ws, size_t ws_size, hipStream_t stream) {
    static int grid = 0;
    if (grid == 0) {
        if (n_in != 18 || out_size != M * D || ws_size < WS_END) { fprintf(stderr, "kernel_launch: unexpected problem (n_in %d, out %d, ws %zu); nothing launched\n", n_in, out_size, ws_size); grid = -1; return; }
        int dev = 0, cus = 0, per_cu = 0;
        if (hipGetDevice(&dev) != hipSuccess || hipDeviceGetAttribute(&cus, hipDeviceAttributeMultiprocessorCount, dev) != hipSuccess) { grid = -1; return; }
        if (hipFuncSetAttribute((const void*)mega_fwd, hipFuncAttributeMaxDynamicSharedMemorySize, LDS_BYTES) != hipSuccess) { fprintf(stderr, "kernel_launch: hipFuncSetAttribute failed\n"); grid = -1; return; }
        if (hipOccupancyMaxActiveBlocksPerMultiprocessor(&per_cu, (const void*)mega_fwd, NWAVES * 64, LDS_BYTES) != hipSuccess || per_cu < 1) { fprintf(stderr, "kernel_launch: occupancy query reports %d workgroups per CU\n", per_cu); }
        (void)hipGetLastError();
        grid = cus;
    }
    if (grid < 0) return;
    if (hipMemsetAsync((char*)d_ws + WS_CTL, 0, CTL_ZERO_BYTES, stream) != hipSuccess) { fprintf(stderr, "kernel_launch: hipMemsetAsync failed\n"); return; }
    Args a{};
    for (int i = 0; i < 18; ++i) a.in[i] = (const float*)d_in[i];
    a.out = (float*)d_out; a.ws = (unsigned char*)d_ws;
#if MK_PER_PHASE
    for (int p = 0; p < NPHASE; ++p) { a.ph_lo = p; a.ph_hi = p + 1; hipLaunchKernelGGL(mega_fwd, dim3(grid), dim3(NWAVES * 64), LDS_BYTES, stream, a); }
#else
    a.ph_lo = 0; a.ph_hi = NPHASE;
    hipLaunchKernelGGL(mega_fwd, dim3(grid), dim3(NWAVES * 64), LDS_BYTES, stream, a);
#endif
    const hipError_t le = hipPeekAtLastError();
    if (le != hipSuccess) fprintf(stderr, "kernel_launch: launch failed: %s\n", hipGetErrorName(le));
}
```
